# Optimizing an MI355X kernel written in HIP

```python
import math
import numpy as np
import jax
import jax.numpy as jnp
from jax import lax


D_MODEL = 1024
BATCH = 4
SEQ = 8192
DEPTH = 2

GRID_W = 64
CTX_LEN = 256
HEAD_DIM = 64
N_GROUP_HEADS = D_MODEL // (4 * HEAD_DIM)
N_HEADS_NA = N_GROUP_HEADS
N_BLOCKS_LRU = N_GROUP_HEADS
LRU_BLOCK = HEAD_DIM
N_HEADS_RET = N_GROUP_HEADS
N_HEADS_DIFF = N_GROUP_HEADS
W_NA = N_HEADS_NA * HEAD_DIM
W_LRU = N_BLOCKS_LRU * LRU_BLOCK
W_RET = N_HEADS_RET * HEAD_DIM
W_DIFF = N_HEADS_DIFF * HEAD_DIM
MIX_WIDTH = W_NA + W_LRU + W_RET + W_DIFF
DIFF_DIM = HEAD_DIM // 2
IN_SPLITS = (W_NA,) * 3 + (W_LRU,) * 2 + (W_RET,) * 4 + (W_DIFF,) * 3
IN_WIDTH = sum(IN_SPLITS)
SPLIT_POINTS = tuple(int(s) for s in np.cumsum(IN_SPLITS)[:-1])
NA_WIN_ROWS = 8
NA_WIN_COLS = 16
LRU_CONV = 4
LRU_C = 8.0
RET_CHUNK = 128
Q_BLOCK = 128
ROPE_BASE = 10000.0
EPS = 1e-6
D_FF = ((8 * D_MODEL + 3 * 256 - 1) // (3 * 256)) * 256
NA_SCALE = HEAD_DIM ** -0.5
RET_SCALE = HEAD_DIM ** -0.5

kernel_name = 'hybrid_grid_diffusion_block'


def rms_norm(x, g):
    xf = x.astype(jnp.float32)
    y = xf * lax.rsqrt(jnp.mean(xf * xf, axis=-1, keepdims=True) + EPS)
    return (y * g.astype(jnp.float32)).astype(x.dtype)


def head_rms(y):
    yf = y.astype(jnp.float32)
    return (yf * lax.rsqrt(jnp.mean(yf * yf, axis=-1, keepdims=True) + EPS)).astype(y.dtype)


def modulate(h, shift, scale):
    return h * (1.0 + scale) + shift


def to_heads(t, h):
    return t.reshape(t.shape[:2] + (h, -1))


def to_maps(t):
    return t.reshape(t.shape[:2] + (N_HEADS_DIFF, 2, DIFF_DIM))


def axial_rope(n, dim):
    t = jnp.arange(n)
    row = (t // GRID_W).astype(jnp.float32)
    col = (t % GRID_W).astype(jnp.float32)
    nf = dim // 4
    inv = ROPE_BASE ** (-jnp.arange(nf, dtype=jnp.float32) / nf)
    ang = jnp.concatenate([row[:, None] * inv, col[:, None] * inv], axis=-1)
    return jnp.cos(ang), jnp.sin(ang)


def apply_rope(x, cos, sin):
    shape = (1, x.shape[1]) + (1,) * (x.ndim - 3) + (cos.shape[-1],)
    cos = cos.reshape(shape).astype(x.dtype)
    sin = sin.reshape(shape).astype(x.dtype)
    half = x.shape[-1] // 2
    x1, x2 = x[..., :half], x[..., half:]
    return jnp.concatenate([x1 * cos - x2 * sin, x2 * cos + x1 * sin], axis=-1)


def softmax_attention(q, k, v):
    s = jnp.einsum('bqhd,bkhd->bhqk', q, k).astype(jnp.float32)
    p = jax.nn.softmax(s, axis=-1).astype(v.dtype)
    o = jnp.einsum('bhqk,bkhd->bqhd', p, v)
    return o.reshape(o.shape[:2] + (-1,))


def neighbourhood_attention(q, k, v, k_ctx, v_ctx, rpb, rows):
    b, n, h, d = q.shape
    wr = min(NA_WIN_ROWS, rows)
    qg = q.reshape(b, rows, GRID_W, h, d)
    kg = k.reshape(b, rows, GRID_W, h, d)
    vg = v.reshape(b, rows, GRID_W, h, d)
    col_start = np.clip(np.arange(GRID_W) - NA_WIN_COLS // 2, 0, GRID_W - NA_WIN_COLS)
    col_idx = col_start[:, None] + np.arange(NA_WIN_COLS)[None, :]
    dc = col_idx - np.arange(GRID_W)[:, None] + NA_WIN_COLS - 1
    n_win = wr * NA_WIN_COLS

    def one_row(r):
        r0 = jnp.clip(r - wr // 2, 0, rows - wr)
        kw = lax.dynamic_slice_in_dim(kg, r0, wr, axis=1)[:, :, col_idx]
        vw = lax.dynamic_slice_in_dim(vg, r0, wr, axis=1)[:, :, col_idx]
        qr = lax.dynamic_index_in_dim(qg, r, axis=1, keepdims=False)
        dr = r0 + jnp.arange(wr) - r + NA_WIN_ROWS - 1
        bias = jnp.transpose(rpb[:, dr][:, :, dc], (0, 2, 1, 3))
        s_win = (jnp.einsum('bqhd,brqjhd->bhqrj', qr, kw).astype(jnp.float32)
                 + bias[None].astype(jnp.float32))
        s_ctx = jnp.einsum('bqhd,bchd->bhqc', qr, k_ctx).astype(jnp.float32)
        s = jnp.concatenate([s_win.reshape(b, h, GRID_W, n_win), s_ctx], axis=-1)
        p = jax.nn.softmax(s, axis=-1).astype(v.dtype)
        p_win = p[..., :n_win].reshape(b, h, GRID_W, wr, NA_WIN_COLS)
        p_ctx = p[..., n_win:]
        return (jnp.einsum('bhqrj,brqjhd->bqhd', p_win, vw)
                + jnp.einsum('bhqc,bchd->bqhd', p_ctx, v_ctx))

    out = lax.map(one_row, jnp.arange(rows))
    return jnp.moveaxis(out, 0, 1).reshape(b, n, h * d)


def depthwise_conv(x, w, bias):
    k = w.shape[0]
    left = (k - 1) // 2
    y = lax.conv_general_dilated(x, w[:, None, :].astype(x.dtype), window_strides=(1,),
                                 padding=[(left, k - 1 - left)],
                                 dimension_numbers=('NWC', 'WIO', 'NWC'),
                                 feature_group_count=x.shape[-1])
    return y + bias


def rglru_coeffs(xb, w_g, b_g, lam):
    bsz, n = xb.shape[:2]
    xk = xb.reshape(bsz, n, N_BLOCKS_LRU, LRU_BLOCK)
    gates = jax.nn.sigmoid(jnp.einsum('bnkc,gkcd->gbnkd', xk, w_g) + b_g[:, None, None])
    r = gates[0].reshape(bsz, n, W_LRU).astype(jnp.float32)
    i = gates[1].reshape(bsz, n, W_LRU).astype(jnp.float32)
    log_a = -LRU_C * r * jax.nn.softplus(-lam.astype(jnp.float32))
    a = jnp.exp(log_a)
    u = jnp.sqrt(-jnp.expm1(2.0 * log_a)) * (i * xb.astype(jnp.float32))
    return a, u


def linear_scan(a, u, h0, reverse):
    def comb(left, right):
        al, ul = left
        ar, ur = right
        return al * ar, ar * ul + ur
    a_cum, u_cum = lax.associative_scan(comb, (a, u), axis=1, reverse=reverse)
    h = a_cum * h0[:, None, :] + u_cum
    final = h[:, 0] if reverse else h[:, -1]
    return h, final


def rglru_bidir(xb, w_g, b_g, lam, h0_fwd, h0_bwd):
    af, uf = rglru_coeffs(xb, w_g[0], b_g[0], lam[0])
    ab, ub = rglru_coeffs(xb, w_g[1], b_g[1], lam[1])
    hf, hf_last = linear_scan(af, uf, h0_fwd, reverse=False)
    hb, hb_last = linear_scan(ab, ub, h0_bwd, reverse=True)
    return (hf + hb).astype(xb.dtype), hf_last, hb_last


def retention_scan(q, k, v, log_gamma, s0, inclusive, reverse):
    dtype = v.dtype
    q, k, v = (t.astype(jnp.float32) for t in (q, k, v))
    if reverse:
        q, k, v = (jnp.flip(t, axis=1) for t in (q, k, v))
    b, n, h, d = q.shape
    cs = min(RET_CHUNK, n)
    nc = n // cs
    shift = 0.0 if inclusive else 1.0
    j = jnp.arange(cs, dtype=jnp.float32)
    rel = j[:, None] - j[None, :] - shift
    mask = rel >= 0
    dmat = jnp.where(mask[None], jnp.exp(log_gamma[:, None, None] * jnp.where(mask, rel, 0.0)[None]), 0.0)
    q_decay = jnp.exp(log_gamma[None, :] * (j[:, None] + 1.0 - shift))
    k_decay = jnp.exp(log_gamma[None, :] * (cs - 1.0 - j[:, None]))
    c_decay = jnp.exp(log_gamma * cs)

    def chunks(t):
        return jnp.moveaxis(t.reshape(b, nc, cs, h, d), 1, 0)

    def step(s, inp):
        qc, kc, vc = inp
        sc = jnp.einsum('bihd,bjhd->bhij', qc, kc) * dmat
        o = (jnp.einsum('bhij,bjhe->bihe', sc, vc)
             + jnp.einsum('bihd,bhde->bihe', qc * q_decay[:, :, None], s))
        s = s * c_decay[:, None, None] + jnp.einsum('bjhd,bjhe->bhde', kc * k_decay[:, :, None], vc)
        return s, o

    s_fin, o = lax.scan(step, s0, (chunks(q), chunks(k), chunks(v)))
    o = jnp.moveaxis(o, 0, 1).reshape(b, n, h, d)
    if reverse:
        o = jnp.flip(o, axis=1)
    return o.astype(dtype), s_fin


def diff_core(q, k, v, lam):
    s = jnp.einsum('bqhmd,bkhmd->bhmqk', q, k).astype(jnp.float32) * (DIFF_DIM ** -0.5)
    p = jax.nn.softmax(s, axis=-1)
    a = (p[:, :, 0] - lam * p[:, :, 1]).astype(v.dtype)
    return jnp.einsum('bhqk,bkhd->bqhd', a, v)


def diff_attention_latent(q, k, v, k_ctx, v_ctx, lam):
    b, n = q.shape[:2]
    keys = jnp.concatenate([k_ctx, k], axis=1)
    vals = jnp.concatenate([v_ctx, v], axis=1)
    qb = jnp.moveaxis(q.reshape((b, n // Q_BLOCK, Q_BLOCK) + q.shape[2:]), 1, 0)
    out = lax.map(lambda qi: diff_core(qi, keys, vals, lam), qb)
    return jnp.moveaxis(out, 0, 1).reshape((b, n) + v.shape[2:])


def diff_output(y, g, lam_init):
    y = head_rms(y) * g.astype(y.dtype) * (1.0 - lam_init)
    return y.reshape(y.shape[:2] + (-1,))


def swiglu(h, w1, w2):
    g, u = jnp.split(h @ w1, 2, axis=-1)
    return (jax.nn.silu(g) * u) @ w2


def setup_inputs(seed: int = 0) -> dict:
    key = jax.random.key(seed)
    ks = jax.random.split(key, 24)
    f32 = jnp.float32

    def nrm(k, shape, std):
        return jax.random.normal(k, shape, f32) * std

    gains = 1.0 + nrm(ks[6], (4, DEPTH, D_MODEL), 0.01)
    u = jax.random.uniform(ks[13], (DEPTH, 2, W_LRU), f32, 0.9, 0.999)
    gamma0 = 1.0 - 2.0 ** (-5.0 - jnp.arange(N_HEADS_RET, dtype=f32))
    return {
        'x': nrm(ks[0], (BATCH, SEQ, D_MODEL), 1.0),
        'c': nrm(ks[1], (BATCH, D_MODEL), 1.0),
        'ctx': nrm(ks[2], (BATCH, CTX_LEN, D_MODEL), 1.0),
        'c_ctx': nrm(ks[3], (D_MODEL,), 1.0),
        'w_mod': nrm(ks[4], (DEPTH, D_MODEL, 6 * D_MODEL), 0.5 * D_MODEL ** -0.5),
        'b_mod': nrm(ks[5], (DEPTH, 6 * D_MODEL), 0.01),
        'g_pre_mix': gains[0],
        'g_post_mix': gains[1],
        'g_pre_ffn': gains[2],
        'g_post_ffn': gains[3],
        'w_in': nrm(ks[7], (DEPTH, D_MODEL, IN_WIDTH), D_MODEL ** -0.5),
        'na_rpb': nrm(ks[8], (DEPTH, N_HEADS_NA, 2 * NA_WIN_ROWS - 1, 2 * NA_WIN_COLS - 1), 0.02),
        'lru_conv_w': nrm(ks[9], (DEPTH, LRU_CONV, W_LRU), LRU_CONV ** -0.5),
        'lru_conv_b': nrm(ks[10], (DEPTH, W_LRU), 0.01),
        'lru_gate_w': nrm(ks[11], (DEPTH, 2, 2, N_BLOCKS_LRU, LRU_BLOCK, LRU_BLOCK), LRU_BLOCK ** -0.5),
        'lru_gate_b': nrm(ks[12], (DEPTH, 2, 2, N_BLOCKS_LRU, LRU_BLOCK), 0.01),
        'lru_lambda': jnp.log(u) - jnp.log1p(-u),
        'ret_decay': (jnp.log(gamma0) - jnp.log1p(-gamma0)) + nrm(ks[14], (DEPTH, 2, N_HEADS_RET), 0.1),
        'diff_lambda': nrm(ks[15], (DEPTH, 4, DIFF_DIM), 0.1),
        'diff_subln': 1.0 + nrm(ks[16], (DEPTH, HEAD_DIM), 0.01),
        'w_out': nrm(ks[17], (DEPTH, MIX_WIDTH, D_MODEL), MIX_WIDTH ** -0.5),
        'w_ffn_in': nrm(ks[18], (DEPTH, D_MODEL, 2 * D_FF), D_MODEL ** -0.5),
        'w_ffn_out': nrm(ks[19], (DEPTH, D_FF, D_MODEL), D_FF ** -0.5),
    }


def reference(x, c, ctx, c_ctx, w_mod, b_mod, g_pre_mix, g_post_mix, g_pre_ffn, g_post_ffn,
              w_in, na_rpb, lru_conv_w, lru_conv_b, lru_gate_w, lru_gate_b, lru_lambda,
              ret_decay, diff_lambda, diff_subln, w_out, w_ffn_in, w_ffn_out):
    f32 = jnp.float32
    b, n_lat = x.shape[0], x.shape[1]
    rows = n_lat // GRID_W
    cos_r, sin_r = axial_rope(n_lat, HEAD_DIM)
    cos_d, sin_d = axial_rope(n_lat, DIFF_DIM)
    zeros_h = jnp.zeros((b, W_LRU), f32)
    zeros_s = jnp.zeros((b, N_HEADS_RET, HEAD_DIM, HEAD_DIM), f32)
    xl, xc = x, ctx
    for l in range(DEPTH):
        last = l == DEPTH - 1
        lam_init = 0.8 - 0.6 * math.exp(-0.3 * l)
        mod_l = jnp.split((jax.nn.silu(c) @ w_mod[l] + b_mod[l])[:, None, :], 6, axis=-1)
        mod_c = jnp.split(jax.nn.silu(c_ctx) @ w_mod[l] + b_mod[l], 6, axis=-1)

        hl = modulate(rms_norm(xl, g_pre_mix[l]), mod_l[0], mod_l[1])
        hc = modulate(rms_norm(xc, g_pre_mix[l]), mod_c[0], mod_c[1])
        pl = jnp.split(hl @ w_in[l], SPLIT_POINTS, axis=-1)
        pc = jnp.split(hc @ w_in[l], SPLIT_POINTS, axis=-1)

        qa_l, ka_l, va_l = (to_heads(t, N_HEADS_NA) for t in pl[0:3])
        qa_c, ka_c, va_c = (to_heads(t, N_HEADS_NA) for t in pc[0:3])
        ya_l = neighbourhood_attention(qa_l * NA_SCALE, ka_l, va_l, ka_c, va_c, na_rpb[l], rows)

        xb_c = depthwise_conv(pc[3], lru_conv_w[l], lru_conv_b[l])
        hb_c, hf_last, hb_last = rglru_bidir(xb_c, lru_gate_w[l], lru_gate_b[l], lru_lambda[l], zeros_h, zeros_h)
        xb_l = depthwise_conv(pl[3], lru_conv_w[l], lru_conv_b[l])
        hb_l, _, _ = rglru_bidir(xb_l, lru_gate_w[l], lru_gate_b[l], lru_lambda[l], hf_last, hb_last)
        yb_l = hb_l * jax.nn.gelu(pl[4])

        log_g = jax.nn.log_sigmoid(ret_decay[l].astype(f32))
        qr_c = to_heads(pc[5], N_HEADS_RET)
        kr_c = to_heads(pc[6], N_HEADS_RET) * RET_SCALE
        vr_c = to_heads(pc[7], N_HEADS_RET)
        of_c, s_fwd = retention_scan(qr_c, kr_c, vr_c, log_g[0], zeros_s, True, False)
        ob_c, s_bwd = retention_scan(qr_c, kr_c, vr_c, log_g[1], zeros_s, False, True)
        qr_l = apply_rope(to_heads(pl[5], N_HEADS_RET), cos_r, sin_r)
        kr_l = apply_rope(to_heads(pl[6], N_HEADS_RET) * RET_SCALE, cos_r, sin_r)
        vr_l = to_heads(pl[7], N_HEADS_RET)
        of_l, _ = retention_scan(qr_l, kr_l, vr_l, log_g[0], s_fwd, True, False)
        ob_l, _ = retention_scan(qr_l, kr_l, vr_l, log_g[1], s_bwd, False, True)
        yc_l = (head_rms(of_l + ob_l) * jax.nn.silu(to_heads(pl[8], N_HEADS_RET))).reshape(b, n_lat, W_RET)

        lq1, lk1, lq2, lk2 = diff_lambda[l].astype(f32)
        lam = jnp.exp(jnp.sum(lq1 * lk1)) - jnp.exp(jnp.sum(lq2 * lk2)) + lam_init
        qd_c, kd_c = to_maps(pc[9]), to_maps(pc[10])
        vd_c = to_heads(pc[11], N_HEADS_DIFF)
        qd_l = apply_rope(to_maps(pl[9]), cos_d, sin_d)
        kd_l = apply_rope(to_maps(pl[10]), cos_d, sin_d)
        vd_l = to_heads(pl[11], N_HEADS_DIFF)
        yd_l = diff_output(diff_attention_latent(qd_l, kd_l, vd_l, kd_c, vd_c, lam), diff_subln[l], lam_init)

        y_l = jnp.concatenate([ya_l, yb_l, yc_l, yd_l], axis=-1) @ w_out[l]
        xl_mid = xl + mod_l[2] * rms_norm(y_l, g_post_mix[l])

        h2 = modulate(rms_norm(xl_mid, g_pre_ffn[l]), mod_l[3], mod_l[4])
        xl_new = xl_mid + mod_l[5] * rms_norm(swiglu(h2, w_ffn_in[l], w_ffn_out[l]), g_post_ffn[l])

        if not last:
            ya_c = softmax_attention(qa_c * NA_SCALE, ka_c, va_c)
            yb_c = hb_c * jax.nn.gelu(pc[4])
            yc_c = (head_rms(of_c + ob_c) * jax.nn.silu(to_heads(pc[8], N_HEADS_RET))).reshape(b, -1, W_RET)
            yd_c = diff_output(diff_core(qd_c, kd_c, vd_c, lam), diff_subln[l], lam_init)
            y_c = jnp.concatenate([ya_c, yb_c, yc_c, yd_c], axis=-1) @ w_out[l]
            xc_mid = xc + mod_c[2] * rms_norm(y_c, g_post_mix[l])
            h2c = modulate(rms_norm(xc_mid, g_pre_ffn[l]), mod_c[3], mod_c[4])
            xc = xc_mid + mod_c[5] * rms_norm(swiglu(h2c, w_ffn_in[l], w_ffn_out[l]), g_post_ffn[l])
        xl = xl_new
    return xl
```

```cpp
#include <hip/hip_runtime.h>
#include <cstdio>
#include <cstdint>
namespace pg8 {
#define PG8_LAS __attribute__((address_space(3)))
typedef unsigned short bf16_t;
typedef short bf16x8 __attribute__((ext_vector_type(8)));
typedef float f32x4 __attribute__((ext_vector_type(4)));
typedef unsigned u32x4 __attribute__((ext_vector_type(4)));
constexpr int BM = 256, BK = 64, HALF = 128, HTB = HALF * BK * 2  , STAGE_BYTES = 8 * HTB, NXCD = 8, WGM = 8;

__host__ __device__ __forceinline__ int lds_byte(int r, int c) { const int st = (r >> 4) * 2 + (c >> 5), rr = r & 15, cc = c & 31, ob = rr * 64 + cc * 2; return st * 1024 + (ob ^ (((ob >> 9) & 1) << 5)); }
__host__ __device__ __forceinline__ void stage_rc(int b, int& R, int& C) { const int st = b / 1024, sb = b % 1024, swz = sb ^ (((sb >> 9) & 1) << 5); R = (st >> 1) * 16 + swz / 64; C = (st & 1) * 32 + (swz % 64) / 2; }
__host__ __device__ __forceinline__ int perm32(int rho) { const int n = rho >> 4, i = rho & 15; return 8 * (i >> 2) + 4 * n + (i & 3); }

struct Unit { int pm, pn; };
struct Gemm { const bf16_t* A; const bf16_t* Bt; int M, N, K; };

struct StaticOrder {
    int nM, nN, nwg, G, c;
    __host__ __device__ void init(int M, int N, int G_, int c_) { nM = M / BM; nN = N / BM; nwg = nM * nN; G = G_; c = c_; }
    __host__ __device__ bool next(int i, Unit& u) const {
        const long L = (long)i * G + c; if (L >= nwg) return false;
        int wgid = (int)L; { const int q = nwg / NXCD, r = nwg % NXCD, xcd = wgid % NXCD, off = wgid / NXCD; wgid = (xcd < r ? xcd * (q + 1) : r * (q + 1) + (xcd - r) * q) + off; }
        const int nig = WGM * nN, gid = wgid / nig, fm = gid * WGM, gsz = (nM - fm) < WGM ? (nM - fm) : WGM;
        u.pm = fm + ((wgid % nig) % gsz); u.pn = (wgid % nig) / gsz; return true;
    }
    __device__ __forceinline__ void a_ready(const Unit&) const {}
    __device__ __forceinline__ void done(const Unit&) const {}
};

__device__ __forceinline__ unsigned cvt_pk_bf16(float lo, float hi) { unsigned r; asm volatile("v_cvt_pk_bf16_f32 %0, %1, %2" : "=v"(r) : "v"(lo), "v"(hi)); return r; }
typedef float f32x2 __attribute__((ext_vector_type(2)));
typedef unsigned u32x2 __attribute__((ext_vector_type(2)));
constexpr float LOG2E_F = 1.4426950408889634f;
struct EpiPlain {
    static constexpr bool PERM = true, AFTER_DRAIN = false;
    bf16_t* O; int ldc;
    __device__ __forceinline__ void operator()(const f32x4 (&acc)[2][2][4][2], const Unit& u, int wr, int wc, int fr, int fq) const {
        const int row0 = u.pm * BM + wr * 64 + fr, col0 = u.pn * BM + wc * 32 + 8 * fq;
#pragma unroll
        for (int ai = 0; ai < 2; ++ai)
#pragma unroll
            for (int m = 0; m < 4; ++m) { bf16_t* rowp = O + (size_t)(row0 + ai * HALF + m * 16) * ldc + col0;
#pragma unroll
                for (int bj = 0; bj < 2; ++bj) { const f32x4 v0 = acc[ai][bj][m][0], v1 = acc[ai][bj][m][1];
                    u32x4 w; w.x = cvt_pk_bf16(v0[0], v0[1]); w.y = cvt_pk_bf16(v0[2], v0[3]); w.z = cvt_pk_bf16(v1[0], v1[1]); w.w = cvt_pk_bf16(v1[2], v1[3]);
                    *(u32x4*)(rowp + bj * HALF) = w; } }
    }
};
struct EpiSwiGLU {
    static constexpr bool PERM = true, AFTER_DRAIN = false;
    bf16_t* O; int ldc;
    __device__ __forceinline__ static float silu_mul(float g, float uu) { return g * __builtin_amdgcn_rcpf(1.0f + __builtin_amdgcn_exp2f(-g * LOG2E_F)) * uu; }
    __device__ __forceinline__ void operator()(const f32x4 (&acc)[2][2][4][2], const Unit& u, int wr, int wc, int fr, int fq) const {
        const int row0 = u.pm * BM + wr * 64 + fr, col0 = u.pn * HALF + wc * 32 + 8 * fq;
#pragma unroll
        for (int ai = 0; ai < 2; ++ai)
#pragma unroll
            for (int m = 0; m < 4; ++m) { bf16_t* rowp = O + (size_t)(row0 + ai * HALF + m * 16) * ldc + col0;
                const f32x4 g0 = acc[ai][0][m][0], g1 = acc[ai][0][m][1], u0 = acc[ai][1][m][0], u1 = acc[ai][1][m][1];
                u32x4 w; w.x = cvt_pk_bf16(silu_mul(g0[0], u0[0]), silu_mul(g0[1], u0[1])); w.y = cvt_pk_bf16(silu_mul(g0[2], u0[2]), silu_mul(g0[3], u0[3]));
                w.z = cvt_pk_bf16(silu_mul(g1[0], u1[0]), silu_mul(g1[1], u1[1])); w.w = cvt_pk_bf16(silu_mul(g1[2], u1[2]), silu_mul(g1[3], u1[3]));
                *(u32x4*)rowp = w; }
    }
};
struct EpiInProj {
    static constexpr bool PERM = true, AFTER_DRAIN = false;
    bf16_t* P; const float* tabRc; const float* tabRs; const float* tabDc; const float* tabDs;
    __device__ __forceinline__ void operator()(const f32x4 (&acc)[2][2][4][2], const Unit& u, int wr, int wc, int fr, int fq) const {
        asm volatile("" : "+v"(fr), "+v"(fq));
        const int sec = u.pn; const bool isctx = u.pm >= 128;
        int tbase; size_t prow0;
        if (!isctx) { const int b = u.pm >> 5; tbase = (u.pm & 31) * 256; prow0 = (size_t)b * 8448 + 256 + tbase; }
        else { const int b = u.pm - 128; tbase = 0; prow0 = (size_t)b * 8448; }
        float sc = 1.0f;
        if (sec == 0) sc = 0.125f * LOG2E_F; else if (sec == 6) sc = 0.125f; else if (sec == 9) sc = 0.17677669529663687f * LOG2E_F;
        const int mode = (sec == 5 || sec == 6) ? 1 : ((sec == 9 || sec == 10) ? 2 : 0);
        const int rbase = wr * 64 + fr;
#pragma unroll
        for (int bj = 0; bj < 2; ++bj) {
            const int pcol = 128 * bj + 32 * wc + 8 * fq, hh = pcol >> 6, ph = pcol & 63;
            if (mode == 0) {
#pragma unroll
                for (int ai = 0; ai < 2; ++ai)
#pragma unroll
                    for (int m = 0; m < 4; ++m) { const int row = rbase + 128 * ai + 16 * m;
                        const f32x4 v0 = acc[ai][bj][m][0] * sc, v1 = acc[ai][bj][m][1] * sc;
                        u32x4 w; w.x = cvt_pk_bf16(v0[0], v0[1]); w.y = cvt_pk_bf16(v0[2], v0[3]); w.z = cvt_pk_bf16(v1[0], v1[1]); w.w = cvt_pk_bf16(v1[2], v1[3]);
                        *(u32x4*)(P + (prow0 + row) * 3072 + sec * 256 + pcol) = w; }
            } else {
                int G, jb, col1, col2, tw; bool userow; const float *tc, *ts;
                if (mode == 1) { G = ph >> 3; jb = (4 * G) & 15; userow = G < 4; col1 = sec * 256 + hh * 64 + 4 * G; col2 = col1 + 32; tw = 16; tc = tabRc; ts = tabRs; }
                else { const int mp = ph >> 5, pm_ = ph & 31; G = pm_ >> 3; jb = (4 * G) & 7; userow = G < 2; col1 = sec * 256 + hh * 64 + mp * 32 + 4 * G; col2 = col1 + 16; tw = 8; tc = tabDc; ts = tabDs; }
#pragma unroll
                for (int ai = 0; ai < 2; ++ai)
#pragma unroll
                    for (int m = 0; m < 4; ++m) { const int row = rbase + 128 * ai + 16 * m; const int t = tbase + row;
                        const int pos = userow ? (t >> 6) : (t & 63);
                        f32x4 c4 = (f32x4){1.f, 1.f, 1.f, 1.f}, s4 = (f32x4){0.f, 0.f, 0.f, 0.f};
                        if (!isctx) { c4 = *(const f32x4*)(tc + pos * tw + jb); s4 = *(const f32x4*)(ts + pos * tw + jb); }
                        const f32x4 x1 = acc[ai][bj][m][0] * sc, x2 = acc[ai][bj][m][1] * sc;
                        const f32x4 o1 = x1 * c4 - x2 * s4, o2 = x2 * c4 + x1 * s4;
                        u32x2 w1, w2; w1.x = cvt_pk_bf16(o1[0], o1[1]); w1.y = cvt_pk_bf16(o1[2], o1[3]); w2.x = cvt_pk_bf16(o2[0], o2[1]); w2.y = cvt_pk_bf16(o2[2], o2[3]);
                        bf16_t* rp = P + (prow0 + row) * 3072;
                        *(u32x2*)(rp + col1) = w1; *(u32x2*)(rp + col2) = w2; asm volatile("" ::: "memory"); }
            }
        }
    }
};
template <class Epi, class Sched, bool ALIGN_EPI = false, bool SP2 = false>
__device__ __forceinline__ void gemm_phase(PG8_LAS unsigned char* lds, const Gemm g, const Sched& S, const Epi& E) {
    int tid_ = threadIdx.x; asm volatile("" : "+v"(tid_)); const int tid = tid_, wid = __builtin_amdgcn_readfirstlane(tid >> 6), lane = tid & 63, wr = wid >> 2, wc = wid & 3, fr = lane & 15, fq = lane >> 4;
    const int K = g.K, nt = K / BK;
    unsigned voffA[2], voffB[2];
#pragma unroll
    for (int i = 0; i < 2; ++i) { int R, C; stage_rc(tid * 16 + i * 8192, R, C); const int Rb = Epi::PERM ? ((R & ~31) + perm32(R & 31)) : R;
        voffA[i] = (unsigned)(R * K + C) * 2u; voffB[i] = (unsigned)(Rb * K + C) * 2u; }
    const size_t kstep = (size_t)(BK * 2);
    const size_t hstep = (size_t)HALF * K * 2;
    const size_t tstep = 2 * hstep;
    const unsigned ldsw = (unsigned)wid * 1024u;
    const int aoff = lds_byte(wr * 64 + fr, fq * 8), boff = lds_byte(wc * 32 + fr, fq * 8);
#define PG8_SA(b, h) (((b) * 2 + (h)) * HTB)
#define PG8_SB(b, h) ((4 + (b) * 2 + (h)) * HTB)
#define PG8_STAGE(bufoff, gbase, voff) do { _Pragma("unroll") for (int _i = 0; _i < 2; ++_i) \
        __builtin_amdgcn_global_load_lds((const unsigned*)((const char*)(gbase) + (voff)[_i]), (PG8_LAS unsigned*)(lds + (bufoff) + ldsw + _i * 8192), 16, 0, 0); } while (0)
#define PG8_LDA(dst, b, h) do { _Pragma("unroll") for (int m = 0; m < 4; ++m) _Pragma("unroll") for (int k = 0; k < 2; ++k) dst[m][k] = *(const PG8_LAS bf16x8*)(lds + PG8_SA(b, h) + aoff + m * 2048 + k * 1024); } while (0)
#define PG8_LDB(dst, b, h) do { _Pragma("unroll") for (int n = 0; n < 2; ++n) _Pragma("unroll") for (int k = 0; k < 2; ++k) dst[n][k] = *(const PG8_LAS bf16x8*)(lds + PG8_SB(b, h) + boff + n * 2048 + k * 1024); } while (0)
#define PG8_MMA(ai, bj, At, Bt) do { __builtin_amdgcn_s_setprio(1); _Pragma("unroll") for (int m = 0; m < 4; ++m) _Pragma("unroll") for (int n = 0; n < 2; ++n) _Pragma("unroll") for (int k = 0; k < 2; ++k) \
        acc[ai][bj][m][n] = __builtin_amdgcn_mfma_f32_16x16x32_bf16(Bt[n][k], At[m][k], acc[ai][bj][m][n], 0, 0, 0); __builtin_amdgcn_s_setprio(0); } while (0)
#define PG8_WAIT_V(n) asm volatile("s_waitcnt vmcnt(" #n ")" ::: "memory")
#define PG8_WAIT_L(n) asm volatile("s_waitcnt lgkmcnt(" #n ")" ::: "memory")
#define PG8_BAR __builtin_amdgcn_s_barrier()
#define PG8_SCHED __builtin_amdgcn_sched_barrier(0)
    Unit cur, nxt; int ui = 0;
    if (!S.next(0, cur)) return;
    f32x4 acc[2][2][4][2];
#pragma unroll
    for (int a = 0; a < 2; ++a)
#pragma unroll
        for (int b = 0; b < 2; ++b)
#pragma unroll
            for (int m = 0; m < 4; ++m)
#pragma unroll
                for (int n = 0; n < 2; ++n) acc[a][b][m][n] = (f32x4){0.f, 0.f, 0.f, 0.f};
    bf16x8 At[4][2], B0[2][2], B1[2][2];
    const char* cA = (const char*)g.A + (size_t)cur.pm * tstep; const char* cB = (const char*)g.Bt + (size_t)cur.pn * tstep;
    S.a_ready(cur);
    if constexpr (SP2) {
        PG8_STAGE(PG8_SB(0, 0), cB, voffB); PG8_STAGE(PG8_SB(0, 1), cB + hstep, voffB); PG8_STAGE(PG8_SA(0, 0), cA, voffA); PG8_STAGE(PG8_SA(0, 1), cA + hstep, voffA);
        if (wr == 1) PG8_BAR;
        PG8_WAIT_V(2); PG8_BAR;
        PG8_STAGE(PG8_SB(1, 0), cB + kstep, voffB); PG8_STAGE(PG8_SA(1, 0), cA + kstep, voffA); PG8_STAGE(PG8_SB(1, 1), cB + hstep + kstep, voffB);
        PG8_WAIT_V(6); PG8_BAR;
    } else {
        PG8_STAGE(PG8_SB(0, 0), cB, voffB); PG8_STAGE(PG8_SA(0, 0), cA, voffA); PG8_STAGE(PG8_SB(0, 1), cB + hstep, voffB); PG8_STAGE(PG8_SA(0, 1), cA + hstep, voffA);
        if (wr == 1) PG8_BAR;
        PG8_WAIT_V(4); PG8_BAR;
        PG8_STAGE(PG8_SB(1, 0), cB + kstep, voffB); PG8_STAGE(PG8_SA(1, 0), cA + kstep, voffA); PG8_STAGE(PG8_SB(1, 1), cB + hstep + kstep, voffB);
        PG8_WAIT_V(6); PG8_BAR;
    }
    for (;;) {
        const bool has_next = S.next(ui + 1, nxt);
        const char* nA = has_next ? (const char*)g.A + (size_t)nxt.pm * tstep : cA; const char* nB = has_next ? (const char*)g.Bt + (size_t)nxt.pn * tstep : cB;
        for (int t = 0; t < nt; t += 2) {
            const bool last = (t == nt - 2);
            const char* a1 = cA + (size_t)(t + 1) * kstep;
            const char* a2 = last ? nA : cA + (size_t)(t + 2) * kstep; const char* b2 = last ? nB : cB + (size_t)(t + 2) * kstep;
            const char* a3 = a2 + kstep; const char* b3 = b2 + kstep;
            if (last && has_next) S.a_ready(nxt);
            if constexpr (SP2) {
            PG8_LDB(B0, 0, 0); PG8_LDB(B1, 0, 1); PG8_SCHED; PG8_LDA(At, 0, 0); PG8_STAGE(PG8_SA(1, 1), a1 + hstep, voffA);
            PG8_WAIT_V(8); PG8_WAIT_L(0); PG8_BAR; PG8_MMA(0, 0, At, B0); PG8_MMA(0, 1, At, B1); PG8_BAR; PG8_SCHED;
            PG8_LDA(At, 0, 1); PG8_STAGE(PG8_SB(0, 0), b2, voffB); PG8_STAGE(PG8_SB(0, 1), b2 + hstep, voffB); PG8_STAGE(PG8_SA(0, 0), a2, voffA);
            PG8_WAIT_V(8); PG8_WAIT_L(0); PG8_BAR; PG8_MMA(1, 0, At, B0); PG8_MMA(1, 1, At, B1); PG8_BAR; PG8_SCHED;
            PG8_LDB(B0, 1, 0); PG8_LDB(B1, 1, 1); PG8_SCHED; PG8_LDA(At, 1, 0); PG8_STAGE(PG8_SA(0, 1), a2 + hstep, voffA);
            PG8_WAIT_V(8); PG8_WAIT_L(0); PG8_BAR; PG8_MMA(0, 0, At, B0); PG8_MMA(0, 1, At, B1); PG8_BAR; PG8_SCHED;
            PG8_LDA(At, 1, 1); PG8_STAGE(PG8_SB(1, 0), b3, voffB); PG8_STAGE(PG8_SB(1, 1), b3 + hstep, voffB); PG8_STAGE(PG8_SA(1, 0), a3, voffA);
            PG8_WAIT_V(8); PG8_WAIT_L(0); PG8_BAR; PG8_MMA(1, 0, At, B0); PG8_MMA(1, 1, At, B1); PG8_BAR; PG8_SCHED;
            } else {
            PG8_LDB(B0, 0, 0); PG8_SCHED; PG8_LDA(At, 0, 0); PG8_STAGE(PG8_SA(1, 1), a1 + hstep, voffA);
            PG8_WAIT_L(8); PG8_BAR; PG8_WAIT_L(0); PG8_MMA(0, 0, At, B0); PG8_BAR; PG8_SCHED;
            PG8_LDB(B1, 0, 1); PG8_STAGE(PG8_SB(0, 0), b2, voffB);
            PG8_BAR; PG8_WAIT_L(0); PG8_MMA(0, 1, At, B1); PG8_BAR;
            PG8_LDA(At, 0, 1); PG8_STAGE(PG8_SA(0, 0), a2, voffA);
            PG8_BAR; PG8_WAIT_L(0); PG8_MMA(1, 0, At, B0); PG8_BAR; PG8_SCHED;
            PG8_STAGE(PG8_SB(0, 1), b2 + hstep, voffB);
            PG8_WAIT_V(6); PG8_BAR; PG8_MMA(1, 1, At, B1); PG8_BAR;
            PG8_LDB(B0, 1, 0); PG8_SCHED; PG8_LDA(At, 1, 0); PG8_STAGE(PG8_SA(0, 1), a2 + hstep, voffA);
            PG8_WAIT_L(8); PG8_BAR; PG8_WAIT_L(0); PG8_MMA(0, 0, At, B0); PG8_BAR; PG8_SCHED;
            PG8_LDB(B1, 1, 1); PG8_STAGE(PG8_SB(1, 0), b3, voffB);
            PG8_BAR; PG8_WAIT_L(0); PG8_MMA(0, 1, At, B1); PG8_BAR;
            PG8_LDA(At, 1, 1); PG8_STAGE(PG8_SA(1, 0), a3, voffA);
            PG8_BAR; PG8_WAIT_L(0); PG8_MMA(1, 0, At, B0); PG8_BAR; PG8_SCHED;
            PG8_STAGE(PG8_SB(1, 1), b3 + hstep, voffB);
            PG8_WAIT_V(6); PG8_BAR; PG8_MMA(1, 1, At, B1); PG8_BAR;
            }
        }
        if constexpr (ALIGN_EPI) { if (wr == 0) PG8_BAR; }
        if constexpr (!Epi::AFTER_DRAIN) { E(acc, cur, wr, wc, fr, fq); S.done(cur); }
        if (!has_next) break;
#pragma unroll
        for (int a = 0; a < 2; ++a)
#pragma unroll
            for (int b = 0; b < 2; ++b)
#pragma unroll
                for (int m = 0; m < 4; ++m)
#pragma unroll
                    for (int n = 0; n < 2; ++n) acc[a][b][m][n] = (f32x4){0.f, 0.f, 0.f, 0.f};
        cur = nxt; cA = nA; cB = nB; ++ui;
        if constexpr (ALIGN_EPI) { if (wr == 1) PG8_BAR; }
    }
    PG8_WAIT_V(0);
    if constexpr (!ALIGN_EPI) { if (wr == 0) PG8_BAR; }
    PG8_BAR;
    if constexpr (Epi::AFTER_DRAIN) { E.fused(acc, cur, wr, wc, fr, fq, lds, wid, lane); S.done(cur); }
#undef PG8_SA
#undef PG8_SB
#undef PG8_STAGE
#undef PG8_LDA
#undef PG8_LDB
#undef PG8_MMA
#undef PG8_WAIT_V
#undef PG8_WAIT_L
#undef PG8_BAR
#undef PG8_SCHED
}
}
#define GAS __attribute__((address_space(1)))
#define LAS __attribute__((address_space(3)))
typedef unsigned short bf16;
typedef unsigned v4u __attribute__((ext_vector_type(4)));
typedef float f32x4 __attribute__((ext_vector_type(4)));
typedef short bf16x8 __attribute__((ext_vector_type(8)));
typedef GAS unsigned gu32;
typedef GAS unsigned long long gu64;
#define RLX_AGENT __ATOMIC_RELAXED, __HIP_MEMORY_SCOPE_AGENT
#define LDS_WAIT() asm volatile("s_waitcnt lgkmcnt(0)" ::: "memory")
#define VM_WAIT() asm volatile("s_waitcnt vmcnt(0)" ::: "memory")
__device__ __forceinline__ unsigned long long rt() { return __builtin_amdgcn_s_memrealtime(); }
__device__ __forceinline__ unsigned f2bf(float f) { unsigned u = __builtin_bit_cast(unsigned, f); return (u + 0x7fffu + ((u >> 16) & 1u)) >> 16; }

#define XB_TMO      128
#define XB_XCNT(j)  (256  + 64 * (j))
#define XB_XSUB(j)  (1280 + 64 * (j))
#define XB_XGEN(j)  (2304 + 64 * (j))
#define XB_TOP      3328
#define XB_TOPGEN   3392
#define XCD_BAR_WORDS 3456
#define XB_SPIN_CAP (1u << 22)

__device__ __forceinline__ unsigned xb_ld(unsigned* p)              { return __hip_atomic_load(p, __ATOMIC_RELAXED, __HIP_MEMORY_SCOPE_AGENT); }
__device__ __forceinline__ unsigned xb_add(unsigned* p, unsigned v) { return __hip_atomic_fetch_add(p, v, __ATOMIC_RELAXED, __HIP_MEMORY_SCOPE_AGENT); }
__device__ __forceinline__ unsigned xb_xcc_id() { return (unsigned)__builtin_amdgcn_s_getreg((3 << 11) | 20) & 0xFu; }
#define XB_SPIN(cond, bar) do { unsigned _sp = 0; while (cond) { __builtin_amdgcn_s_sleep(1); \
    if ((++_sp & 255u) == 0u) { if (xb_ld(&(bar)[XB_TMO])) break; if (_sp > XB_SPIN_CAP) { atomicAdd(&(bar)[XB_TMO], 1u); break; } } } } while (0)

struct XcdBarrier {
    unsigned* bar; unsigned x;
    volatile LAS unsigned* st;
};

__device__ __forceinline__ XcdBarrier xcd_barrier_post(unsigned* bar, volatile LAS unsigned* st) {
    XcdBarrier b; b.bar = bar; b.x = xb_xcc_id(); b.st = st;
    if (threadIdx.x == 0) (void)xb_add(&bar[XB_XCNT(b.x)], 1u);
    return b;
}
__device__ __forceinline__ void xcd_barrier_complete(unsigned* bar, unsigned x, unsigned& nloc, unsigned& nx) {
    const unsigned G = gridDim.x * gridDim.y * gridDim.z;
    unsigned sum, cnt, mine, sp = 0u;
    for (;;) {
        sum = 0u; cnt = 0u; mine = 0u;
#pragma unroll
        for (unsigned j = 0; j < 16; ++j) { const unsigned c = xb_ld(&bar[XB_XCNT(j)]); sum += c; cnt += (c > 0u) ? 1u : 0u; mine = (j == x) ? c : mine; }
        if (sum == G) break;
        __builtin_amdgcn_s_sleep(1);
        if ((++sp & 255u) == 0u) { if (xb_ld(&bar[XB_TMO])) break; if (sp > XB_SPIN_CAP) { atomicAdd(&bar[XB_TMO], 1u); break; } }
    }
    nloc = mine > 0u ? mine : 1u; nx = cnt > 0u ? cnt : 1u;
}

__device__ __forceinline__ void xcd_barrier(const XcdBarrier& b) {
    asm volatile("s_waitcnt vmcnt(0)" ::: "memory");
    __syncthreads();
    if (threadIdx.x == 0) {
        unsigned* bar = b.bar;
        __builtin_amdgcn_s_waitcnt(0);
        unsigned nloc = b.st[0], nx = b.st[1];
        if (nloc == 0u) { xcd_barrier_complete(bar, b.x, nloc, nx); b.st[0] = nloc; b.st[1] = nx; }
        const unsigned old = xb_add(&bar[XB_XSUB(b.x)], 1u);
        const unsigned gen = old / nloc;
        if (old + 1u == (gen + 1u) * nloc) {
            __builtin_amdgcn_fence(__ATOMIC_RELEASE, "agent");
            asm volatile("s_waitcnt vmcnt(0)" ::: "memory");
            const unsigned og = xb_add(&bar[XB_TOP], 1u);
            const unsigned tg = og / nx;
            if (og + 1u == (tg + 1u) * nx) xb_add(&bar[XB_TOPGEN], 1u);
            else XB_SPIN(xb_ld(&bar[XB_TOPGEN]) == tg, bar);
            __builtin_amdgcn_fence(__ATOMIC_ACQUIRE, "agent");
            xb_add(&bar[XB_XGEN(b.x)], 1u);
            asm volatile("s_waitcnt vmcnt(0)" ::: "memory");
        } else {
            XB_SPIN(xb_ld(&bar[XB_XGEN(b.x)]) == gen, bar);
            __builtin_amdgcn_fence(__ATOMIC_ACQUIRE, "agent");
            asm volatile("s_waitcnt vmcnt(0)" ::: "memory");
        }
    }
    __syncthreads();
}
#ifndef DBG_PROBE
#define DBG_PROBE 0
#endif
#ifndef DBG_NOINTER
#define DBG_NOINTER 0
#endif
#ifndef DBG_LAYER
#define DBG_LAYER -1
#endif
#ifndef NAIVE_RET
#define NAIVE_RET 0
#endif
#ifndef NAIVE_LRU
#define NAIVE_LRU 0
#endif
constexpr int NB = 4, SEQ = 8192, DM = 1024, NCX = 256, NKEY = 8448, MLAT = 32768, MCTX = 1024, MALL = 33792, NIN = 3072, DFF = 2816;
constexpr float EPS = 1e-6f, LOG2E = 1.4426950408889634f;
constexpr int NWAVES = 8;
constexpr size_t MiB = 1u << 20, KiB = 1024;
constexpr size_t WS_CTL = 0, CTL_ZERO_BYTES = 1 * MiB;
constexpr size_t WS_WIN = 2 * MiB, WS_WOUT = 14 * MiB, WS_WF1 = 18 * MiB, WS_WF2 = 40 * MiB;
constexpr size_t SZ_WIN = 6 * MiB, SZ_WOUT = 2 * MiB, SZ_WF1 = 11 * MiB, SZ_WF2 = (size_t)1024 * 2816 * 2;
constexpr size_t WS_LRUW = 52 * MiB, SZ_LRUW = 128 * KiB;
constexpr size_t WS_MOD = 52 * MiB + 256 * KiB;
constexpr size_t WS_TAB = 52 * MiB + 512 * KiB;
constexpr size_t WS_LAM = 52 * MiB + 544 * KiB;
constexpr size_t WS_XC = 54 * MiB;
constexpr size_t WS_LSUM = 58 * MiB;
constexpr size_t WS_LCIN = 67 * MiB;
constexpr size_t WS_KVT = 72 * MiB;
constexpr size_t WS_SIN = 105 * MiB;
constexpr size_t WS_B = 122 * MiB;
constexpr size_t WS_A = 188 * MiB;
constexpr size_t WS_END = 386 * MiB;
constexpr int CW_BAR = 4096, CW_Q = 8192;
constexpr int RING_BYTES = 131072, LDSCTL_OFF = RING_BYTES, MISC_OFF = LDSCTL_OFF + 320, LDS_BYTES = 147456;

typedef unsigned u32x2 __attribute__((ext_vector_type(2)));
typedef float f32x16 __attribute__((ext_vector_type(16)));
typedef short s16x4 __attribute__((ext_vector_type(4)));
typedef short v4i16_t __attribute__((ext_vector_type(4)));
typedef float f32x2_t __attribute__((ext_vector_type(2))); typedef __bf16 bf16x2_t __attribute__((ext_vector_type(2)));

__device__ __forceinline__ unsigned pk2(float lo, float hi) { f32x2_t v = {lo, hi}; bf16x2_t b = __builtin_convertvector(v, bf16x2_t); return __builtin_bit_cast(unsigned, b); }
__device__ __forceinline__ float bf2f(unsigned short u) { return __builtin_bit_cast(float, (unsigned)u << 16); }
__device__ __forceinline__ float bflo(unsigned w) { return __builtin_bit_cast(float, w << 16); }
__device__ __forceinline__ float bfhi(unsigned w) { return __builtin_bit_cast(float, w & 0xffff0000u); }
__device__ __forceinline__ float wave_sum(float v) {
#pragma unroll
    for (int o = 1; o < 64; o <<= 1) v += __shfl_xor(v, o);
    return v;
}
__device__ __forceinline__ float ex2(float x) { return __builtin_amdgcn_exp2f(x); }
__device__ __forceinline__ float rcp(float x) { return __builtin_amdgcn_rcpf(x); }
__device__ __forceinline__ float sigmoidf_(float x) { return rcp(1.0f + ex2(-x * LOG2E)); }
__device__ __forceinline__ float gelu_tanh(float x) { const float z = 0.7978845608028654f * (x + 0.044715f * x * x * x); const float e = ex2(2.0f * LOG2E * z); const float th = 1.0f - 2.0f * rcp(1.0f + e); return 0.5f * x * (1.0f + th); }
__device__ __forceinline__ float swap_max(float v) { return fmaxf(v, __shfl_xor(v, 32)); }
__device__ __forceinline__ float swap_add(float v) { return v + __shfl_xor(v, 32); }
__device__ __forceinline__ int crow(int r, int hi) { return (r & 3) + 8 * (r >> 2) + 4 * hi; }
__device__ __forceinline__ s16x4 vtr(const LAS unsigned char* p) { return __builtin_bit_cast(s16x4, __builtin_amdgcn_ds_read_tr16_b64_v4i16((LAS v4i16_t*)p)); }
__device__ __forceinline__ bf16x8 mk8(s16x4 lo, s16x4 hi) { return (bf16x8){lo[0], lo[1], lo[2], lo[3], hi[0], hi[1], hi[2], hi[3]}; }
__device__ __forceinline__ bf16x8 pack8(float a0, float a1, float a2, float a3, float a4, float a5, float a6, float a7) {
    v4u w; w.x = pk2(a0, a1); w.y = pk2(a2, a3); w.z = pk2(a4, a5); w.w = pk2(a6, a7); return __builtin_bit_cast(bf16x8, w); }
#define MFMA32(a, b, c) __builtin_amdgcn_mfma_f32_32x32x16_bf16((a), (b), (c), 0, 0, 0)
#define MFMA16(a, b, c) __builtin_amdgcn_mfma_f32_16x16x32_bf16((a), (b), (c), 0, 0, 0)

struct Frame {
    LAS unsigned char* lds;
    int tid, lane, wave, vcu, G;
    const float* const __attribute__((address_space(4)))* kin; float* out; unsigned char* ws;
};
#define LAUNDER_IDS int tid_ = F.tid; asm volatile("" : "+v"(tid_)); int wid_ = F.wave; asm volatile("" : "+s"(wid_)); const int tid = tid_, lane = tid_ & 63, wid = wid_; (void)tid; (void)lane; (void)wid; const float* const __attribute__((address_space(4)))* kin_ = F.kin; asm volatile("" : "+s"(kin_));
#define FIN(i) (kin_[i])
#define IN_X 0
#define IN_C 1
#define IN_CTX 2
#define IN_CCTX 3
#define IN_WMOD 4
#define IN_BMOD 5
#define IN_GPREMIX 6
#define IN_GPOSTMIX 7
#define IN_GPREFFN 8
#define IN_GPOSTFFN 9
#define IN_WIN 10
#define IN_RPB 11
#define IN_CONVW 12
#define IN_CONVB 13
#define IN_GATEW 14
#define IN_GATEB 15
#define IN_LRULAM 16
#define IN_RETDECAY 17
#define IN_DIFFLAM 18
#define IN_SUBLN 19
#define IN_WOUT 20
#define IN_WF1 21
#define IN_WF2 22

__device__ __forceinline__ int perm_in(int n) {
    const int sec = n >> 8, p = n & 255, hh = p >> 6, ph = p & 63;
    if (sec == 5 || sec == 6) { const int G = ph >> 3, j = ph & 7; return sec * 256 + hh * 64 + ((j < 4) ? 4 * G + j : 32 + 4 * G + (j - 4)); }
    if (sec == 9 || sec == 10) { const int mp = ph >> 5, pm = ph & 31, G = pm >> 3, j = pm & 7; return sec * 256 + hh * 64 + mp * 32 + ((j < 4) ? 4 * G + j : 16 + 4 * G + (j - 4)); }
    return n;
}
__device__ __forceinline__ int perm_f1(int n) { const int pn = n >> 8, half = (n >> 7) & 1, i = n & 127; return half * 2816 + pn * 128 + i; }
template <int MAP> __device__ __forceinline__ void p0_transpose_item(const float* W, int K, int N, bf16* WT, LAS float* scr, int item, int lane) {
    const int nblk = N / 32, kb = item / nblk, nb = item % nblk, k0 = 64 * kb, n0 = 32 * nb;
    const int nphys = n0 + (lane & 31);
    const int nsrc = (MAP == 1) ? perm_in(nphys) : ((MAP == 2) ? perm_f1(nphys) : nphys);
#pragma unroll 8
    for (int i = 0; i < 32; ++i) { const int kk = 2 * i + (lane >> 5); scr[kk * 33 + (lane & 31)] = W[(size_t)(k0 + kk) * N + nsrc]; }
    LDS_WAIT(); asm volatile("" ::: "memory");
    const int c = lane & 7;
#pragma unroll
    for (int j = 0; j < 4; ++j) { const int n = (lane >> 3) + 8 * j; const LAS float* s = scr + (8 * c) * 33 + n;
        v4u o; o.x = pk2(s[0 * 33], s[1 * 33]); o.y = pk2(s[2 * 33], s[3 * 33]); o.z = pk2(s[4 * 33], s[5 * 33]); o.w = pk2(s[6 * 33], s[7 * 33]);
        *(GAS v4u*)(WT + (size_t)(n0 + n) * K + k0 + 8 * c) = o; }
    LDS_WAIT(); asm volatile("" ::: "memory");
}
__device__ __forceinline__ void p0a(Frame& F) {
    LAUNDER_IDS
    if ((int)blockIdx.x < 192) {
        LAS float* sc = (LAS float*)F.lds; LAS float* red = (LAS float*)(F.lds + 20480);
        for (int i = tid; i < 5120; i += 512) { const float v = (i < 4096) ? FIN(IN_C)[i] : FIN(IN_CCTX)[i - 4096]; sc[i] = v * sigmoidf_(v); }
        __syncthreads();
        for (int item = blockIdx.x; item < 192; item += F.G) {
            const int l = item / 96, cg = item % 96, cl = tid & 63, ks = tid >> 6;
            const float* wm = FIN(IN_WMOD) + (size_t)l * 1024 * 6144 + cg * 64 + cl;
            float a0 = 0.f, a1 = 0.f, a2 = 0.f, a3 = 0.f, a4 = 0.f;
#pragma unroll 8
            for (int k = ks * 128; k < ks * 128 + 128; ++k) { const float w = wm[(size_t)k * 6144]; a0 += sc[k] * w; a1 += sc[1024 + k] * w; a2 += sc[2048 + k] * w; a3 += sc[3072 + k] * w; a4 += sc[4096 + k] * w; }
            red[(ks * 5 + 0) * 64 + cl] = a0; red[(ks * 5 + 1) * 64 + cl] = a1; red[(ks * 5 + 2) * 64 + cl] = a2; red[(ks * 5 + 3) * 64 + cl] = a3; red[(ks * 5 + 4) * 64 + cl] = a4;
            __syncthreads();
            if (tid < 320) { const int s = tid >> 6; float sum = 0.f;
#pragma unroll
                for (int k2 = 0; k2 < 8; ++k2) sum += red[(k2 * 5 + s) * 64 + cl];
                ((float*)(F.ws + WS_MOD))[(size_t)(l * 5 + s) * 6144 + cg * 64 + cl] = sum + FIN(IN_BMOD)[l * 6144 + cg * 64 + cl]; }
            __syncthreads();
        }
    }
    if ((int)blockIdx.x == F.G - 1) {
        if (tid < 16) {
            double th = 1.0; for (int i = 0; i < tid; ++i) th *= 0.5623413251903491;
            const double t2 = th * th; double s = 1.0, c = 1.0;
            for (int n = 14; n >= 1; --n) { s = 1.0 - s * t2 / (double)((2 * n) * (2 * n + 1)); c = 1.0 - c * t2 / (double)((2 * n - 1) * (2 * n)); }
            s *= th;
            float* Rc = (float*)(F.ws + WS_TAB); float* Rs = Rc + 2048; float* Dc = Rs + 2048; float* Ds = Dc + 1024;
            double cp = 1.0, sp = 0.0;
            for (int p = 0; p < 128; ++p) { Rc[p * 16 + tid] = (float)cp; Rs[p * 16 + tid] = (float)sp;
                if ((tid & 1) == 0) { Dc[p * 8 + (tid >> 1)] = (float)cp; Ds[p * 8 + (tid >> 1)] = (float)sp; }
                const double cn = cp * c - sp * s, sn = sp * c + cp * s; cp = cn; sp = sn; }
        }
        if (tid >= 64 && tid < 66) { const int l = tid - 64; const float* dl = FIN(IN_DIFFLAM) + l * 128; float d1 = 0.f, d2 = 0.f;
            for (int i = 0; i < 32; ++i) { d1 += dl[i] * dl[32 + i]; d2 += dl[64 + i] * dl[96 + i]; }
            const float lam_init = (l == 0) ? 0.2f : 0.35550906759f;
            ((float*)(F.ws + WS_LAM))[l] = expf(d1) - expf(d2) + lam_init; }
    }
    for (int idx = F.vcu * 512 + tid; idx < 131072; idx += F.G * 512) { const int c = idx & 63, d = (idx >> 6) & 63, rest = idx >> 12;
        ((bf16*)(F.ws + WS_LRUW))[idx] = (bf16)f2bf(FIN(IN_GATEW)[(size_t)rest * 4096 + c * 64 + d]); }
    __syncthreads();
    LAS float* scr = (LAS float*)(F.lds + wid * 16384);
    const int gw = F.vcu * NWAVES + wid, NGW = F.G * NWAVES;
    constexpr int I_IN = 16 * 96, I_OUT = 16 * 32, I_F1 = 16 * 176, I_F2 = 44 * 32, I_L = I_IN + I_OUT + I_F1 + I_F2;
    for (int it = gw; it < 2 * I_L; it += NGW) {
        const int l = it / I_L; int r = it % I_L;
        if (r < I_IN) { p0_transpose_item<1>(FIN(IN_WIN) + (size_t)l * 1024 * 3072, 1024, 3072, (bf16*)(F.ws + WS_WIN + l * SZ_WIN), scr, r, lane); continue; } r -= I_IN;
        if (r < I_OUT) { p0_transpose_item<0>(FIN(IN_WOUT) + (size_t)l * 1024 * 1024, 1024, 1024, (bf16*)(F.ws + WS_WOUT + l * SZ_WOUT), scr, r, lane); continue; } r -= I_OUT;
        if (r < I_F1) { p0_transpose_item<2>(FIN(IN_WF1) + (size_t)l * 1024 * 5632, 1024, 5632, (bf16*)(F.ws + WS_WF1 + l * SZ_WF1), scr, r, lane); continue; } r -= I_F1;
        p0_transpose_item<0>(FIN(IN_WF2) + (size_t)l * 2816 * 1024, 2816, 1024, (bf16*)(F.ws + WS_WF2 + l * SZ_WF2), scr, r, lane);
    }
}

__device__ __forceinline__ void ld_row_f32(const float* row, int lane, f32x4 (&v)[4]) {
#pragma unroll
    for (int j = 0; j < 4; ++j) v[j] = *(const f32x4*)(row + 4 * lane + 256 * j);
}
__device__ __forceinline__ void ld_row_bf16(const bf16* row, int lane, f32x4 (&v)[4]) {
#pragma unroll
    for (int j = 0; j < 4; ++j) { const u32x2 w = *(const u32x2*)(row + 4 * lane + 256 * j); v[j] = (f32x4){bflo(w.x), bfhi(w.x), bflo(w.y), bfhi(w.y)}; }
}
__device__ __forceinline__ float row_rstd(const f32x4 (&v)[4]) {
    float s = 0.f;
#pragma unroll
    for (int j = 0; j < 4; ++j) s += (v[j].x * v[j].x + v[j].y * v[j].y) + (v[j].z * v[j].z + v[j].w * v[j].w);
    return 1.0f / sqrtf(wave_sum(s) * (1.0f / 1024.0f) + EPS);
}
__device__ __forceinline__ void st_modulated(bf16* orow, int lane, const f32x4 (&v)[4], float rstd, const float* g, const float* shift, const float* scale) {
#pragma unroll
    for (int j = 0; j < 4; ++j) { const int c = 4 * lane + 256 * j; const f32x4 gg = *(const f32x4*)(g + c), sh = *(const f32x4*)(shift + c), scl = *(const f32x4*)(scale + c);
        const f32x4 o = v[j] * rstd * gg * (scl + 1.0f) + sh;
        u32x2 w; w.x = pk2(o.x, o.y); w.y = pk2(o.z, o.w); *(u32x2*)(orow + c) = w; }
}
__device__ __forceinline__ const float* mod_ptr(Frame& F, int l, int m) { const int slot = (m < MLAT) ? (m >> 13) : 4; return (const float*)(F.ws + WS_MOD) + (size_t)(l * 5 + slot) * 6144; }
__device__ __forceinline__ void p0b(Frame& F) {
    LAUNDER_IDS
    const int gw = F.vcu * NWAVES + wid, NGW = F.G * NWAVES;
    bf16* H = (bf16*)(F.ws + WS_B);
    for (int m = gw; m < MALL; m += NGW) {
        const float* xr = (m < MLAT) ? FIN(IN_X) + (size_t)m * DM : FIN(IN_CTX) + (size_t)(m - MLAT) * DM;
        f32x4 v[4]; ld_row_f32(xr, lane, v);
        const float rstd = row_rstd(v); const float* mp = mod_ptr(F, 0, m);
        st_modulated(H + (size_t)m * DM, lane, v, rstd, FIN(IN_GPREMIX), mp, mp + 1024);
    }
}
__device__ __forceinline__ void e2_phase(Frame& F, int l, int M) {
    LAUNDER_IDS
    const int gw = F.vcu * NWAVES + wid, NGW = F.G * NWAVES;
    const bf16* Y = (const bf16*)(F.ws + WS_A); bf16* H2 = (bf16*)(F.ws + WS_B); float* XC = (float*)(F.ws + WS_XC);
    for (int m = gw; m < M; m += NGW) {
        const float* xr; float* xo;
        if (m < MLAT) { xr = (l == 0) ? FIN(IN_X) + (size_t)m * DM : F.out + (size_t)m * DM; xo = F.out + (size_t)m * DM; }
        else { xr = FIN(IN_CTX) + (size_t)(m - MLAT) * DM; xo = XC + (size_t)(m - MLAT) * DM; }
        f32x4 y[4], x[4]; ld_row_bf16(Y + (size_t)m * DM, lane, y); ld_row_f32(xr, lane, x);
        const float rstd = row_rstd(y); const float* mp = mod_ptr(F, l, m); const float* gp = FIN(IN_GPOSTMIX) + l * 1024;
#pragma unroll
        for (int j = 0; j < 4; ++j) { const int c = 4 * lane + 256 * j; const f32x4 gg = *(const f32x4*)(gp + c), gate = *(const f32x4*)(mp + 2048 + c);
            x[j] = x[j] + gate * (y[j] * rstd * gg); *(f32x4*)(xo + c) = x[j]; }
        const float rstd2 = row_rstd(x);
        st_modulated(H2 + (size_t)m * DM, lane, x, rstd2, FIN(IN_GPREFFN) + l * 1024, mp + 3072, mp + 4096);
    }
}
__device__ __forceinline__ void e3_phase(Frame& F, int l, int M) {
    LAUNDER_IDS
    const int gw = F.vcu * NWAVES + wid, NGW = F.G * NWAVES;
    bf16* YB = (bf16*)(F.ws + WS_B); float* XC = (float*)(F.ws + WS_XC);
    for (int m = gw; m < M; m += NGW) {
        float* xo = (m < MLAT) ? F.out + (size_t)m * DM : XC + (size_t)(m - MLAT) * DM;
        f32x4 y[4], x[4]; ld_row_bf16(YB + (size_t)m * DM, lane, y); ld_row_f32(xo, lane, x);
        const float rstd = row_rstd(y); const float* mp = mod_ptr(F, l, m); const float* gp = FIN(IN_GPOSTFFN) + l * 1024;
#pragma unroll
        for (int j = 0; j < 4; ++j) { const int c = 4 * lane + 256 * j; const f32x4 gg = *(const f32x4*)(gp + c), gate = *(const f32x4*)(mp + 5120 + c);
            x[j] = x[j] + gate * (y[j] * rstd * gg); *(f32x4*)(xo + c) = x[j]; }
        if (l == 0) { const float rstd2 = row_rstd(x); const float* mp1 = mod_ptr(F, 1, m);
            st_modulated(YB + (size_t)m * DM, lane, x, rstd2, FIN(IN_GPREMIX) + 1024, mp1, mp1 + 1024); }
    }
}
constexpr int ATT_KB = 0, ATT_VB = 16384, ATT_BIAS = 32768;
template <int MODE> __device__ __forceinline__ void attn_unit(Frame& F, int l, int b, int h, int blk) {
    constexpr bool DIFF = (MODE == 0 || MODE == 2), LAT = (MODE < 2);
    constexpr int SQ = DIFF ? 9 : 0, SK = DIFF ? 10 : 1, SV = DIFF ? 11 : 2, NMAP = DIFF ? 2 : 1, NDS = DIFF ? 2 : 4;
    LAUNDER_IDS
    const int r32 = lane & 31, hi = lane >> 5;
    const bf16* P = (const bf16*)(F.ws + WS_A); bf16* Y = (bf16*)(F.ws + WS_B);
    LAS unsigned char* lds = F.lds;
    const int qtok = (LAT ? blk * 256 : 0) + wid * 32 + r32;
    const size_t qprow = (size_t)b * NKEY + (LAT ? 256 : 0) + qtok;
    const size_t ygrow = LAT ? (size_t)b * SEQ + qtok : (size_t)MLAT + b * 256 + qtok;
    int nt, nwin = 0, kr0 = 0;
    if (MODE == 0) nt = 132;
    else if (MODE == 1) { const int R = blk * 4; kr0 = min(max(R - 4, 0), 120); const int krl = min(max(R + 3 - 4, 0), 120) + 7; nwin = krl - kr0 + 1; nt = nwin + 4; }
    else nt = 4;
    const int qrow = blk * 4 + (wid >> 1), qcol = 32 * (wid & 1) + r32;
    const int r0q = min(max(qrow - 4, 0), 120), csq = min(max(qcol - 8, 0), 48);
    const int srow = tid >> 3, sch = tid & 7;
    const int koff = srow * 128 + ((sch ^ (srow & 7)) << 4);
    const int voff = (sch >> 2) * 4096 + (srow >> 3) * 512 + (srow & 7) * 64 + (sch & 3) * 16;
    const bf16* kvbase = P + (size_t)srow * NIN + h * 64 + sch * 8;
#define TILE_PROW(j) ((size_t)b * NKEY + ((MODE == 1) ? (((j) < nwin) ? 256 + (kr0 + (j)) * 64 : 64 * ((j) - nwin)) : 64 * (j)))
    bf16x8 qr[4];
#pragma unroll
    for (int d0 = 0; d0 < 4; ++d0) qr[d0] = *(const bf16x8*)(P + qprow * NIN + SQ * 256 + h * 64 + d0 * 16 + hi * 8);
    if (MODE == 1) { LAS float* bl = (LAS float*)(lds + ATT_BIAS); const float* rp = FIN(IN_RPB) + (size_t)(l * 4 + h) * 465;
        for (int i = tid; i < 480; i += 512) { const int dr = i >> 5, dc = i & 31; bl[i] = (dc < 31) ? rp[dr * 31 + dc] * LOG2E : 0.f; } }
    f32x16 o[NMAP][2]; float mrun[NMAP], lrun[NMAP];
#pragma unroll
    for (int mp = 0; mp < NMAP; ++mp) { mrun[mp] = -1e30f; lrun[mp] = 0.f;
#pragma unroll
        for (int d0 = 0; d0 < 2; ++d0)
#pragma unroll
            for (int r = 0; r < 16; ++r) o[mp][d0][r] = 0.f; }
    { const bf16* src = kvbase + TILE_PROW(0) * NIN; const v4u kk = *(const v4u*)(src + SK * 256), vv = *(const v4u*)(src + SV * 256);
      *(LAS v4u*)(lds + ATT_KB + koff) = kk; *(LAS v4u*)(lds + ATT_VB + voff) = vv; }
    __syncthreads();
    const int kfo = r32 * 128, ksw = r32 & 7;
    const int vb = ((lane >> 4) & 1) * 32 + (lane & 3) * 8 + (4 * hi + ((lane & 15) >> 2)) * 64;
    for (int j = 0; j < nt; ++j) {
        const int cur = j & 1;
        v4u kn, vn;
        if (j + 1 < nt) { const bf16* src = kvbase + TILE_PROW(j + 1) * NIN; kn = *(const v4u*)(src + SK * 256); vn = *(const v4u*)(src + SV * 256); }
        bool act = true;
        if (MODE == 1) { if (j < nwin) { const int d = kr0 + j - r0q; act = (d >= 0 && d < 8); } }
        if (act) {
            const LAS unsigned char* kb = lds + ATT_KB + cur * 8192; const LAS unsigned char* vbp = lds + ATT_VB + cur * 8192 + vb;
            bf16x8 vf[4][2];
#pragma unroll
            for (int ks = 0; ks < 4; ++ks)
#pragma unroll
                for (int d0 = 0; d0 < 2; ++d0) vf[ks][d0] = mk8(vtr(vbp + d0 * 4096 + ks * 1024), vtr(vbp + d0 * 4096 + ks * 1024 + 512));
#pragma unroll
            for (int mp = 0; mp < NMAP; ++mp) {
                f32x16 c0, c1;
#pragma unroll
                for (int r = 0; r < 16; ++r) { c0[r] = 0.f; c1[r] = 0.f; }
#pragma unroll
                for (int ds = 0; ds < NDS; ++ds) { const int dstep = mp * 2 + ds; const int chunk = 2 * dstep + hi;
                    const LAS unsigned char* kp = kb + kfo + ((chunk ^ ksw) << 4);
                    const bf16x8 k0 = *(const LAS bf16x8*)kp, k1 = *(const LAS bf16x8*)(kp + 4096);
                    c0 = MFMA32(k0, qr[dstep], c0); c1 = MFMA32(k1, qr[dstep], c1); }
                if (MODE == 1) { if (j < nwin) { const LAS float* bl = (const LAS float*)(lds + ATT_BIAS) + (kr0 + j - qrow + 7) * 32;
#pragma unroll
                    for (int r = 0; r < 16; ++r) { const int kc0 = (r & 3) + 8 * (r >> 2) + 4 * hi, kc1 = kc0 + 32;
                        const float b0 = bl[(kc0 - qcol + 15) & 31], b1 = bl[(kc1 - qcol + 15) & 31];
                        c0[r] = ((unsigned)(kc0 - csq) < 16u) ? c0[r] + b0 : -1e30f; c1[r] = ((unsigned)(kc1 - csq) < 16u) ? c1[r] + b1 : -1e30f; } } }
                float rm = fmaxf(c0[0], c1[0]);
#pragma unroll
                for (int r = 1; r < 16; ++r) rm = fmaxf(rm, fmaxf(c0[r], c1[r]));
                rm = swap_max(rm);
                if (__any(rm > mrun[mp] + 6.0f)) { const float mn = fmaxf(mrun[mp], rm), f = ex2(mrun[mp] - mn); mrun[mp] = mn; lrun[mp] *= f;
#pragma unroll
                    for (int r = 0; r < 16; ++r) { o[mp][0][r] *= f; o[mp][1][r] *= f; } }
                const float mm = mrun[mp]; float ps = 0.f;
#pragma unroll
                for (int r = 0; r < 16; ++r) { c0[r] = ex2(c0[r] - mm); c1[r] = ex2(c1[r] - mm); ps += c0[r] + c1[r]; }
                lrun[mp] += ps;
                const bf16x8 p0 = pack8(c0[0], c0[1], c0[2], c0[3], c0[4], c0[5], c0[6], c0[7]), p1 = pack8(c0[8], c0[9], c0[10], c0[11], c0[12], c0[13], c0[14], c0[15]);
                const bf16x8 p2 = pack8(c1[0], c1[1], c1[2], c1[3], c1[4], c1[5], c1[6], c1[7]), p3 = pack8(c1[8], c1[9], c1[10], c1[11], c1[12], c1[13], c1[14], c1[15]);
#pragma unroll
                for (int d0 = 0; d0 < 2; ++d0) { o[mp][d0] = MFMA32(vf[0][d0], p0, o[mp][d0]); o[mp][d0] = MFMA32(vf[1][d0], p1, o[mp][d0]); o[mp][d0] = MFMA32(vf[2][d0], p2, o[mp][d0]); o[mp][d0] = MFMA32(vf[3][d0], p3, o[mp][d0]); }
            }
        }
        if (j + 1 < nt) { *(LAS v4u*)(lds + ATT_KB + (cur ^ 1) * 8192 + koff) = kn; *(LAS v4u*)(lds + ATT_VB + (cur ^ 1) * 8192 + voff) = vn; }
        __syncthreads();
    }
#undef TILE_PROW
    if (DIFF) {
        const float lam = ((const float*)(F.ws + WS_LAM))[l]; const float omli = (l == 0) ? 0.8f : 0.64449093241f;
        const float i1 = 1.0f / swap_add(lrun[0]), i2 = lam / swap_add(lrun[NMAP - 1]);
        float ss = 0.f;
#pragma unroll
        for (int d0 = 0; d0 < 2; ++d0)
#pragma unroll
            for (int r = 0; r < 16; ++r) { const float y = o[0][d0][r] * i1 - o[NMAP - 1][d0][r] * i2; o[0][d0][r] = y; ss += y * y; }
        ss = swap_add(ss);
        const float rs = omli / sqrtf(ss * (1.0f / 64.0f) + EPS); const float* sg = FIN(IN_SUBLN) + l * 64;
#pragma unroll
        for (int d0 = 0; d0 < 2; ++d0)
#pragma unroll
            for (int rg = 0; rg < 4; ++rg) { const int dv = 32 * d0 + 8 * rg + 4 * hi; const f32x4 g4 = *(const f32x4*)(sg + dv);
                u32x2 w; w.x = pk2(o[0][d0][4 * rg] * rs * g4.x, o[0][d0][4 * rg + 1] * rs * g4.y); w.y = pk2(o[0][d0][4 * rg + 2] * rs * g4.z, o[0][d0][4 * rg + 3] * rs * g4.w);
                *(u32x2*)(Y + ygrow * DM + 768 + h * 64 + dv) = w; }
    } else {
        const float i1 = 1.0f / swap_add(lrun[0]);
#pragma unroll
        for (int d0 = 0; d0 < 2; ++d0)
#pragma unroll
            for (int rg = 0; rg < 4; ++rg) { const int dv = 32 * d0 + 8 * rg + 4 * hi;
                u32x2 w; w.x = pk2(o[0][d0][4 * rg] * i1, o[0][d0][4 * rg + 1] * i1); w.y = pk2(o[0][d0][4 * rg + 2] * i1, o[0][d0][4 * rg + 3] * i1);
                *(u32x2*)(Y + ygrow * DM + h * 64 + dv) = w; }
    }
}
constexpr int LRU_XB = 0, LRU_XB_PITCH = 528, LRU_XF = 16384, LRU_CW = 16384 + 16384;
template <bool FINAL> __device__ __forceinline__ void lru_unit(Frame& F, int l, int unit) {
    LAUNDER_IDS
    const int b = unit / 132, g = unit % 132; const bool isctx = g < 4;
    const int seqlen = isctx ? 256 : 8192, t0 = isctx ? 64 * g : 64 * (g - 4);
    const size_t prow0 = (size_t)b * NKEY + (isctx ? 0 : 256);
    const int gc0 = isctx ? 4 * g : 16 + 4 * (g - 4);
    const bf16* P = (const bf16*)(F.ws + WS_A); bf16* Y = (bf16*)(F.ws + WS_B);
    LAS unsigned char* lds = F.lds;
    LAS float* cwl = (LAS float*)(lds + LRU_CW);
    for (int i = tid; i < 1280; i += 512) cwl[i] = (i < 1024) ? FIN(IN_CONVW)[l * 1024 + i] : FIN(IN_CONVB)[l * 256 + (i - 1024)];
    const int kblk = wid >> 1, dp = wid & 1, d16 = lane & 15, tg = lane >> 4;
    const bf16* WG = (const bf16*)(F.ws + WS_LRUW) + (size_t)l * 65536;
    bf16x8 bw[2][2][2][2];
    float spv[2][2], brv[2][2], biv[2][2];
#pragma unroll
    for (int dir = 0; dir < 2; ++dir)
#pragma unroll
        for (int dtl = 0; dtl < 2; ++dtl) { const int dcol = 16 * (2 * dp + dtl) + d16, ch = kblk * 64 + dcol;
#pragma unroll
            for (int gt = 0; gt < 2; ++gt)
#pragma unroll
                for (int s = 0; s < 2; ++s) bw[dir][gt][dtl][s] = *(const bf16x8*)(WG + ((size_t)((dir * 2 + gt) * 4 + kblk) * 64 + dcol) * 64 + 32 * s + 8 * tg);
            const float lam = FIN(IN_LRULAM)[(l * 2 + dir) * 256 + ch];
            spv[dir][dtl] = log1pf(expf(-lam));
            brv[dir][dtl] = FIN(IN_GATEB)[((size_t)((l * 2 + dir) * 2 + 0) * 4 + kblk) * 64 + dcol];
            biv[dir][dtl] = FIN(IN_GATEB)[((size_t)((l * 2 + dir) * 2 + 1) * 4 + kblk) * 64 + dcol]; }
    __syncthreads();
    const int ct = tid >> 5, cg = tid & 31;
    for (int ci = 0; ci < 4; ++ci) {
        const int tc = t0 + 16 * ci;
        { const int t = tc + ct; float acc8[8];
#pragma unroll
          for (int e = 0; e < 8; ++e) acc8[e] = cwl[1024 + cg * 8 + e];
#pragma unroll
          for (int j = 0; j < 4; ++j) { const int tt = t + j - 1;
              if (tt >= 0 && tt < seqlen) { const v4u w = *(const v4u*)(P + (prow0 + tt) * NIN + 768 + cg * 8);
                  const LAS float* cw = cwl + j * 256 + cg * 8;
                  acc8[0] += cw[0] * bflo(w.x); acc8[1] += cw[1] * bfhi(w.x); acc8[2] += cw[2] * bflo(w.y); acc8[3] += cw[3] * bfhi(w.y);
                  acc8[4] += cw[4] * bflo(w.z); acc8[5] += cw[5] * bfhi(w.z); acc8[6] += cw[6] * bflo(w.w); acc8[7] += cw[7] * bfhi(w.w); } }
          v4u o; o.x = pk2(acc8[0], acc8[1]); o.y = pk2(acc8[2], acc8[3]); o.z = pk2(acc8[4], acc8[5]); o.w = pk2(acc8[6], acc8[7]);
          *(LAS v4u*)(lds + LRU_XB + ct * LRU_XB_PITCH + cg * 16) = o;
          LAS float* xf = (LAS float*)(lds + LRU_XF) + ct * 256 + cg * 8;
          *(LAS f32x4*)xf = (f32x4){acc8[0], acc8[1], acc8[2], acc8[3]}; *(LAS f32x4*)(xf + 4) = (f32x4){acc8[4], acc8[5], acc8[6], acc8[7]}; }
        __syncthreads();
        bf16x8 af[2];
#pragma unroll
        for (int s = 0; s < 2; ++s) af[s] = *(const LAS bf16x8*)(lds + LRU_XB + d16 * LRU_XB_PITCH + (kblk * 64 + 32 * s + 8 * tg) * 2);
        const int gc = gc0 + ci;
        float hsum[2][4];
#pragma unroll
        for (int dtl = 0; dtl < 2; ++dtl)
#pragma unroll
            for (int r = 0; r < 4; ++r) hsum[dtl][r] = 0.f;
#pragma unroll
        for (int dir = 0; dir < 2; ++dir)
#pragma unroll
            for (int dtl = 0; dtl < 2; ++dtl) {
                const int ch = kblk * 64 + 16 * (2 * dp + dtl) + d16;
                f32x4 gr = (f32x4){0.f, 0.f, 0.f, 0.f}, gi = (f32x4){0.f, 0.f, 0.f, 0.f};
#pragma unroll
                for (int s = 0; s < 2; ++s) { gr = MFMA16(af[s], bw[dir][0][dtl][s], gr); gi = MFMA16(af[s], bw[dir][1][dtl][s], gi); }
                float a[4], u[4];
#pragma unroll
                for (int r = 0; r < 4; ++r) { const float rr = sigmoidf_(gr[r] + brv[dir][dtl]), ii = sigmoidf_(gi[r] + biv[dir][dtl]);
                    const float la = -8.0f * rr * spv[dir][dtl]; a[r] = expf(la);
                    const float xv = ((const LAS float*)(lds + LRU_XF))[(4 * tg + r) * 256 + ch];
                    u[r] = sqrtf(-expm1f(2.0f * la)) * (ii * xv); }
                float hl[4], pp[4];
                if (dir == 0) { pp[0] = a[0]; hl[0] = u[0];
#pragma unroll
                    for (int r = 1; r < 4; ++r) { pp[r] = a[r] * pp[r - 1]; hl[r] = a[r] * hl[r - 1] + u[r]; } }
                else { pp[3] = a[3]; hl[3] = u[3];
#pragma unroll
                    for (int r = 2; r >= 0; --r) { pp[r] = a[r] * pp[r + 1]; hl[r] = a[r] * hl[r + 1] + u[r]; } }
                const float Ag = (dir == 0) ? pp[3] : pp[0], Ug = (dir == 0) ? hl[3] : hl[0];
                float Aq[4], Uq[4];
#pragma unroll
                for (int q = 0; q < 4; ++q) { Aq[q] = __shfl(Ag, d16 + 16 * q); Uq[q] = __shfl(Ug, d16 + 16 * q); }
                if (!FINAL) {
                    float At = 1.f, Ut = 0.f;
                    if (dir == 0) {
#pragma unroll
                        for (int q = 0; q < 4; ++q) { Ut = Aq[q] * Ut + Uq[q]; At *= Aq[q]; } }
                    else {
#pragma unroll
                        for (int q = 3; q >= 0; --q) { Ut = Aq[q] * Ut + Uq[q]; At *= Aq[q]; } }
                    if (tg == 0) { f32x2_t v = {At, Ut}; *(f32x2_t*)((float*)(F.ws + WS_LSUM) + ((size_t)((b * 528 + gc) * 2 + dir) * 256 + ch) * 2) = v; }
                } else {
                    float c = ((const float*)(F.ws + WS_LCIN))[(size_t)((b * 528 + gc) * 2 + dir) * 256 + ch];
                    if (dir == 0) {
#pragma unroll
                        for (int q = 0; q < 3; ++q) c = (q < tg) ? Aq[q] * c + Uq[q] : c; }
                    else {
#pragma unroll
                        for (int q = 3; q >= 1; --q) c = (q > tg) ? Aq[q] * c + Uq[q] : c; }
#pragma unroll
                    for (int r = 0; r < 4; ++r) hsum[dtl][r] += hl[r] + pp[r] * c;
                }
            }
        if (FINAL) {
#pragma unroll
            for (int dtl = 0; dtl < 2; ++dtl) { const int ch = kblk * 64 + 16 * (2 * dp + dtl) + d16;
#pragma unroll
                for (int r = 0; r < 4; ++r) { const int t = tc + 4 * tg + r;
                    const float gv = bf2f(P[(prow0 + t) * NIN + 1024 + ch]);
                    const size_t grow = isctx ? (size_t)MLAT + b * 256 + t : (size_t)b * SEQ + t;
                    Y[grow * DM + 256 + ch] = (bf16)f2bf(hsum[dtl][r] * gelu_tanh(gv)); } }
        }
        __syncthreads();
    }
}

#ifndef DBG_NOINTER
#define DBG_NOINTER 0
#endif
__device__ __forceinline__ float ret_lg2(const float* rd, int l, int dir, int h) { const float x = rd[(l * 2 + dir) * 4 + h]; return -log1pf(expf(-x)) * LOG2E; }
__device__ __forceinline__ int tr_off(int token, int ch  ) { return (ch >> 2) * 8192 + (token >> 3) * 512 + (token & 7) * 64 + (ch & 3) * 16; }
__device__ __forceinline__ void ret_m1_unit(Frame& F, int l, int unit) {
    LAUNDER_IDS
    const int r32 = lane & 31, hi = lane >> 5;
    const int hp = unit & 1, cc = (unit >> 1) % 66, b = unit / 132;
    const bf16* P = (const bf16*)(F.ws + WS_A); LAS unsigned char* lds = F.lds;
    const size_t prow0 = (size_t)b * NKEY + 128 * cc;
    { const int hs = tid >> 8, tt = tid & 255, h = 2 * hp + hs;
      const float lgf = ret_lg2(FIN(IN_RETDECAY), l, 0, h), lgb = ret_lg2(FIN(IN_RETDECAY), l, 1, h);
      LAS unsigned char* base = lds + hs * 49152;
#pragma unroll
      for (int i = 0; i < 4; ++i) { const int idx = tt + 256 * i, row = idx >> 3, ch = idx & 7;
          const bf16* src = P + (prow0 + row) * NIN + h * 64 + ch * 8;
          const v4u kk = *(const v4u*)(src + 6 * 256), vv = *(const v4u*)(src + 7 * 256);
          const int off = tr_off(row, ch);
          *(LAS v4u*)(base + off) = vv;
          const float df = ex2((float)(127 - row) * lgf), db = ex2((float)row * lgb);
          v4u kf, kb2;
          kf.x = pk2(bflo(kk.x) * df, bfhi(kk.x) * df); kf.y = pk2(bflo(kk.y) * df, bfhi(kk.y) * df); kf.z = pk2(bflo(kk.z) * df, bfhi(kk.z) * df); kf.w = pk2(bflo(kk.w) * df, bfhi(kk.w) * df);
          kb2.x = pk2(bflo(kk.x) * db, bfhi(kk.x) * db); kb2.y = pk2(bflo(kk.y) * db, bfhi(kk.y) * db); kb2.z = pk2(bflo(kk.z) * db, bfhi(kk.z) * db); kb2.w = pk2(bflo(kk.w) * db, bfhi(kk.w) * db);
          *(LAS v4u*)(base + 16384 + off) = kf; *(LAS v4u*)(base + 32768 + off) = kb2; } }
    __syncthreads();
    { const int hs = wid >> 2, h = 2 * hp + hs, et = (wid >> 1) & 1, dt = wid & 1;
      const LAS unsigned char* base = lds + hs * 49152;
      const int vb = ((lane >> 4) & 1) * 32 + (lane & 3) * 8 + (4 * hi + ((lane & 15) >> 2)) * 64;
      f32x16 accf, accb;
#pragma unroll
      for (int r = 0; r < 16; ++r) { accf[r] = 0.f; accb[r] = 0.f; }
#pragma unroll
      for (int ks = 0; ks < 8; ++ks) {
          const bf16x8 va = mk8(vtr(base + et * 8192 + ks * 1024 + vb), vtr(base + et * 8192 + ks * 1024 + 512 + vb));
          const bf16x8 kf = mk8(vtr(base + 16384 + dt * 8192 + ks * 1024 + vb), vtr(base + 16384 + dt * 8192 + ks * 1024 + 512 + vb));
          const bf16x8 kb2 = mk8(vtr(base + 32768 + dt * 8192 + ks * 1024 + vb), vtr(base + 32768 + dt * 8192 + ks * 1024 + 512 + vb));
          accf = MFMA32(va, kf, accf); accb = MFMA32(va, kb2, accb); }
      float* KV = (float*)(F.ws + WS_KVT) + (size_t)(((b * 4 + h) * 66 + cc) * 2) * 4096;
#pragma unroll
      for (int r = 0; r < 16; ++r) { const int e = 32 * et + crow(r, hi), d = 32 * dt + r32; KV[e * 64 + d] = accf[r]; KV[4096 + e * 64 + d] = accb[r]; } }
    __syncthreads();
}
__device__ __forceinline__ void ret_m3_unit(Frame& F, int l, int unit) {
    LAUNDER_IDS
    const int r32 = lane & 31, hi = lane >> 5;
    const int hp = unit & 1, cc = (unit >> 1) % 66, b = unit / 132;
    const bf16* P = (const bf16*)(F.ws + WS_A); bf16* Y = (bf16*)(F.ws + WS_B); LAS unsigned char* lds = F.lds;
    const size_t prow0 = (size_t)b * NKEY + 128 * cc;
    { const int hs = tid >> 8, tt = tid & 255, h = 2 * hp + hs; LAS unsigned char* base = lds + hs * 32768;
#pragma unroll
      for (int i = 0; i < 4; ++i) { const int idx = tt + 256 * i, row = idx >> 3, ch = idx & 7;
          const bf16* src = P + (prow0 + row) * NIN + h * 64 + ch * 8;
          const v4u kk = *(const v4u*)(src + 6 * 256), vv = *(const v4u*)(src + 7 * 256);
          *(LAS v4u*)(base + row * 128 + ((ch ^ (row & 7)) << 4)) = kk; *(LAS v4u*)(base + 16384 + tr_off(row, ch)) = vv; } }
    const int hs = wid >> 2, h = 2 * hp + hs, qt = wid & 3;
    const int qi = 32 * qt + r32;
    bf16x8 qr[4];
#pragma unroll
    for (int d0 = 0; d0 < 4; ++d0) qr[d0] = *(const bf16x8*)(P + (prow0 + qi) * NIN + 5 * 256 + h * 64 + d0 * 16 + hi * 8);
    const float lgf = ret_lg2(FIN(IN_RETDECAY), l, 0, h), lgb = ret_lg2(FIN(IN_RETDECAY), l, 1, h);
    __syncthreads();
    const LAS unsigned char* base = lds + hs * 32768;
    const int vb = ((lane >> 4) & 1) * 32 + (lane & 3) * 8 + (4 * hi + ((lane & 15) >> 2)) * 64;
    f32x16 o[2];
#pragma unroll
    for (int r = 0; r < 16; ++r) { o[0][r] = 0.f; o[1][r] = 0.f; }
#pragma unroll
    for (int kt = 0; kt < 4; ++kt) {
        f32x16 c;
#pragma unroll
        for (int r = 0; r < 16; ++r) c[r] = 0.f;
#pragma unroll
        for (int ds = 0; ds < 4; ++ds) { const int key = 32 * kt + r32, chunk = 2 * ds + hi;
            const bf16x8 kf = *(const LAS bf16x8*)(base + key * 128 + ((chunk ^ (key & 7)) << 4));
            c = MFMA32(kf, qr[ds], c); }
#pragma unroll
        for (int r = 0; r < 16; ++r) { const int kj = 32 * kt + crow(r, hi); const int dd = qi - kj;
            const float e = (dd >= 0) ? (float)dd * lgf : (float)(-dd - 1) * lgb; c[r] *= ex2(e); }
        const bf16x8 p0 = pack8(c[0], c[1], c[2], c[3], c[4], c[5], c[6], c[7]), p1 = pack8(c[8], c[9], c[10], c[11], c[12], c[13], c[14], c[15]);
#pragma unroll
        for (int et = 0; et < 2; ++et) {
            const bf16x8 v0 = mk8(vtr(base + 16384 + et * 8192 + (2 * kt) * 1024 + vb), vtr(base + 16384 + et * 8192 + (2 * kt) * 1024 + 512 + vb));
            const bf16x8 v1 = mk8(vtr(base + 16384 + et * 8192 + (2 * kt + 1) * 1024 + vb), vtr(base + 16384 + et * 8192 + (2 * kt + 1) * 1024 + 512 + vb));
            o[et] = MFMA32(v0, p0, o[et]); o[et] = MFMA32(v1, p1, o[et]); }
    }
    { const bf16* SI = (const bf16*)(F.ws + WS_SIN) + (size_t)(((b * 4 + h) * 66 + cc) * 2) * 4096;
      const float df = ex2((float)(qi + 1) * lgf), db = ex2((float)(127 - qi) * lgb);
#pragma unroll
      for (int et = 0; et < 2; ++et) { f32x16 xf, xb;
#pragma unroll
          for (int r = 0; r < 16; ++r) { xf[r] = 0.f; xb[r] = 0.f; }
#pragma unroll
          for (int ds = 0; ds < 4; ++ds) { const bf16x8 sf = *(const bf16x8*)(SI + (32 * et + r32) * 64 + 16 * ds + 8 * hi), sb = *(const bf16x8*)(SI + 4096 + (32 * et + r32) * 64 + 16 * ds + 8 * hi);
              xf = MFMA32(sf, qr[ds], xf); xb = MFMA32(sb, qr[ds], xb); }
#pragma unroll
          for (int r = 0; r < 16; ++r) o[et][r] += DBG_NOINTER ? 0.f : df * xf[r] + db * xb[r]; } }
    float ss = 0.f;
#pragma unroll
    for (int et = 0; et < 2; ++et)
#pragma unroll
        for (int r = 0; r < 16; ++r) ss += o[et][r] * o[et][r];
    ss = swap_add(ss);
    const float rs = 1.0f / sqrtf(ss * (1.0f / 64.0f) + EPS);
    const size_t prow = prow0 + qi;
    const size_t grow = (cc < 2) ? (size_t)MLAT + b * 256 + 128 * cc + qi : (size_t)b * SEQ + 128 * (cc - 2) + qi;
#pragma unroll
    for (int et = 0; et < 2; ++et)
#pragma unroll
        for (int rg = 0; rg < 4; ++rg) { const int e = 32 * et + 8 * rg + 4 * hi;
            const u32x2 gw = *(const u32x2*)(P + prow * NIN + 8 * 256 + h * 64 + e);
            const float g0 = bflo(gw.x), g1 = bfhi(gw.x), g2 = bflo(gw.y), g3 = bfhi(gw.y);
            u32x2 w; w.x = pk2(o[et][4 * rg] * rs * (g0 * sigmoidf_(g0)), o[et][4 * rg + 1] * rs * (g1 * sigmoidf_(g1)));
            w.y = pk2(o[et][4 * rg + 2] * rs * (g2 * sigmoidf_(g2)), o[et][4 * rg + 3] * rs * (g3 * sigmoidf_(g3)));
            *(u32x2*)(Y + grow * DM + 512 + h * 64 + e) = w; }
    __syncthreads();
}

__device__ __forceinline__ void m2_phase(Frame& F, int l) {
    LAUNDER_IDS
    for (int item = blockIdx.x; item < 64; item += F.G) {
        const int seg = tid >> 5, ci = tid & 31, chain = item * 32 + ci, b = chain >> 9, dir = (chain >> 8) & 1, ch = chain & 255;
        const float* SUM = (const float*)(F.ws + WS_LSUM); float* CIN = (float*)(F.ws + WS_LCIN);
        LAS float* sA = (LAS float*)F.lds; LAS float* sU = sA + 512;
        float A[33], U[33];
#pragma unroll
        for (int i = 0; i < 33; ++i) { const int pos = seg * 33 + i; const int gc = (dir == 0) ? pos : ((pos < 16) ? 15 - pos : 543 - pos);
            const f32x2_t v = *(const f32x2_t*)(SUM + ((size_t)((b * 528 + gc) * 2 + dir) * 256 + ch) * 2); A[i] = v.x; U[i] = v.y; }
        float As = 1.f, Us = 0.f;
#pragma unroll
        for (int i = 0; i < 33; ++i) { Us = A[i] * Us + U[i]; As *= A[i]; }
        sA[seg * 32 + ci] = As; sU[seg * 32 + ci] = Us;
        __syncthreads();
        float c = 0.f;
        for (int s = 0; s < 15; ++s) { const float a2 = sA[s * 32 + ci], u2 = sU[s * 32 + ci]; c = (s < seg) ? a2 * c + u2 : c; }
#pragma unroll
        for (int i = 0; i < 33; ++i) { const int pos = seg * 33 + i; const int gc = (dir == 0) ? pos : ((pos < 16) ? 15 - pos : 543 - pos);
            CIN[(size_t)((b * 528 + gc) * 2 + dir) * 256 + ch] = c; c = A[i] * c + U[i]; }
        __syncthreads();
    }
    for (int idx = F.vcu * 512 + tid; idx < 131072; idx += F.G * 512) {
        const int chain = idx >> 12, el = idx & 4095, bh = chain >> 1, dir = chain & 1, h = bh & 3;
        const float c128 = ex2(128.0f * ret_lg2(FIN(IN_RETDECAY), l, dir, h));
        const float* KV = (const float*)(F.ws + WS_KVT) + (size_t)bh * 66 * 2 * 4096 + dir * 4096 + el;
        bf16* SI = (bf16*)(F.ws + WS_SIN) + (size_t)bh * 66 * 2 * 4096 + dir * 4096 + el;
        float S = 0.f;
        for (int p0 = 0; p0 < 66; p0 += 11) { float kv[11];
#pragma unroll
            for (int i = 0; i < 11; ++i) { const int pos = p0 + i; const int cc = (dir == 0) ? pos : ((pos < 2) ? 1 - pos : 67 - pos); kv[i] = KV[(size_t)cc * 8192]; }
#pragma unroll
            for (int i = 0; i < 11; ++i) { const int pos = p0 + i; const int cc = (dir == 0) ? pos : ((pos < 2) ? 1 - pos : 67 - pos); SI[(size_t)cc * 8192] = (bf16)f2bf(S); S = c128 * S + kv[i]; } }
    }
}
constexpr size_t WS_DBG = 390 * MiB;
#ifndef DBG_PROBE
#define DBG_PROBE 0
#endif
#ifndef DBG_NOINTER
#define DBG_NOINTER 0
#endif
#ifndef DBG_LAYER
#define DBG_LAYER -1
#endif
constexpr int CW_DBG = 12288;
#ifndef NAIVE_RET
#define NAIVE_RET 0
#endif
#ifndef NAIVE_LRU
#define NAIVE_LRU 0
#endif
__device__ __forceinline__ void chain_tok(int b, int dir, int pos, size_t& prow, size_t& grow) {
    int isctx = pos < 256, t = isctx ? pos : pos - 256;
    if (dir == 1) t = isctx ? 255 - t : 8191 - t;
    prow = (size_t)b * NKEY + (isctx ? 0 : 256) + t; grow = isctx ? (size_t)MLAT + b * 256 + t : (size_t)b * SEQ + t;
}
__device__ __forceinline__ void naive_ret(Frame& F, int l) {
    LAUNDER_IDS
    const bf16* P = (const bf16*)(F.ws + WS_A); bf16* Y = (bf16*)(F.ws + WS_B); float* T = (float*)(F.ws + WS_DBG);
    LAS float* red = (LAS float*)F.lds;
    for (int item = blockIdx.x; item < 32; item += F.G) {
        const int dir = item & 1, h = (item >> 1) & 3, b = item >> 3, e = tid & 63, dg = tid >> 6;
        const float gam = ex2(ret_lg2(FIN(IN_RETDECAY), l, dir, h));
        float S[8];
#pragma unroll
        for (int i = 0; i < 8; ++i) S[i] = 0.f;
        for (int pos = 0; pos < 8448; ++pos) {
            size_t prow, grow; chain_tok(b, dir, pos, prow, grow);
#if DBG_PROBE == 1
            if ((pos & 127) == 0 && (DBG_LAYER < 0 || l == DBG_LAYER)) { const int cc = (dir == 0) ? (pos >> 7) : ((pos < 256) ? 1 - (pos >> 7) : 65 - ((pos - 256) >> 7));
                const bf16* SI = (const bf16*)(F.ws + WS_SIN) + (size_t)((((b * 4 + h) * 66 + cc) * 2) + dir) * 4096;
                float md = 0.f, ms = 0.f;
#pragma unroll
                for (int i = 0; i < 8; ++i) { const float sv = bf2f(SI[e * 64 + dg * 8 + i]); md = fmaxf(md, fabsf(sv - S[i])); ms = fmaxf(ms, fabsf(S[i])); }
                atomicMax((unsigned*)(F.ws + WS_CTL) + CW_DBG, __float_as_uint(md)); atomicMax((unsigned*)(F.ws + WS_CTL) + CW_DBG + 1, __float_as_uint(ms)); }
#endif
#if DBG_NOINTER
            if ((pos & 127) == 0) {
#pragma unroll
                for (int i = 0; i < 8; ++i) S[i] = 0.f; }
#endif
            const bf16* pr = P + prow * NIN + h * 64;
            const v4u qw = *(const v4u*)(pr + 5 * 256 + dg * 8), kw = *(const v4u*)(pr + 6 * 256 + dg * 8);
            const float v = bf2f(pr[7 * 256 + e]);
            const float q[8] = {bflo(qw.x), bfhi(qw.x), bflo(qw.y), bfhi(qw.y), bflo(qw.z), bfhi(qw.z), bflo(qw.w), bfhi(qw.w)};
            const float k[8] = {bflo(kw.x), bfhi(kw.x), bflo(kw.y), bfhi(kw.y), bflo(kw.z), bfhi(kw.z), bflo(kw.w), bfhi(kw.w)};
            float part = 0.f;
            if (dir == 0) {
#pragma unroll
                for (int i = 0; i < 8; ++i) { S[i] = gam * S[i] + k[i] * v; part += q[i] * S[i]; } }
            else {
#pragma unroll
                for (int i = 0; i < 8; ++i) { part += q[i] * S[i]; S[i] = gam * S[i] + k[i] * v; } }
            red[dg * 64 + e] = part;
            __syncthreads();
            if (dg == 0) { float o = 0.f;
#pragma unroll
                for (int i = 0; i < 8; ++i) o += red[i * 64 + e];
                T[((size_t)dir * MALL + grow) * 256 + h * 64 + e] = o; }
            __syncthreads();
        }
    }
}
__device__ __forceinline__ void naive_ret_combine(Frame& F, int l) {
    LAUNDER_IDS
    const bf16* P = (const bf16*)(F.ws + WS_A); bf16* Y = (bf16*)(F.ws + WS_B); const float* T = (const float*)(F.ws + WS_DBG);
    const int gw = F.vcu * NWAVES + wid, NGW = F.G * NWAVES;
    for (int it = gw; it < MALL * 4; it += NGW) {
        const int grow = it >> 2, h = it & 3;
        if (l == 1 && grow >= MLAT) continue;
        const size_t prow = (grow < MLAT) ? (size_t)(grow >> 13) * NKEY + 256 + (grow & 8191) : (size_t)((grow - MLAT) >> 8) * NKEY + ((grow - MLAT) & 255);
        const float o = T[(size_t)grow * 256 + h * 64 + lane] + T[((size_t)MALL + grow) * 256 + h * 64 + lane];
        const float ss = wave_sum(o * o); const float rs = 1.0f / sqrtf(ss * (1.0f / 64.0f) + EPS);
        const float g = bf2f(P[prow * NIN + 8 * 256 + h * 64 + lane]);
#if DBG_PROBE == 2
        if (DBG_LAYER < 0 || l == DBG_LAYER) { const float mine = bf2f(Y[(size_t)grow * DM + 512 + h * 64 + lane]), ref = o * rs * (g * sigmoidf_(g));
            atomicMax((unsigned*)(F.ws + WS_CTL) + CW_DBG, __float_as_uint(fabsf(mine - ref))); atomicMax((unsigned*)(F.ws + WS_CTL) + CW_DBG + 1, __float_as_uint(fabsf(ref))); }
#else
        Y[(size_t)grow * DM + 512 + h * 64 + lane] = (bf16)f2bf(o * rs * (g * sigmoidf_(g)));
#endif
    }
}
__device__ __forceinline__ void naive_lru(Frame& F, int l) {
    LAUNDER_IDS
    const bf16* P = (const bf16*)(F.ws + WS_A); float* T = (float*)(F.ws + WS_DBG);
    LAS float* xs = (LAS float*)F.lds;
    for (int item = blockIdx.x; item < 16; item += F.G) {
        const int b = item >> 2, k = item & 3, dir = (tid >> 6) & 1, d = tid & 63, ch = k * 64 + d; const bool on = tid < 128;
        const float* cw = FIN(IN_CONVW) + l * 1024; const float cb = FIN(IN_CONVB)[l * 256 + ch];
        const float* wr_ = FIN(IN_GATEW) + ((size_t)((l * 2 + dir) * 2 + 0) * 4 + k) * 4096;
        const float* wi_ = FIN(IN_GATEW) + ((size_t)((l * 2 + dir) * 2 + 1) * 4 + k) * 4096;
        const float br = FIN(IN_GATEB)[((size_t)((l * 2 + dir) * 2 + 0) * 4 + k) * 64 + d], bi = FIN(IN_GATEB)[((size_t)((l * 2 + dir) * 2 + 1) * 4 + k) * 64 + d];
        const float sp = log1pf(expf(-FIN(IN_LRULAM)[(l * 2 + dir) * 256 + ch]));
        float hst = 0.f;
        for (int pos = 0; pos < 8448; ++pos) {
            size_t prow, grow; chain_tok(b, dir, pos, prow, grow);
            const int isctx = pos < 256; int t = isctx ? pos : pos - 256; if (dir == 1) t = isctx ? 255 - t : 8191 - t;
            const int seqlen = isctx ? 256 : 8192;
            float xb = cb;
#pragma unroll
            for (int j = 0; j < 4; ++j) { const int tt = t + j - 1; if (tt >= 0 && tt < seqlen) xb += cw[j * 256 + ch] * bf2f(P[(prow + (tt - t)) * NIN + 768 + ch]); }
            if (on) xs[dir * 64 + d] = xb;
            __syncthreads();
            if (on) { float pr_ = br, pi_ = bi;
                for (int c = 0; c < 64; ++c) { const float xv = xs[dir * 64 + c]; pr_ += xv * wr_[c * 64 + d]; pi_ += xv * wi_[c * 64 + d]; }
                const float r = 1.0f / (1.0f + expf(-pr_)), ii = 1.0f / (1.0f + expf(-pi_));
                const float la = -8.0f * r * sp, a = expf(la), u = sqrtf(-expm1f(2.0f * la)) * (ii * xb);
                hst = a * hst + u;
                T[((size_t)dir * MALL + grow) * 256 + ch] = hst; }
            __syncthreads();
        }
    }
}
__device__ __forceinline__ void naive_lru_combine(Frame& F, int l) {
    LAUNDER_IDS
    const bf16* P = (const bf16*)(F.ws + WS_A); bf16* Y = (bf16*)(F.ws + WS_B); const float* T = (const float*)(F.ws + WS_DBG);
    const int gw = F.vcu * NWAVES + wid, NGW = F.G * NWAVES;
    for (int it = gw; it < MALL * 4; it += NGW) {
        const int grow = it >> 2, k = it & 3, ch = k * 64 + lane;
        if (l == 1 && grow >= MLAT) continue;
        const size_t prow = (grow < MLAT) ? (size_t)(grow >> 13) * NKEY + 256 + (grow & 8191) : (size_t)((grow - MLAT) >> 8) * NKEY + ((grow - MLAT) & 255);
        const float hsum = T[(size_t)grow * 256 + ch] + T[((size_t)MALL + grow) * 256 + ch];
        const float g = bf2f(P[prow * NIN + 1024 + ch]);
        const float z = 0.7978845608028654f * (g + 0.044715f * g * g * g);
        Y[(size_t)grow * DM + 256 + ch] = (bf16)f2bf(hsum * 0.5f * g * (1.0f + tanhf(z)));
    }
}
struct Args { const float* in[23]; float* out; unsigned char* ws; int ph_lo, ph_hi; };
__device__ __forceinline__ int fetch_item(Frame& F, unsigned* ctr) {
    volatile LAS int* slot = (volatile LAS int*)(F.lds + MISC_OFF + 64);
    __syncthreads();
    if (F.tid == 0) *slot = (int)__hip_atomic_fetch_add(ctr, 1u, __ATOMIC_RELAXED, __HIP_MEMORY_SCOPE_AGENT);
    __syncthreads();
    return *slot;
}
__global__ void __launch_bounds__(NWAVES * 64, 2) hybrid_fwd(Args args) {
    extern __shared__ __attribute__((aligned(16))) unsigned char lds_raw[];
    Frame F;
    F.lds = (LAS unsigned char*)lds_raw;
    F.tid = threadIdx.x; F.lane = F.tid & 63; F.wave = __builtin_amdgcn_readfirstlane(F.tid >> 6);
    F.G = gridDim.x; { const int bx = blockIdx.x; F.vcu = (F.G % 8 == 0) ? (bx % 8) * (F.G / 8) + bx / 8 : bx; }
    F.kin = (const float* const __attribute__((address_space(4)))*)__builtin_amdgcn_kernarg_segment_ptr();
    F.out = args.out; F.ws = args.ws;
    unsigned* ctl = (unsigned*)(F.ws + WS_CTL);
    for (int u = F.tid; u < (LDS_BYTES - LDSCTL_OFF) / 4; u += NWAVES * 64) ((LAS unsigned*)(F.lds + LDSCTL_OFF))[u] = 0u;
    __syncthreads();
    XcdBarrier bar = xcd_barrier_post(ctl + CW_BAR, (volatile LAS unsigned*)(F.lds + MISC_OFF) + 8);
    const int lo = args.ph_lo, hi = args.ph_hi; int ph = 0;
#ifndef UMASK
#define UMASK 0xFF
#endif
#ifndef PHMASK
#define PHMASK 0xFFFF
#endif
#define PHASE_BEGIN(kind) if ((((PHMASK) >> (kind)) & 1) && ph >= lo && ph < hi) {
#define PHASE_END(last) if (!(last) && ph + 1 < hi) xcd_barrier(bar); } ++ph;

    PHASE_BEGIN(0) p0a(F); PHASE_END(false)
    PHASE_BEGIN(1) p0b(F); PHASE_END(false)
    for (int l = 0; l < 2; ++l) {
        const int M = (l == 0) ? MALL : MLAT;
        PHASE_BEGIN(2) {
            pg8::Gemm g{(const pg8::bf16_t*)(F.ws + WS_B), (const pg8::bf16_t*)(F.ws + WS_WIN + l * SZ_WIN), MALL, NIN, DM}; pg8::StaticOrder S; S.init(MALL, NIN, F.G, (int)blockIdx.x);
            const float* tab = (const float*)(F.ws + WS_TAB);
            pg8::EpiInProj E{(pg8::bf16_t*)(F.ws + WS_A), tab, tab + 2048, tab + 4096, tab + 5120};
            pg8::gemm_phase<pg8::EpiInProj, pg8::StaticOrder, true, true>(F.lds, g, S, E);
        } PHASE_END(false)
        PHASE_BEGIN(3) {
            unsigned* ctr = ctl + CW_Q + 64 * l;
            const int n_diff = 512, n_na = 512, n_ret = 528, n_lru = 528, n_cx = (l == 0) ? 32 : 0;
            const int total = n_diff + n_na + n_ret + n_lru + n_cx;
            for (;;) {
                int it = fetch_item(F, ctr);
                if (it >= total) break;
                if (it < n_diff) { if (UMASK & 1) attn_unit<0>(F, l, it >> 7, (it >> 5) & 3, it & 31); continue; } it -= n_diff;
                if (it < n_na) { if (UMASK & 2) attn_unit<1>(F, l, it >> 7, (it >> 5) & 3, it & 31); continue; } it -= n_na;
                if (it < n_ret) { if (UMASK & 4) ret_m1_unit(F, l, it); continue; } it -= n_ret;
                if (it < n_lru) { if (UMASK & 8) lru_unit<false>(F, l, it); continue; } it -= n_lru;
                if (it < 16) { if (UMASK & 16) attn_unit<2>(F, l, it >> 2, it & 3, 0); } else { if (UMASK & 32) attn_unit<3>(F, l, (it - 16) >> 2, it & 3, 0); }
            }
        } PHASE_END(false)
        PHASE_BEGIN(4) m2_phase(F, l); PHASE_END(false)
        PHASE_BEGIN(5) {
            for (int it = blockIdx.x; it < 1056; it += F.G) {
                if (it < 528) { const int cc = (it >> 1) % 66; if ((!NAIVE_RET || DBG_PROBE == 2) && (UMASK & 64) && (l == 0 || cc >= 2)) ret_m3_unit(F, l, it); }
                else { const int u = it - 528; if (!NAIVE_LRU && (UMASK & 128) && (l == 0 || (u % 132) >= 4)) lru_unit<true>(F, l, u); }
            }
#if NAIVE_RET
            naive_ret(F, l); xcd_barrier(bar); naive_ret_combine(F, l);
#endif
#if NAIVE_LRU
            xcd_barrier(bar); naive_lru(F, l); xcd_barrier(bar); naive_lru_combine(F, l);
#endif
        } PHASE_END(false)
        PHASE_BEGIN(6) {
            pg8::Gemm g{(const pg8::bf16_t*)(F.ws + WS_B), (const pg8::bf16_t*)(F.ws + WS_WOUT + l * SZ_WOUT), M, DM, DM}; pg8::StaticOrder S; S.init(M, DM, F.G, (int)blockIdx.x);
            pg8::EpiPlain E{(pg8::bf16_t*)(F.ws + WS_A), DM};
            pg8::gemm_phase<pg8::EpiPlain, pg8::StaticOrder, true, true>(F.lds, g, S, E);
        } PHASE_END(false)
        PHASE_BEGIN(7) e2_phase(F, l, M); PHASE_END(false)
        PHASE_BEGIN(8) {
            pg8::Gemm g{(const pg8::bf16_t*)(F.ws + WS_B), (const pg8::bf16_t*)(F.ws + WS_WF1 + l * SZ_WF1), M, 2 * DFF, DM}; pg8::StaticOrder S; S.init(M, 2 * DFF, F.G, (int)blockIdx.x);
            pg8::EpiSwiGLU E{(pg8::bf16_t*)(F.ws + WS_A), DFF};
            pg8::gemm_phase<pg8::EpiSwiGLU, pg8::StaticOrder, true, true>(F.lds, g, S, E);
        } PHASE_END(false)
        PHASE_BEGIN(9) {
            pg8::Gemm g{(const pg8::bf16_t*)(F.ws + WS_A), (const pg8::bf16_t*)(F.ws + WS_WF2 + l * SZ_WF2), M, DM, DFF}; pg8::StaticOrder S; S.init(M, DM, F.G, (int)blockIdx.x);
            pg8::EpiPlain E{(pg8::bf16_t*)(F.ws + WS_B), DM};
            pg8::gemm_phase<pg8::EpiPlain, pg8::StaticOrder, true, true>(F.lds, g, S, E);
        } PHASE_END(false)
        PHASE_BEGIN(10) e3_phase(F, l, M); PHASE_END(l == 1)
    }
#if DBG_PROBE
    xcd_barrier(bar);
    if (blockIdx.x == 0 && F.tid == 0) { const float md = __uint_as_float(ctl[CW_DBG]), ms = __uint_as_float(ctl[CW_DBG + 1]); F.out[0] = 1.0e4f * md / fmaxf(ms, 1e-20f); F.out[1] = 0.f; }
#endif
}
constexpr int N_PHASES = 2 + 2 * 9;

#ifndef MK_N_LAUNCHES
#define MK_N_LAUNCHES 1
#endif
extern "C" void kernel_launch(void* const* d_in, const int* in_sizes, int n_in, void* d_out, int out_size, void* d_ws, size_t ws_size, hipStream_t stream) {
    static int grid = 0;
    if (grid == 0) {
        if (n_in != 23 || in_sizes[0] != MLAT * DM || out_size != MLAT * DM || ws_size < WS_END) { fprintf(stderr, "kernel_launch: unexpected shapes (n_in %d, in0 %d, out %d, ws %zu); nothing launched\n", n_in, n_in > 0 ? in_sizes[0] : -1, out_size, ws_size); grid = -1; return; }
        int dev = 0, cus = 0, per_cu = 0;
        if (hipGetDevice(&dev) != hipSuccess || hipDeviceGetAttribute(&cus, hipDeviceAttributeMultiprocessorCount, dev) != hipSuccess) { fprintf(stderr, "kernel_launch: device query failed\n"); grid = -1; return; }
        if (hipFuncSetAttribute((const void*)hybrid_fwd, hipFuncAttributeMaxDynamicSharedMemorySize, LDS_BYTES) != hipSuccess) { fprintf(stderr, "kernel_launch: hipFuncSetAttribute failed\n"); grid = -1; return; }
        if (hipOccupancyMaxActiveBlocksPerMultiprocessor(&per_cu, (const void*)hybrid_fwd, NWAVES * 64, LDS_BYTES) != hipSuccess || per_cu < 1) { fprintf(stderr, "kernel_launch: occupancy query reports %d workgroups per CU\n", per_cu); }
        (void)hipGetLastError();
        grid = cus;
    }
    if (grid < 0) return;
    if (hipMemsetAsync((char*)d_ws + WS_CTL, 0, CTL_ZERO_BYTES, stream) != hipSuccess) { fprintf(stderr, "kernel_launch: memset failed\n"); return; }
    Args a{};
    for (int i = 0; i < 23; ++i) a.in[i] = (const float*)d_in[i];
    a.out = (float*)d_out; a.ws = (unsigned char*)d_ws;
#if MK_N_LAUNCHES == 1
    a.ph_lo = 0; a.ph_hi = N_PHASES;
    hipLaunchKernelGGL(hybrid_fwd, dim3(grid), dim3(NWAVES * 64), LDS_BYTES, stream, a);
#else
    for (int p = 0; p < N_PHASES; ++p) { a.ph_lo = p; a.ph_hi = p + 1; hipLaunchKernelGGL(hybrid_fwd, dim3(grid), dim3(NWAVES * 64), LDS_BYTES, stream, a); }
#endif
    const hipError_t le = hipPeekAtLastError();
    if (le != hipSuccess) fprintf(stderr, "kernel_launch: launch failed: %s\n", hipGetErrorName(le));
}
```

```cpp
#include <hip/hip_runtime.h>
#include <cstdio>
#include <cstdint>
namespace pg8 {
#define PG8_LAS __attribute__((address_space(3)))
typedef unsigned short bf16_t;
typedef short bf16x8 __attribute__((ext_vector_type(8)));
typedef float f32x4 __attribute__((ext_vector_type(4)));
typedef unsigned u32x4 __attribute__((ext_vector_type(4)));
constexpr int BM = 256, BK = 64, HALF = 128, HTB = HALF * BK * 2  , STAGE_BYTES = 8 * HTB, NXCD = 8, WGM = 8;

__host__ __device__ __forceinline__ int lds_byte(int r, int c) { const int st = (r >> 4) * 2 + (c >> 5), rr = r & 15, cc = c & 31, ob = rr * 64 + cc * 2; return st * 1024 + (ob ^ (((ob >> 9) & 1) << 5)); }
__host__ __device__ __forceinline__ void stage_rc(int b, int& R, int& C) { const int st = b / 1024, sb = b % 1024, swz = sb ^ (((sb >> 9) & 1) << 5); R = (st >> 1) * 16 + swz / 64; C = (st & 1) * 32 + (swz % 64) / 2; }
__host__ __device__ __forceinline__ int perm32(int rho) { const int n = rho >> 4, i = rho & 15; return 8 * (i >> 2) + 4 * n + (i & 3); }

struct Unit { int pm, pn; };
struct Gemm { const bf16_t* A; const bf16_t* Bt; int M, N, K; int ld = 0; };

struct StaticOrder {
    int nM, nN, nwg, G, c;
    __host__ __device__ void init(int M, int N, int G_, int c_) { nM = M / BM; nN = N / BM; nwg = nM * nN; G = G_; c = c_; }
    __host__ __device__ bool next(int i, Unit& u) const {
        const long L = (long)i * G + c; if (L >= nwg) return false;
        int wgid = (int)L; { const int q = nwg / NXCD, r = nwg % NXCD, xcd = wgid % NXCD, off = wgid / NXCD; wgid = (xcd < r ? xcd * (q + 1) : r * (q + 1) + (xcd - r) * q) + off; }
        const int nig = WGM * nN, gid = wgid / nig, fm = gid * WGM, gsz = (nM - fm) < WGM ? (nM - fm) : WGM;
        u.pm = fm + ((wgid % nig) % gsz); u.pn = (wgid % nig) / gsz; return true;
    }
    __device__ __forceinline__ void a_ready(const Unit&) const {}
    __device__ __forceinline__ void done(const Unit&) const {}
};

__device__ __forceinline__ unsigned cvt_pk_bf16(float lo, float hi) { unsigned r; asm volatile("v_cvt_pk_bf16_f32 %0, %1, %2" : "=v"(r) : "v"(lo), "v"(hi)); return r; }
typedef float f32x2 __attribute__((ext_vector_type(2)));
typedef unsigned u32x2 __attribute__((ext_vector_type(2)));
constexpr float LOG2E_F = 1.4426950408889634f;
struct EpiPlain {
    static constexpr bool PERM = true, AFTER_DRAIN = false;
    bf16_t* O; int ldc;
    __device__ __forceinline__ void operator()(const f32x4 (&acc)[2][2][4][2], const Unit& u, int wr, int wc, int fr, int fq) const {
        const int row0 = u.pm * BM + wr * 64 + fr, col0 = u.pn * BM + wc * 32 + 8 * fq;
#pragma unroll
        for (int ai = 0; ai < 2; ++ai)
#pragma unroll
            for (int m = 0; m < 4; ++m) { bf16_t* rowp = O + (size_t)(row0 + ai * HALF + m * 16) * ldc + col0;
#pragma unroll
                for (int bj = 0; bj < 2; ++bj) { const f32x4 v0 = acc[ai][bj][m][0], v1 = acc[ai][bj][m][1];
                    u32x4 w; w.x = cvt_pk_bf16(v0[0], v0[1]); w.y = cvt_pk_bf16(v0[2], v0[3]); w.z = cvt_pk_bf16(v1[0], v1[1]); w.w = cvt_pk_bf16(v1[2], v1[3]);
                    *(u32x4*)(rowp + bj * HALF) = w; } }
    }
};
struct EpiSwiGLU {
    static constexpr bool PERM = true, AFTER_DRAIN = false;
    bf16_t* O; int ldc;
    __device__ __forceinline__ static float silu_mul(float g, float uu) { return g * __builtin_amdgcn_rcpf(1.0f + __builtin_amdgcn_exp2f(-g * LOG2E_F)) * uu; }
    __device__ __forceinline__ void operator()(const f32x4 (&acc)[2][2][4][2], const Unit& u, int wr, int wc, int fr, int fq) const {
        const int row0 = u.pm * BM + wr * 64 + fr, col0 = u.pn * HALF + wc * 32 + 8 * fq;
#pragma unroll
        for (int ai = 0; ai < 2; ++ai)
#pragma unroll
            for (int m = 0; m < 4; ++m) { bf16_t* rowp = O + (size_t)(row0 + ai * HALF + m * 16) * ldc + col0;
                const f32x4 g0 = acc[ai][0][m][0], g1 = acc[ai][0][m][1], u0 = acc[ai][1][m][0], u1 = acc[ai][1][m][1];
                u32x4 w; w.x = cvt_pk_bf16(silu_mul(g0[0], u0[0]), silu_mul(g0[1], u0[1])); w.y = cvt_pk_bf16(silu_mul(g0[2], u0[2]), silu_mul(g0[3], u0[3]));
                w.z = cvt_pk_bf16(silu_mul(g1[0], u1[0]), silu_mul(g1[1], u1[1])); w.w = cvt_pk_bf16(silu_mul(g1[2], u1[2]), silu_mul(g1[3], u1[3]));
                *(u32x4*)rowp = w; }
    }
};
struct EpiInProj {
    static constexpr bool PERM = true, AFTER_DRAIN = false;
    bf16_t* P; const float* tabRc; const float* tabRs; const float* tabDc; const float* tabDs;
    __device__ __forceinline__ void operator()(const f32x4 (&acc)[2][2][4][2], const Unit& u, int wr, int wc, int fr, int fq) const {
        asm volatile("" : "+v"(fr), "+v"(fq));
        const int sec = u.pn; const bool isctx = u.pm >= 128;
        int tbase; size_t prow0;
        if (!isctx) { const int b = u.pm >> 5; tbase = (u.pm & 31) * 256; prow0 = (size_t)b * 8448 + 256 + tbase; }
        else { const int b = u.pm - 128; tbase = 0; prow0 = (size_t)b * 8448; }
        float sc = 1.0f;
        if (sec == 0) sc = 0.125f * LOG2E_F; else if (sec == 6) sc = 0.125f; else if (sec == 9) sc = 0.17677669529663687f * LOG2E_F;
        const int mode = (sec == 5 || sec == 6) ? 1 : ((sec == 9 || sec == 10) ? 2 : 0);
        const int rbase = wr * 64 + fr;
#pragma unroll
        for (int bj = 0; bj < 2; ++bj) {
            const int pcol = 128 * bj + 32 * wc + 8 * fq, hh = pcol >> 6, ph = pcol & 63;
            if (mode == 0) {
#pragma unroll
                for (int ai = 0; ai < 2; ++ai)
#pragma unroll
                    for (int m = 0; m < 4; ++m) { const int row = rbase + 128 * ai + 16 * m;
                        const f32x4 v0 = acc[ai][bj][m][0] * sc, v1 = acc[ai][bj][m][1] * sc;
                        u32x4 w; w.x = cvt_pk_bf16(v0[0], v0[1]); w.y = cvt_pk_bf16(v0[2], v0[3]); w.z = cvt_pk_bf16(v1[0], v1[1]); w.w = cvt_pk_bf16(v1[2], v1[3]);
                        *(u32x4*)(P + (prow0 + row) * 3072 + sec * 256 + pcol) = w; }
            } else {
                int G, jb, col1, col2, tw; bool userow; const float *tc, *ts;
                if (mode == 1) { G = ph >> 3; jb = (4 * G) & 15; userow = G < 4; col1 = sec * 256 + hh * 64 + 4 * G; col2 = col1 + 32; tw = 16; tc = tabRc; ts = tabRs; }
                else { const int mp = ph >> 5, pm_ = ph & 31; G = pm_ >> 3; jb = (4 * G) & 7; userow = G < 2; col1 = sec * 256 + hh * 64 + mp * 32 + 4 * G; col2 = col1 + 16; tw = 8; tc = tabDc; ts = tabDs; }
#pragma unroll
                for (int ai = 0; ai < 2; ++ai)
#pragma unroll
                    for (int m = 0; m < 4; ++m) { const int row = rbase + 128 * ai + 16 * m; const int t = tbase + row;
                        const int pos = userow ? (t >> 6) : (t & 63);
                        f32x4 c4 = (f32x4){1.f, 1.f, 1.f, 1.f}, s4 = (f32x4){0.f, 0.f, 0.f, 0.f};
                        if (!isctx) { c4 = *(const f32x4*)(tc + pos * tw + jb); s4 = *(const f32x4*)(ts + pos * tw + jb); }
                        const f32x4 x1 = acc[ai][bj][m][0] * sc, x2 = acc[ai][bj][m][1] * sc;
                        const f32x4 o1 = x1 * c4 - x2 * s4, o2 = x2 * c4 + x1 * s4;
                        u32x2 w1, w2; w1.x = cvt_pk_bf16(o1[0], o1[1]); w1.y = cvt_pk_bf16(o1[2], o1[3]); w2.x = cvt_pk_bf16(o2[0], o2[1]); w2.y = cvt_pk_bf16(o2[2], o2[3]);
                        bf16_t* rp = P + (prow0 + row) * 3072;
                        *(u32x2*)(rp + col1) = w1; *(u32x2*)(rp + col2) = w2; asm volatile("" ::: "memory"); }
            }
        }
    }
};
template <class Epi, class Sched, bool ALIGN_EPI = false, bool SP2 = false>
__device__ __forceinline__ void gemm_phase(PG8_LAS unsigned char* lds, const Gemm g, const Sched& S, const Epi& E) {
    int tid_ = threadIdx.x; asm volatile("" : "+v"(tid_)); const int tid = tid_, wid = __builtin_amdgcn_readfirstlane(tid >> 6), lane = tid & 63, wr = wid >> 2, wc = wid & 3, fr = lane & 15, fq = lane >> 4;
    const int K = g.K, nt = K / BK, LD = g.ld ? g.ld : g.K;
    unsigned voffA[2], voffB[2];
#pragma unroll
    for (int i = 0; i < 2; ++i) { int R, C; stage_rc(tid * 16 + i * 8192, R, C); const int Rb = Epi::PERM ? ((R & ~31) + perm32(R & 31)) : R;
        voffA[i] = (unsigned)(R * LD + C) * 2u; voffB[i] = (unsigned)(Rb * LD + C) * 2u; }
    const size_t kstep = (size_t)(BK * 2);
    const size_t hstep = (size_t)HALF * LD * 2;
    const size_t tstep = 2 * hstep;
    const unsigned ldsw = (unsigned)wid * 1024u;
    const int aoff = lds_byte(wr * 64 + fr, fq * 8), boff = lds_byte(wc * 32 + fr, fq * 8);
#define PG8_SA(b, h) (((b) * 2 + (h)) * HTB)
#define PG8_SB(b, h) ((4 + (b) * 2 + (h)) * HTB)
#define PG8_STAGE(bufoff, gbase, voff) do { _Pragma("unroll") for (int _i = 0; _i < 2; ++_i) \
        __builtin_amdgcn_global_load_lds((const unsigned*)((const char*)(gbase) + (voff)[_i]), (PG8_LAS unsigned*)(lds + (bufoff) + ldsw + _i * 8192), 16, 0, 0); } while (0)
#define PG8_LDA(dst, b, h) do { _Pragma("unroll") for (int m = 0; m < 4; ++m) _Pragma("unroll") for (int k = 0; k < 2; ++k) dst[m][k] = *(const PG8_LAS bf16x8*)(lds + PG8_SA(b, h) + aoff + m * 2048 + k * 1024); } while (0)
#define PG8_LDB(dst, b, h) do { _Pragma("unroll") for (int n = 0; n < 2; ++n) _Pragma("unroll") for (int k = 0; k < 2; ++k) dst[n][k] = *(const PG8_LAS bf16x8*)(lds + PG8_SB(b, h) + boff + n * 2048 + k * 1024); } while (0)
#define PG8_MMA(ai, bj, At, Bt) do { __builtin_amdgcn_s_setprio(1); _Pragma("unroll") for (int m = 0; m < 4; ++m) _Pragma("unroll") for (int n = 0; n < 2; ++n) _Pragma("unroll") for (int k = 0; k < 2; ++k) \
        acc[ai][bj][m][n] = __builtin_amdgcn_mfma_f32_16x16x32_bf16(Bt[n][k], At[m][k], acc[ai][bj][m][n], 0, 0, 0); __builtin_amdgcn_s_setprio(0); } while (0)
#define PG8_WAIT_V(n) asm volatile("s_waitcnt vmcnt(" #n ")" ::: "memory")
#define PG8_WAIT_L(n) asm volatile("s_waitcnt lgkmcnt(" #n ")" ::: "memory")
#define PG8_BAR __builtin_amdgcn_s_barrier()
#define PG8_SCHED __builtin_amdgcn_sched_barrier(0)
    Unit cur, nxt; int ui = 0;
    if (!S.next(0, cur)) return;
    f32x4 acc[2][2][4][2];
#pragma unroll
    for (int a = 0; a < 2; ++a)
#pragma unroll
        for (int b = 0; b < 2; ++b)
#pragma unroll
            for (int m = 0; m < 4; ++m)
#pragma unroll
                for (int n = 0; n < 2; ++n) acc[a][b][m][n] = (f32x4){0.f, 0.f, 0.f, 0.f};
    bf16x8 At[4][2], B0[2][2], B1[2][2];
    const char* cA = (const char*)g.A + (size_t)cur.pm * tstep; const char* cB = (const char*)g.Bt + (size_t)cur.pn * tstep;
    S.a_ready(cur);
    if constexpr (SP2) {
        PG8_STAGE(PG8_SB(0, 0), cB, voffB); PG8_STAGE(PG8_SB(0, 1), cB + hstep, voffB); PG8_STAGE(PG8_SA(0, 0), cA, voffA); PG8_STAGE(PG8_SA(0, 1), cA + hstep, voffA);
        if (wr == 1) PG8_BAR;
        PG8_WAIT_V(2); PG8_BAR;
        PG8_STAGE(PG8_SB(1, 0), cB + kstep, voffB); PG8_STAGE(PG8_SA(1, 0), cA + kstep, voffA); PG8_STAGE(PG8_SB(1, 1), cB + hstep + kstep, voffB);
        PG8_WAIT_V(6); PG8_BAR;
    } else {
        PG8_STAGE(PG8_SB(0, 0), cB, voffB); PG8_STAGE(PG8_SA(0, 0), cA, voffA); PG8_STAGE(PG8_SB(0, 1), cB + hstep, voffB); PG8_STAGE(PG8_SA(0, 1), cA + hstep, voffA);
        if (wr == 1) PG8_BAR;
        PG8_WAIT_V(4); PG8_BAR;
        PG8_STAGE(PG8_SB(1, 0), cB + kstep, voffB); PG8_STAGE(PG8_SA(1, 0), cA + kstep, voffA); PG8_STAGE(PG8_SB(1, 1), cB + hstep + kstep, voffB);
        PG8_WAIT_V(6); PG8_BAR;
    }
    for (;;) {
        const bool has_next = S.next(ui + 1, nxt);
        const char* nA = has_next ? (const char*)g.A + (size_t)nxt.pm * tstep : cA; const char* nB = has_next ? (const char*)g.Bt + (size_t)nxt.pn * tstep : cB;
        for (int t = 0; t < nt; t += 2) {
            const bool last = (t == nt - 2);
            const char* a1 = cA + (size_t)(t + 1) * kstep;
            const char* a2 = last ? nA : cA + (size_t)(t + 2) * kstep; const char* b2 = last ? nB : cB + (size_t)(t + 2) * kstep;
            const char* a3 = a2 + kstep; const char* b3 = b2 + kstep;
            if (last && has_next) S.a_ready(nxt);
            if constexpr (SP2) {
            PG8_LDB(B0, 0, 0); PG8_LDB(B1, 0, 1); PG8_SCHED; PG8_LDA(At, 0, 0); PG8_STAGE(PG8_SA(1, 1), a1 + hstep, voffA);
            PG8_WAIT_V(8); PG8_WAIT_L(0); PG8_BAR; PG8_MMA(0, 0, At, B0); PG8_MMA(0, 1, At, B1); PG8_BAR; PG8_SCHED;
            PG8_LDA(At, 0, 1); PG8_STAGE(PG8_SB(0, 0), b2, voffB); PG8_STAGE(PG8_SB(0, 1), b2 + hstep, voffB); PG8_STAGE(PG8_SA(0, 0), a2, voffA);
            PG8_WAIT_V(8); PG8_WAIT_L(0); PG8_BAR; PG8_MMA(1, 0, At, B0); PG8_MMA(1, 1, At, B1); PG8_BAR; PG8_SCHED;
            PG8_LDB(B0, 1, 0); PG8_LDB(B1, 1, 1); PG8_SCHED; PG8_LDA(At, 1, 0); PG8_STAGE(PG8_SA(0, 1), a2 + hstep, voffA);
            PG8_WAIT_V(8); PG8_WAIT_L(0); PG8_BAR; PG8_MMA(0, 0, At, B0); PG8_MMA(0, 1, At, B1); PG8_BAR; PG8_SCHED;
            PG8_LDA(At, 1, 1); PG8_STAGE(PG8_SB(1, 0), b3, voffB); PG8_STAGE(PG8_SB(1, 1), b3 + hstep, voffB); PG8_STAGE(PG8_SA(1, 0), a3, voffA);
            PG8_WAIT_V(8); PG8_WAIT_L(0); PG8_BAR; PG8_MMA(1, 0, At, B0); PG8_MMA(1, 1, At, B1); PG8_BAR; PG8_SCHED;
            } else {
            PG8_LDB(B0, 0, 0); PG8_SCHED; PG8_LDA(At, 0, 0); PG8_STAGE(PG8_SA(1, 1), a1 + hstep, voffA);
            PG8_WAIT_L(8); PG8_BAR; PG8_WAIT_L(0); PG8_MMA(0, 0, At, B0); PG8_BAR; PG8_SCHED;
            PG8_LDB(B1, 0, 1); PG8_STAGE(PG8_SB(0, 0), b2, voffB);
            PG8_BAR; PG8_WAIT_L(0); PG8_MMA(0, 1, At, B1); PG8_BAR;
            PG8_LDA(At, 0, 1); PG8_STAGE(PG8_SA(0, 0), a2, voffA);
            PG8_BAR; PG8_WAIT_L(0); PG8_MMA(1, 0, At, B0); PG8_BAR; PG8_SCHED;
            PG8_STAGE(PG8_SB(0, 1), b2 + hstep, voffB);
            PG8_WAIT_V(6); PG8_BAR; PG8_MMA(1, 1, At, B1); PG8_BAR;
            PG8_LDB(B0, 1, 0); PG8_SCHED; PG8_LDA(At, 1, 0); PG8_STAGE(PG8_SA(0, 1), a2 + hstep, voffA);
            PG8_WAIT_L(8); PG8_BAR; PG8_WAIT_L(0); PG8_MMA(0, 0, At, B0); PG8_BAR; PG8_SCHED;
            PG8_LDB(B1, 1, 1); PG8_STAGE(PG8_SB(1, 0), b3, voffB);
            PG8_BAR; PG8_WAIT_L(0); PG8_MMA(0, 1, At, B1); PG8_BAR;
            PG8_LDA(At, 1, 1); PG8_STAGE(PG8_SA(1, 0), a3, voffA);
            PG8_BAR; PG8_WAIT_L(0); PG8_MMA(1, 0, At, B0); PG8_BAR; PG8_SCHED;
            PG8_STAGE(PG8_SB(1, 1), b3 + hstep, voffB);
            PG8_WAIT_V(6); PG8_BAR; PG8_MMA(1, 1, At, B1); PG8_BAR;
            }
        }
        if constexpr (ALIGN_EPI) { if (wr == 0) PG8_BAR; }
        if constexpr (!Epi::AFTER_DRAIN) { E(acc, cur, wr, wc, fr, fq); S.done(cur); }
        if (!has_next) break;
#pragma unroll
        for (int a = 0; a < 2; ++a)
#pragma unroll
            for (int b = 0; b < 2; ++b)
#pragma unroll
                for (int m = 0; m < 4; ++m)
#pragma unroll
                    for (int n = 0; n < 2; ++n) acc[a][b][m][n] = (f32x4){0.f, 0.f, 0.f, 0.f};
        cur = nxt; cA = nA; cB = nB; ++ui;
        if constexpr (ALIGN_EPI) { if (wr == 1) PG8_BAR; }
    }
    PG8_WAIT_V(0);
    if constexpr (!ALIGN_EPI) { if (wr == 0) PG8_BAR; }
    PG8_BAR;
    if constexpr (Epi::AFTER_DRAIN) { E.fused(acc, cur, wr, wc, fr, fq, lds, wid, lane); S.done(cur); }
#undef PG8_SA
#undef PG8_SB
#undef PG8_STAGE
#undef PG8_LDA
#undef PG8_LDB
#undef PG8_MMA
#undef PG8_WAIT_V
#undef PG8_WAIT_L
#undef PG8_BAR
#undef PG8_SCHED
}
}
#define GAS __attribute__((address_space(1)))
#define LAS __attribute__((address_space(3)))
typedef unsigned short bf16;
typedef unsigned v4u __attribute__((ext_vector_type(4)));
typedef float f32x4 __attribute__((ext_vector_type(4)));
typedef short bf16x8 __attribute__((ext_vector_type(8)));
typedef GAS unsigned gu32;
typedef GAS unsigned long long gu64;
#define RLX_AGENT __ATOMIC_RELAXED, __HIP_MEMORY_SCOPE_AGENT
#define LDS_WAIT() asm volatile("s_waitcnt lgkmcnt(0)" ::: "memory")
#define VM_WAIT() asm volatile("s_waitcnt vmcnt(0)" ::: "memory")
__device__ __forceinline__ unsigned long long rt() { return __builtin_amdgcn_s_memrealtime(); }
__device__ __forceinline__ unsigned f2bf(float f) { unsigned u = __builtin_bit_cast(unsigned, f); return (u + 0x7fffu + ((u >> 16) & 1u)) >> 16; }

#define XB_TMO      128
#define XB_XCNT(j)  (256  + 64 * (j))
#define XB_XSUB(j)  (1280 + 64 * (j))
#define XB_XGEN(j)  (2304 + 64 * (j))
#define XB_TOP      3328
#define XB_TOPGEN   3392
#define XCD_BAR_WORDS 3456
#define XB_SPIN_CAP (1u << 22)

__device__ __forceinline__ unsigned xb_ld(unsigned* p)              { return __hip_atomic_load(p, __ATOMIC_RELAXED, __HIP_MEMORY_SCOPE_AGENT); }
__device__ __forceinline__ unsigned xb_add(unsigned* p, unsigned v) { return __hip_atomic_fetch_add(p, v, __ATOMIC_RELAXED, __HIP_MEMORY_SCOPE_AGENT); }
__device__ __forceinline__ unsigned xb_xcc_id() { return (unsigned)__builtin_amdgcn_s_getreg((3 << 11) | 20) & 0xFu; }
#define XB_SPIN(cond, bar) do { unsigned _sp = 0; while (cond) { __builtin_amdgcn_s_sleep(1); \
    if ((++_sp & 255u) == 0u) { if (xb_ld(&(bar)[XB_TMO])) break; if (_sp > XB_SPIN_CAP) { atomicAdd(&(bar)[XB_TMO], 1u); break; } } } } while (0)

struct XcdBarrier {
    unsigned* bar; unsigned x;
    volatile LAS unsigned* st;
};

__device__ __forceinline__ XcdBarrier xcd_barrier_post(unsigned* bar, volatile LAS unsigned* st) {
    XcdBarrier b; b.bar = bar; b.x = xb_xcc_id(); b.st = st;
    if (threadIdx.x == 0) (void)xb_add(&bar[XB_XCNT(b.x)], 1u);
    return b;
}
__device__ __forceinline__ void xcd_barrier_complete(unsigned* bar, unsigned x, unsigned& nloc, unsigned& nx) {
    const unsigned G = gridDim.x * gridDim.y * gridDim.z;
    unsigned sum, cnt, mine, sp = 0u;
    for (;;) {
        sum = 0u; cnt = 0u; mine = 0u;
#pragma unroll
        for (unsigned j = 0; j < 16; ++j) { const unsigned c = xb_ld(&bar[XB_XCNT(j)]); sum += c; cnt += (c > 0u) ? 1u : 0u; mine = (j == x) ? c : mine; }
        if (sum == G) break;
        __builtin_amdgcn_s_sleep(1);
        if ((++sp & 255u) == 0u) { if (xb_ld(&bar[XB_TMO])) break; if (sp > XB_SPIN_CAP) { atomicAdd(&bar[XB_TMO], 1u); break; } }
    }
    nloc = mine > 0u ? mine : 1u; nx = cnt > 0u ? cnt : 1u;
}

__device__ __forceinline__ void xcd_barrier(const XcdBarrier& b) {
    asm volatile("s_waitcnt vmcnt(0)" ::: "memory");
    __syncthreads();
    if (threadIdx.x == 0) {
        unsigned* bar = b.bar;
        __builtin_amdgcn_s_waitcnt(0);
        unsigned nloc = b.st[0], nx = b.st[1];
        if (nloc == 0u) { xcd_barrier_complete(bar, b.x, nloc, nx); b.st[0] = nloc; b.st[1] = nx; }
        const unsigned old = xb_add(&bar[XB_XSUB(b.x)], 1u);
        const unsigned gen = old / nloc;
        if (old + 1u == (gen + 1u) * nloc) {
            __builtin_amdgcn_fence(__ATOMIC_RELEASE, "agent");
            asm volatile("s_waitcnt vmcnt(0)" ::: "memory");
            const unsigned og = xb_add(&bar[XB_TOP], 1u);
            const unsigned tg = og / nx;
            if (og + 1u == (tg + 1u) * nx) xb_add(&bar[XB_TOPGEN], 1u);
            else XB_SPIN(xb_ld(&bar[XB_TOPGEN]) == tg, bar);
            __builtin_amdgcn_fence(__ATOMIC_ACQUIRE, "agent");
            xb_add(&bar[XB_XGEN(b.x)], 1u);
            asm volatile("s_waitcnt vmcnt(0)" ::: "memory");
        } else {
            XB_SPIN(xb_ld(&bar[XB_XGEN(b.x)]) == gen, bar);
            __builtin_amdgcn_fence(__ATOMIC_ACQUIRE, "agent");
            asm volatile("s_waitcnt vmcnt(0)" ::: "memory");
        }
    }
    __syncthreads();
}
#ifndef DBG_PROBE
#define DBG_PROBE 0
#endif
#ifndef DBG_NOINTER
#define DBG_NOINTER 0
#endif
#ifndef DBG_LAYER
#define DBG_LAYER -1
#endif
#ifndef NAIVE_RET
#define NAIVE_RET 0
#endif
#ifndef NAIVE_LRU
#define NAIVE_LRU 0
#endif
constexpr int NB = 4, SEQ = 8192, DM = 1024, NCX = 256, NKEY = 8448, MLAT = 32768, MCTX = 1024, MALL = 33792, NIN = 3072, DFF = 2816;
constexpr float EPS = 1e-6f, LOG2E = 1.4426950408889634f;
constexpr int NWAVES = 8;
constexpr size_t MiB = 1u << 20, KiB = 1024;
constexpr size_t WS_CTL = 0, CTL_ZERO_BYTES = 1 * MiB;
constexpr size_t WS_WIN = 2 * MiB, WS_WOUT = 14 * MiB, WS_WF1 = 18 * MiB, WS_WF2 = 40 * MiB;
constexpr size_t SZ_WIN = 6 * MiB, SZ_WOUT = 2 * MiB, SZ_WF1 = 11 * MiB, SZ_WF2 = (size_t)1024 * 2816 * 2;
constexpr size_t WS_LRUW = 52 * MiB, SZ_LRUW = 128 * KiB;
constexpr size_t WS_MOD = 52 * MiB + 256 * KiB;
constexpr size_t WS_TAB = 52 * MiB + 512 * KiB;
constexpr size_t WS_LAM = 52 * MiB + 544 * KiB;
constexpr size_t WS_XC = 54 * MiB;
constexpr size_t WS_LSUM = 58 * MiB;
constexpr size_t WS_LCIN = 67 * MiB;
constexpr size_t WS_KVT = 72 * MiB;
constexpr size_t WS_SIN = 105 * MiB;
constexpr size_t WS_B = 122 * MiB;
constexpr size_t WS_A = 188 * MiB;
constexpr size_t WS_XRES = 386 * MiB;
constexpr size_t WS_END = 452 * MiB;
constexpr int CW_BAR = 4096, CW_Q = 8192;
constexpr int RING_BYTES = 131072, LDSCTL_OFF = RING_BYTES, MISC_OFF = LDSCTL_OFF + 320, LDS_BYTES = 147456;

typedef unsigned u32x2 __attribute__((ext_vector_type(2)));
typedef float f32x16 __attribute__((ext_vector_type(16)));
typedef short s16x4 __attribute__((ext_vector_type(4)));
typedef short v4i16_t __attribute__((ext_vector_type(4)));
typedef float f32x2_t __attribute__((ext_vector_type(2))); typedef __bf16 bf16x2_t __attribute__((ext_vector_type(2)));

__device__ __forceinline__ unsigned pk2(float lo, float hi) { f32x2_t v = {lo, hi}; bf16x2_t b = __builtin_convertvector(v, bf16x2_t); return __builtin_bit_cast(unsigned, b); }
__device__ __forceinline__ float bf2f(unsigned short u) { return __builtin_bit_cast(float, (unsigned)u << 16); }
__device__ __forceinline__ float bflo(unsigned w) { return __builtin_bit_cast(float, w << 16); }
__device__ __forceinline__ float bfhi(unsigned w) { return __builtin_bit_cast(float, w & 0xffff0000u); }
__device__ __forceinline__ float wave_sum(float v) {
#pragma unroll
    for (int o = 1; o < 64; o <<= 1) v += __shfl_xor(v, o);
    return v;
}
__device__ __forceinline__ float ex2(float x) { return __builtin_amdgcn_exp2f(x); }
__device__ __forceinline__ float rcp(float x) { return __builtin_amdgcn_rcpf(x); }
__device__ __forceinline__ float sigmoidf_(float x) { return rcp(1.0f + ex2(-x * LOG2E)); }
__device__ __forceinline__ float gelu_tanh(float x) { const float z = 0.7978845608028654f * (x + 0.044715f * x * x * x); const float e = ex2(2.0f * LOG2E * z); const float th = 1.0f - 2.0f * rcp(1.0f + e); return 0.5f * x * (1.0f + th); }
__device__ __forceinline__ float max3f(float a, float b, float c) { float r; asm("v_max3_f32 %0, %1, %2, %3" : "=v"(r) : "v"(a), "v"(b), "v"(c)); return r; }
__device__ __forceinline__ float max2f(float a, float b) { float r; asm("v_max_f32_e32 %0, %1, %2" : "=v"(r) : "v"(a), "v"(b)); return r; }
__device__ __forceinline__ void swap32(float v, float& lo, float& hi) { float a = v, b = v; asm volatile("s_nop 1\n\tv_permlane32_swap_b32 %0, %1" : "+v"(a), "+v"(b)); lo = a; hi = b; }
__device__ __forceinline__ float swap_max(float v) { float lo, hi; swap32(v, lo, hi); return max2f(lo, hi); }
__device__ __forceinline__ float swap_add(float v) { float lo, hi; swap32(v, lo, hi); return lo + hi; }
__device__ __forceinline__ int crow(int r, int hi) { return (r & 3) + 8 * (r >> 2) + 4 * hi; }
__device__ __forceinline__ s16x4 vtr(const LAS unsigned char* p) { return __builtin_bit_cast(s16x4, __builtin_amdgcn_ds_read_tr16_b64_v4i16((LAS v4i16_t*)p)); }
__device__ __forceinline__ bf16x8 mk8(s16x4 lo, s16x4 hi) { return (bf16x8){lo[0], lo[1], lo[2], lo[3], hi[0], hi[1], hi[2], hi[3]}; }
__device__ __forceinline__ bf16x8 pack8(float a0, float a1, float a2, float a3, float a4, float a5, float a6, float a7) {
    v4u w; w.x = pk2(a0, a1); w.y = pk2(a2, a3); w.z = pk2(a4, a5); w.w = pk2(a6, a7); return __builtin_bit_cast(bf16x8, w); }
#define MFMA32(a, b, c) __builtin_amdgcn_mfma_f32_32x32x16_bf16((a), (b), (c), 0, 0, 0)
#define MFMA16(a, b, c) __builtin_amdgcn_mfma_f32_16x16x32_bf16((a), (b), (c), 0, 0, 0)

struct Frame {
    LAS unsigned char* lds;
    int tid, lane, wave, vcu, G;
    const float* const __attribute__((address_space(4)))* kin; float* out; unsigned char* ws;
};
#define LAUNDER_IDS int tid_ = F.tid; asm volatile("" : "+v"(tid_)); int wid_ = F.wave; asm volatile("" : "+s"(wid_)); const int tid = tid_, lane = tid_ & 63, wid = wid_; (void)tid; (void)lane; (void)wid; const float* const __attribute__((address_space(4)))* kin_ = F.kin; asm volatile("" : "+s"(kin_));
#define FIN(i) (kin_[i])
#define IN_X 0
#define IN_C 1
#define IN_CTX 2
#define IN_CCTX 3
#define IN_WMOD 4
#define IN_BMOD 5
#define IN_GPREMIX 6
#define IN_GPOSTMIX 7
#define IN_GPREFFN 8
#define IN_GPOSTFFN 9
#define IN_WIN 10
#define IN_RPB 11
#define IN_CONVW 12
#define IN_CONVB 13
#define IN_GATEW 14
#define IN_GATEB 15
#define IN_LRULAM 16
#define IN_RETDECAY 17
#define IN_DIFFLAM 18
#define IN_SUBLN 19
#define IN_WOUT 20
#define IN_WF1 21
#define IN_WF2 22

__device__ __forceinline__ int perm_in(int n) {
    const int sec = n >> 8, p = n & 255, hh = p >> 6, ph = p & 63;
    if (sec == 5 || sec == 6) { const int G = ph >> 3, j = ph & 7; return sec * 256 + hh * 64 + ((j < 4) ? 4 * G + j : 32 + 4 * G + (j - 4)); }
    if (sec == 9 || sec == 10) { const int mp = ph >> 5, pm = ph & 31, G = pm >> 3, j = pm & 7; return sec * 256 + hh * 64 + mp * 32 + ((j < 4) ? 4 * G + j : 16 + 4 * G + (j - 4)); }
    return n;
}
__device__ __forceinline__ int perm_f1(int n) { const int pn = n >> 8, half = (n >> 7) & 1, i = n & 127; return half * 2816 + pn * 128 + i; }
template <int MAP> __device__ __forceinline__ void p0_transpose_item(const float* W, int K, int N, bf16* WT, LAS float* scr, int item, int lane) {
    const int nblk = N / 32, kb = item / nblk, nb = item % nblk, k0 = 64 * kb, n0 = 32 * nb;
    const int nphys = n0 + (lane & 31);
    const int nsrc = (MAP == 1) ? perm_in(nphys) : ((MAP == 2) ? perm_f1(nphys) : nphys);
    float wv[32];
#pragma unroll
    for (int i = 0; i < 32; ++i) wv[i] = W[(size_t)(k0 + 2 * i + (lane >> 5)) * N + nsrc];
#pragma unroll
    for (int i = 0; i < 32; ++i) scr[(2 * i + (lane >> 5)) * 33 + (lane & 31)] = wv[i];
    LDS_WAIT(); asm volatile("" ::: "memory");
    const int c = lane & 7;
#pragma unroll
    for (int j = 0; j < 4; ++j) { const int n = (lane >> 3) + 8 * j; const LAS float* s = scr + (8 * c) * 33 + n;
        v4u o; o.x = pk2(s[0 * 33], s[1 * 33]); o.y = pk2(s[2 * 33], s[3 * 33]); o.z = pk2(s[4 * 33], s[5 * 33]); o.w = pk2(s[6 * 33], s[7 * 33]);
        *(GAS v4u*)(WT + (size_t)(n0 + n) * K + k0 + 8 * c) = o; }
    LDS_WAIT(); asm volatile("" ::: "memory");
}
__device__ __forceinline__ void p0a(Frame& F) {
    LAUNDER_IDS
    if ((int)blockIdx.x < 192) {
        LAS float* sc = (LAS float*)F.lds; LAS float* red = (LAS float*)(F.lds + 20480);
        for (int i = tid; i < 5120; i += 512) { const float v = (i < 4096) ? FIN(IN_C)[i] : FIN(IN_CCTX)[i - 4096]; sc[i] = v * sigmoidf_(v); }
        __syncthreads();
        for (int item = blockIdx.x; item < 192; item += F.G) {
            const int l = item / 96, cg = item % 96, cl = tid & 63, ks = tid >> 6;
            const float* wm = FIN(IN_WMOD) + (size_t)l * 1024 * 6144 + cg * 64 + cl;
            float a0 = 0.f, a1 = 0.f, a2 = 0.f, a3 = 0.f, a4 = 0.f;
            for (int kb = ks * 128; kb < ks * 128 + 128; kb += 32) { float wv[32];
#pragma unroll
                for (int i = 0; i < 32; ++i) wv[i] = wm[(size_t)(kb + i) * 6144];
#pragma unroll
                for (int i = 0; i < 32; ++i) { const int k = kb + i; const float w = wv[i]; a0 += sc[k] * w; a1 += sc[1024 + k] * w; a2 += sc[2048 + k] * w; a3 += sc[3072 + k] * w; a4 += sc[4096 + k] * w; } }
            red[(ks * 5 + 0) * 64 + cl] = a0; red[(ks * 5 + 1) * 64 + cl] = a1; red[(ks * 5 + 2) * 64 + cl] = a2; red[(ks * 5 + 3) * 64 + cl] = a3; red[(ks * 5 + 4) * 64 + cl] = a4;
            __syncthreads();
            if (tid < 320) { const int s = tid >> 6; float sum = 0.f;
#pragma unroll
                for (int k2 = 0; k2 < 8; ++k2) sum += red[(k2 * 5 + s) * 64 + cl];
                ((float*)(F.ws + WS_MOD))[(size_t)(l * 5 + s) * 6144 + cg * 64 + cl] = sum + FIN(IN_BMOD)[l * 6144 + cg * 64 + cl]; }
            __syncthreads();
        }
    }
    if ((int)blockIdx.x == F.G - 1) {
        if (tid < 16) {
            double th = 1.0; for (int i = 0; i < tid; ++i) th *= 0.5623413251903491;
            const double t2 = th * th; double s = 1.0, c = 1.0;
            for (int n = 14; n >= 1; --n) { s = 1.0 - s * t2 / (double)((2 * n) * (2 * n + 1)); c = 1.0 - c * t2 / (double)((2 * n - 1) * (2 * n)); }
            s *= th;
            float* Rc = (float*)(F.ws + WS_TAB); float* Rs = Rc + 2048; float* Dc = Rs + 2048; float* Ds = Dc + 1024;
            double cp = 1.0, sp = 0.0;
            for (int p = 0; p < 128; ++p) { Rc[p * 16 + tid] = (float)cp; Rs[p * 16 + tid] = (float)sp;
                if ((tid & 1) == 0) { Dc[p * 8 + (tid >> 1)] = (float)cp; Ds[p * 8 + (tid >> 1)] = (float)sp; }
                const double cn = cp * c - sp * s, sn = sp * c + cp * s; cp = cn; sp = sn; }
        }
        if (tid >= 64 && tid < 66) { const int l = tid - 64; const float* dl = FIN(IN_DIFFLAM) + l * 128; float d1 = 0.f, d2 = 0.f;
            for (int i = 0; i < 32; ++i) { d1 += dl[i] * dl[32 + i]; d2 += dl[64 + i] * dl[96 + i]; }
            const float lam_init = (l == 0) ? 0.2f : 0.35550906759f;
            ((float*)(F.ws + WS_LAM))[l] = expf(d1) - expf(d2) + lam_init; }
    }
    for (int idx = F.vcu * 512 + tid; idx < 1024; idx += F.G * 512) ((float*)(F.ws + WS_LAM + 4096))[idx] = log1pf(expf(-FIN(IN_LRULAM)[idx])) * (-8.0f * LOG2E);
    for (int idx = F.vcu * 512 + tid; idx < 131072; idx += F.G * 512) { const int c = idx & 63, d = (idx >> 6) & 63, rest = idx >> 12;
        ((bf16*)(F.ws + WS_LRUW))[idx] = (bf16)f2bf(FIN(IN_GATEW)[(size_t)rest * 4096 + c * 64 + d]); }
    __syncthreads();
    LAS float* scr = (LAS float*)(F.lds + wid * 16384);
    const int gw = F.vcu * NWAVES + wid, NGW = F.G * NWAVES;
    constexpr int I_IN = 16 * 96, I_OUT = 16 * 32, I_F1 = 16 * 176, I_F2 = 44 * 32, I_L = I_IN + I_OUT + I_F1 + I_F2;
    for (int it = gw; it < 2 * I_L; it += NGW) {
        const int l = it / I_L; int r = it % I_L;
        if (r < I_IN) { p0_transpose_item<1>(FIN(IN_WIN) + (size_t)l * 1024 * 3072, 1024, 3072, (bf16*)(F.ws + WS_WIN + l * SZ_WIN), scr, r, lane); continue; } r -= I_IN;
        if (r < I_OUT) { p0_transpose_item<0>(FIN(IN_WOUT) + (size_t)l * 1024 * 1024, 1024, 1024, (bf16*)(F.ws + WS_WOUT + l * SZ_WOUT), scr, r, lane); continue; } r -= I_OUT;
        if (r < I_F1) { p0_transpose_item<2>(FIN(IN_WF1) + (size_t)l * 1024 * 5632, 1024, 5632, (bf16*)(F.ws + WS_WF1 + l * SZ_WF1), scr, r, lane); continue; } r -= I_F1;
        p0_transpose_item<0>(FIN(IN_WF2) + (size_t)l * 2816 * 1024, 2816, 1024, (bf16*)(F.ws + WS_WF2 + l * SZ_WF2), scr, r, lane);
    }
}

__device__ __forceinline__ void ld_row_f32(const float* row, int lane, f32x4 (&v)[4]) {
#pragma unroll
    for (int j = 0; j < 4; ++j) v[j] = *(const f32x4*)(row + 4 * lane + 256 * j);
}
__device__ __forceinline__ void ld_row_bf16(const bf16* row, int lane, f32x4 (&v)[4]) {
#pragma unroll
    for (int j = 0; j < 4; ++j) { const u32x2 w = *(const u32x2*)(row + 4 * lane + 256 * j); v[j] = (f32x4){bflo(w.x), bfhi(w.x), bflo(w.y), bfhi(w.y)}; }
}
__device__ __forceinline__ float row_rstd(const f32x4 (&v)[4]) {
    float s = 0.f;
#pragma unroll
    for (int j = 0; j < 4; ++j) s += (v[j].x * v[j].x + v[j].y * v[j].y) + (v[j].z * v[j].z + v[j].w * v[j].w);
    return 1.0f / sqrtf(wave_sum(s) * (1.0f / 1024.0f) + EPS);
}
__device__ __forceinline__ void st_modulated(bf16* orow, int lane, const f32x4 (&v)[4], float rstd, const float* g, const float* shift, const float* scale) {
#pragma unroll
    for (int j = 0; j < 4; ++j) { const int c = 4 * lane + 256 * j; const f32x4 gg = *(const f32x4*)(g + c), sh = *(const f32x4*)(shift + c), scl = *(const f32x4*)(scale + c);
        const f32x4 o = v[j] * rstd * gg * (scl + 1.0f) + sh;
        u32x2 w; w.x = pk2(o.x, o.y); w.y = pk2(o.z, o.w); *(u32x2*)(orow + c) = w; }
}
__device__ __forceinline__ const float* mod_ptr(Frame& F, int l, int m) { const int slot = (m < MLAT) ? (m >> 13) : 4; return (const float*)(F.ws + WS_MOD) + (size_t)(l * 5 + slot) * 6144; }
#define ROWCOL(j) (4 * lane + 256 * (j))
__device__ __forceinline__ float rstd_of(const f32x4 (&v)[4]) { return row_rstd(v); }
#define ROW_PIPE3(ma, mb, LD, BODY) do { const int n_ = (mb) - (ma); if (n_ > 0) { const int last_ = (mb) - 1; LD((ma), 0); LD(min((ma) + 1, last_), 1); const int T_ = n_ / 3; int r_ = (ma); \
        for (int t_ = 0; t_ < T_; ++t_, r_ += 3) { LD(min(r_ + 2, last_), 2); BODY(r_, 0); LD(min(r_ + 3, last_), 0); BODY(r_ + 1, 1); LD(min(r_ + 4, last_), 1); BODY(r_ + 2, 2); } \
        const int rem_ = n_ - 3 * T_; if (rem_ >= 1) { BODY(r_, 0); if (rem_ == 2) BODY(r_ + 1, 1); } } } while (0)
#define ROW_SEG_END(a, mhi_) (((a) < MLAT) ? min((mhi_), min(MLAT, (((a) >> 13) + 1) << 13)) : (mhi_))
__device__ __forceinline__ void p0b(Frame& F) {
    LAUNDER_IDS
    const int gw = F.vcu * NWAVES + wid, NGW = F.G * NWAVES, R = (MALL + NGW - 1) / NGW, m0 = gw * R, m1 = min(MALL, m0 + R);
    bf16* H = (bf16*)(F.ws + WS_B);
    f32x4 G[4], Sh[4], Sc[4], xb[3][4];
#pragma unroll
    for (int j = 0; j < 4; ++j) G[j] = *(const f32x4*)(FIN(IN_GPREMIX) + ROWCOL(j));
#define P0B_SRC(m) (((m) < MLAT) ? FIN(IN_X) + (size_t)(m) * DM : FIN(IN_CTX) + (size_t)((m) - MLAT) * DM)
#define P0B_LD(m, B) do { const float* s_ = P0B_SRC(m); _Pragma("unroll") for (int j_ = 0; j_ < 4; ++j_) xb[B][j_] = *(const f32x4*)(s_ + ROWCOL(j_)); } while (0)
#define P0B_BODY(m, B) do { const float rstd_ = row_rstd(xb[B]); \
        _Pragma("unroll") for (int j_ = 0; j_ < 4; ++j_) { const f32x4 o_ = xb[B][j_] * rstd_ * G[j_] * Sc[j_] + Sh[j_]; u32x2 w_; w_.x = pk2(o_.x, o_.y); w_.y = pk2(o_.z, o_.w); *(u32x2*)(H + (size_t)(m) * DM + ROWCOL(j_)) = w_; } } while (0)
    for (int a = m0; a < m1; ) { const int e = ROW_SEG_END(a, m1), slot = (a < MLAT) ? (a >> 13) : 4; const float* mp = (const float*)(F.ws + WS_MOD) + (size_t)slot * 6144;
#pragma unroll
        for (int j = 0; j < 4; ++j) { Sh[j] = *(const f32x4*)(mp + ROWCOL(j)); Sc[j] = *(const f32x4*)(mp + 1024 + ROWCOL(j)) + 1.0f; }
        ROW_PIPE3(a, e, P0B_LD, P0B_BODY); a = e; }
#undef P0B_SRC
#undef P0B_LD
#undef P0B_BODY
}
__device__ __forceinline__ f32x4 bf4(u32x2 w) { return (f32x4){bflo(w.x), bfhi(w.x), bflo(w.y), bfhi(w.y)}; }
template <bool F32SRC>
__device__ __forceinline__ void e2_rows(Frame& F, int l, int mlo, int mhi, int wg_rank, int wg_count) {
    LAUNDER_IDS
    const int gw = wg_rank * NWAVES + wid, NGW = wg_count * NWAVES, R = (mhi - mlo + NGW - 1) / NGW, m0 = mlo + gw * R, m1 = min(mhi, m0 + R);
    const bf16* Y = (const bf16*)(F.ws + WS_A); bf16* H2 = (bf16*)(F.ws + WS_B); bf16* XR = (bf16*)(F.ws + WS_XRES);
    f32x4 Gp[4], Gf[4], Gate[4], Sh[4], Sc[4], xf[3][4]; u32x2 xh[3][4], yb[3][4];
#pragma unroll
    for (int j = 0; j < 4; ++j) { Gp[j] = *(const f32x4*)(FIN(IN_GPOSTMIX) + l * 1024 + ROWCOL(j)); Gf[j] = *(const f32x4*)(FIN(IN_GPREFFN) + l * 1024 + ROWCOL(j)); }
#define E2_SRC(m) (((m) < MLAT) ? FIN(IN_X) + (size_t)(m) * DM : FIN(IN_CTX) + (size_t)((m) - MLAT) * DM)
#define E2_LD(m, B) do { if (F32SRC) { const float* s_ = E2_SRC(m); _Pragma("unroll") for (int j_ = 0; j_ < 4; ++j_) xf[B][j_] = *(const f32x4*)(s_ + ROWCOL(j_)); } \
        else { _Pragma("unroll") for (int j_ = 0; j_ < 4; ++j_) xh[B][j_] = *(const u32x2*)(XR + (size_t)(m) * DM + ROWCOL(j_)); } \
        _Pragma("unroll") for (int j_ = 0; j_ < 4; ++j_) yb[B][j_] = *(const u32x2*)(Y + (size_t)(m) * DM + ROWCOL(j_)); } while (0)
#define E2_BODY(m, B) do { f32x4 y_[4], x_[4]; \
        _Pragma("unroll") for (int j_ = 0; j_ < 4; ++j_) { y_[j_] = bf4(yb[B][j_]); x_[j_] = F32SRC ? xf[B][j_] : bf4(xh[B][j_]); } \
        const float rstd_ = row_rstd(y_); \
        _Pragma("unroll") for (int j_ = 0; j_ < 4; ++j_) { x_[j_] = x_[j_] + Gate[j_] * (y_[j_] * rstd_ * Gp[j_]); u32x2 w_; w_.x = pk2(x_[j_].x, x_[j_].y); w_.y = pk2(x_[j_].z, x_[j_].w); *(u32x2*)(XR + (size_t)(m) * DM + ROWCOL(j_)) = w_; } \
        const float rstd2_ = row_rstd(x_); \
        _Pragma("unroll") for (int j_ = 0; j_ < 4; ++j_) { const f32x4 o_ = x_[j_] * rstd2_ * Gf[j_] * Sc[j_] + Sh[j_]; u32x2 w_; w_.x = pk2(o_.x, o_.y); w_.y = pk2(o_.z, o_.w); *(u32x2*)(H2 + (size_t)(m) * DM + ROWCOL(j_)) = w_; } } while (0)
    for (int a = m0; a < m1; ) { const int e = ROW_SEG_END(a, m1), slot = (a < MLAT) ? (a >> 13) : 4; const float* mp = (const float*)(F.ws + WS_MOD) + (size_t)(l * 5 + slot) * 6144;
#pragma unroll
        for (int j = 0; j < 4; ++j) { Gate[j] = *(const f32x4*)(mp + 2048 + ROWCOL(j)); Sh[j] = *(const f32x4*)(mp + 3072 + ROWCOL(j)); Sc[j] = *(const f32x4*)(mp + 4096 + ROWCOL(j)) + 1.0f; }
        ROW_PIPE3(a, e, E2_LD, E2_BODY); a = e; }
#undef E2_SRC
#undef E2_LD
#undef E2_BODY
}
__device__ __forceinline__ void e2_phase(Frame& F, int l, int mlo, int mhi, int wg_rank, int wg_count) { if (l == 0) e2_rows<true>(F, l, mlo, mhi, wg_rank, wg_count); else e2_rows<false>(F, l, mlo, mhi, wg_rank, wg_count); }
template <bool LAST, bool PART2 = false>
__device__ __forceinline__ void e3_rows(Frame& F, int l, int mlo, int mhi, int wg_rank, int wg_count, const bf16* Y2 = nullptr) {
    LAUNDER_IDS
    const int gw = wg_rank * NWAVES + wid, NGW = wg_count * NWAVES, R = (mhi - mlo + NGW - 1) / NGW, m0 = mlo + gw * R, m1 = min(mhi, m0 + R);
    bf16* YB = (bf16*)(F.ws + WS_B); bf16* XR = (bf16*)(F.ws + WS_XRES);
    f32x4 Gp[4], Gn[4], Gate[4], Sh[4], Sc[4]; u32x2 xb[3][4], yb[3][4], y2[3][4];
#pragma unroll
    for (int j = 0; j < 4; ++j) { Gp[j] = *(const f32x4*)(FIN(IN_GPOSTFFN) + l * 1024 + ROWCOL(j)); Gn[j] = *(const f32x4*)(FIN(IN_GPREMIX) + 1024 + ROWCOL(j)); }
#define E3_LD(m, B) do { _Pragma("unroll") for (int j_ = 0; j_ < 4; ++j_) { xb[B][j_] = *(const u32x2*)(XR + (size_t)(m) * DM + ROWCOL(j_)); yb[B][j_] = *(const u32x2*)(YB + (size_t)(m) * DM + ROWCOL(j_)); \
        if (PART2) y2[B][j_] = *(const u32x2*)(Y2 + (size_t)(m) * DM + ROWCOL(j_)); } } while (0)
#define E3_BODY(m, B) do { f32x4 y_[4], x_[4]; \
        _Pragma("unroll") for (int j_ = 0; j_ < 4; ++j_) { y_[j_] = bf4(yb[B][j_]); if (PART2) y_[j_] = y_[j_] + bf4(y2[B][j_]); x_[j_] = bf4(xb[B][j_]); } \
        const float rstd_ = row_rstd(y_); \
        _Pragma("unroll") for (int j_ = 0; j_ < 4; ++j_) x_[j_] = x_[j_] + Gate[j_] * (y_[j_] * rstd_ * Gp[j_]); \
        if (!LAST) { \
            _Pragma("unroll") for (int j_ = 0; j_ < 4; ++j_) { u32x2 w_; w_.x = pk2(x_[j_].x, x_[j_].y); w_.y = pk2(x_[j_].z, x_[j_].w); *(u32x2*)(XR + (size_t)(m) * DM + ROWCOL(j_)) = w_; } \
            const float rstd2_ = row_rstd(x_); \
            _Pragma("unroll") for (int j_ = 0; j_ < 4; ++j_) { const f32x4 o_ = x_[j_] * rstd2_ * Gn[j_] * Sc[j_] + Sh[j_]; u32x2 w_; w_.x = pk2(o_.x, o_.y); w_.y = pk2(o_.z, o_.w); *(u32x2*)(YB + (size_t)(m) * DM + ROWCOL(j_)) = w_; } \
        } else { \
            _Pragma("unroll") for (int j_ = 0; j_ < 4; ++j_) *(f32x4*)(F.out + (size_t)(m) * DM + ROWCOL(j_)) = x_[j_]; \
        } } while (0)
    for (int a = m0; a < m1; ) { const int e = ROW_SEG_END(a, m1), slot = (a < MLAT) ? (a >> 13) : 4;
        const float* mp = (const float*)(F.ws + WS_MOD) + (size_t)(l * 5 + slot) * 6144; const float* mp1 = (const float*)(F.ws + WS_MOD) + (size_t)(5 + slot) * 6144;
#pragma unroll
        for (int j = 0; j < 4; ++j) { Gate[j] = *(const f32x4*)(mp + 5120 + ROWCOL(j)); if (!LAST) { Sh[j] = *(const f32x4*)(mp1 + ROWCOL(j)); Sc[j] = *(const f32x4*)(mp1 + 1024 + ROWCOL(j)) + 1.0f; } }
        ROW_PIPE3(a, e, E3_LD, E3_BODY); a = e; }
#undef E3_LD
#undef E3_BODY
}
__device__ __forceinline__ void e3_phase(Frame& F, int l, int mlo, int mhi, int wg_rank, int wg_count) { if (l == 0) e3_rows<false>(F, l, mlo, mhi, wg_rank, wg_count); else e3_rows<true>(F, l, mlo, mhi, wg_rank, wg_count); }
constexpr int ATT_KB = 0, ATT_VB = 16384, ATT_BIAS = 32768;
template <int MODE> __device__ __forceinline__ void attn_unit(Frame& F, int l, int b, int h, int blk) {
    constexpr bool DIFF = (MODE == 0 || MODE == 2), LAT = (MODE < 2);
    constexpr int SQ = DIFF ? 9 : 0, SK = DIFF ? 10 : 1, SV = DIFF ? 11 : 2, NMAP = DIFF ? 2 : 1, NDS = DIFF ? 2 : 4;
    LAUNDER_IDS
    const int r32 = lane & 31, hi = lane >> 5;
    const bf16* P = (const bf16*)(F.ws + WS_A); bf16* Y = (bf16*)(F.ws + WS_B);
    LAS unsigned char* lds = F.lds;
    const int qtok = (LAT ? blk * 256 : 0) + wid * 32 + r32;
    const size_t qprow = (size_t)b * NKEY + (LAT ? 256 : 0) + qtok;
    const size_t ygrow = LAT ? (size_t)b * SEQ + qtok : (size_t)MLAT + b * 256 + qtok;
    int nt, nwin = 0, kr0 = 0;
    if (MODE == 0) nt = 132;
    else if (MODE == 1) { const int R = blk * 4; kr0 = min(max(R - 4, 0), 120); const int krl = min(max(R + 3 - 4, 0), 120) + 7; nwin = krl - kr0 + 1; nt = nwin + 4; }
    else nt = 4;
    const int qrow = blk * 4 + (wid >> 1), qcol = 32 * (wid & 1) + r32;
    const int r0q = min(max(qrow - 4, 0), 120), csq = min(max(qcol - 8, 0), 48);
    const int srow = tid >> 3, sch = tid & 7;
    const int koff = srow * 128 + ((sch ^ ((srow >> 1) & 7)) << 4);
    const int voff = (sch >> 2) * 4096 + (srow >> 3) * 512 + (srow & 7) * 64 + (sch & 3) * 16;
    const bf16* kvbase = P + (size_t)srow * NIN + h * 64 + sch * 8;
#define TILE_PROW(j) ((size_t)b * NKEY + ((MODE == 1) ? (((j) < nwin) ? 256 + (kr0 + (j)) * 64 : 64 * ((j) - nwin)) : 64 * (j)))
    bf16x8 qr[4];
#pragma unroll
    for (int d0 = 0; d0 < 4; ++d0) qr[d0] = *(const bf16x8*)(P + qprow * NIN + SQ * 256 + h * 64 + d0 * 16 + hi * 8);
    unsigned ipk[8] = {0u, 0u, 0u, 0u, 0u, 0u, 0u, 0u};
    if (MODE == 1) { LAS float* bl = (LAS float*)(lds + ATT_BIAS); const float* rp = FIN(IN_RPB) + (size_t)(l * 4 + h) * 465;
        for (int i = tid; i < 495; i += 512) { const int dr = i / 33, dc = i % 33; bl[i] = (dc < 31) ? rp[dr * 31 + dc] * LOG2E : ((dc == 32) ? -1e30f : 0.f); }
#pragma unroll
        for (int e = 0; e < 32; ++e) { const int r = e & 15, kc = (r & 3) + 8 * (r >> 2) + 4 * hi + 32 * (e >> 4);
            const unsigned off = ((unsigned)(kc - csq) < 16u) ? (unsigned)(((kc - qcol + 15) & 31) * 4) : 128u;
            ipk[e >> 2] |= off << (8 * (e & 3)); } }
    f32x16 o[NMAP][2]; float mrun[NMAP], lrun[NMAP];
#pragma unroll
    for (int mp = 0; mp < NMAP; ++mp) { mrun[mp] = -1e30f; lrun[mp] = 0.f;
#pragma unroll
        for (int d0 = 0; d0 < 2; ++d0)
#pragma unroll
            for (int r = 0; r < 16; ++r) o[mp][d0][r] = 0.f; }
    { const bf16* src = kvbase + TILE_PROW(0) * NIN; const v4u kk = *(const v4u*)(src + SK * 256), vv = *(const v4u*)(src + SV * 256);
      *(LAS v4u*)(lds + ATT_KB + koff) = kk; *(LAS v4u*)(lds + ATT_VB + voff) = vv; }
    __syncthreads();
    const int kfo = r32 * 128, ksw = (r32 >> 1) & 7;
    const int vb = ((lane >> 4) & 1) * 32 + (lane & 3) * 8 + (4 * hi + ((lane & 15) >> 2)) * 64;
    v4u krg[2], vrg[2];
#define ATT_GLD(dst, ptr) asm volatile("global_load_dwordx4 %0, %1, off" : "=&v"(dst) : "v"(ptr) : "memory")
    { const bf16* src = kvbase + TILE_PROW(min(1, nt - 1)) * NIN; const bf16* pk_ = src + SK * 256; const bf16* pv_ = src + SV * 256; ATT_GLD(krg[1], pk_); ATT_GLD(vrg[1], pv_); }
    for (int j0 = 0; j0 < nt; j0 += 2) {
#pragma unroll
      for (int u = 0; u < 2; ++u) {
        const int j = j0 + u; const int cur = u;
        { const bf16* src = kvbase + TILE_PROW(min(j + 2, nt - 1)) * NIN; const bf16* pk_ = src + SK * 256; const bf16* pv_ = src + SV * 256; ATT_GLD(krg[u], pk_); ATT_GLD(vrg[u], pv_); }
        bool act = (j < nt);
        if (MODE == 1) { if (j < nwin) { const int d = kr0 + j - r0q; act = (d >= 0 && d < 8); } }
        if (act) {
            const LAS unsigned char* kb = lds + ATT_KB + cur * 8192; const LAS unsigned char* vbp = lds + ATT_VB + cur * 8192 + vb;
            bf16x8 vf[4][2];
#pragma unroll
            for (int ks = 0; ks < 4; ++ks)
#pragma unroll
                for (int d0 = 0; d0 < 2; ++d0) vf[ks][d0] = mk8(vtr(vbp + d0 * 4096 + ks * 1024), vtr(vbp + d0 * 4096 + ks * 1024 + 512));
#pragma unroll
            for (int mp = 0; mp < NMAP; ++mp) {
                f32x16 c0, c1;
#pragma unroll
                for (int r = 0; r < 16; ++r) { c0[r] = 0.f; c1[r] = 0.f; }
#pragma unroll
                for (int ds = 0; ds < NDS; ++ds) { const int dstep = mp * 2 + ds; const int chunk = 2 * dstep + hi;
                    const LAS unsigned char* kp = kb + kfo + ((chunk ^ ksw) << 4);
                    const bf16x8 k0 = *(const LAS bf16x8*)kp, k1 = *(const LAS bf16x8*)(kp + 4096);
                    c0 = MFMA32(k0, qr[dstep], c0); c1 = MFMA32(k1, qr[dstep], c1); }
                if (MODE == 1) { if (j < nwin) { const LAS unsigned char* bb = lds + ATT_BIAS + (kr0 + j - qrow + 7) * 132;
#pragma unroll
                    for (int r = 0; r < 16; ++r) { const unsigned o0 = (ipk[r >> 2] >> (8 * (r & 3))) & 0xFFu, o1 = (ipk[4 + (r >> 2)] >> (8 * (r & 3))) & 0xFFu;
                        c0[r] += *(const LAS float*)(bb + o0); c1[r] += *(const LAS float*)(bb + o1); } } }
                float rm = max3f(c0[0], c0[1], c1[0]), rm2 = max3f(c0[2], c0[3], c1[1]); rm = max3f(rm, c1[2], c1[3]);
#pragma unroll
                for (int r = 4; r < 16; r += 4) { rm = max3f(rm, c0[r], c0[r + 1]); rm2 = max3f(rm2, c0[r + 2], c0[r + 3]); rm = max3f(rm, c1[r], c1[r + 1]); rm2 = max3f(rm2, c1[r + 2], c1[r + 3]); }
                rm = swap_max(max2f(rm, rm2));
                if (__any(rm > mrun[mp] + 6.0f)) { const float mn = max2f(mrun[mp], rm), f = ex2(mrun[mp] - mn); mrun[mp] = mn; lrun[mp] *= f;
#pragma unroll
                    for (int r = 0; r < 16; ++r) { o[mp][0][r] *= f; o[mp][1][r] *= f; } }
                const float mm = mrun[mp]; float ps = 0.f;
#pragma unroll
                for (int r = 0; r < 16; ++r) { c0[r] = ex2(c0[r] - mm); c1[r] = ex2(c1[r] - mm); ps += c0[r] + c1[r]; }
                lrun[mp] += ps;
                const bf16x8 p0 = pack8(c0[0], c0[1], c0[2], c0[3], c0[4], c0[5], c0[6], c0[7]), p1 = pack8(c0[8], c0[9], c0[10], c0[11], c0[12], c0[13], c0[14], c0[15]);
                const bf16x8 p2 = pack8(c1[0], c1[1], c1[2], c1[3], c1[4], c1[5], c1[6], c1[7]), p3 = pack8(c1[8], c1[9], c1[10], c1[11], c1[12], c1[13], c1[14], c1[15]);
#pragma unroll
                for (int d0 = 0; d0 < 2; ++d0) { o[mp][d0] = MFMA32(vf[0][d0], p0, o[mp][d0]); o[mp][d0] = MFMA32(vf[1][d0], p1, o[mp][d0]); o[mp][d0] = MFMA32(vf[2][d0], p2, o[mp][d0]); o[mp][d0] = MFMA32(vf[3][d0], p3, o[mp][d0]); }
            }
        }
        asm volatile("s_waitcnt vmcnt(2)" : "+v"(krg[u ^ 1]), "+v"(vrg[u ^ 1]) :: "memory");
        if (j + 1 < nt) { *(LAS v4u*)(lds + ATT_KB + (cur ^ 1) * 8192 + koff) = krg[u ^ 1]; *(LAS v4u*)(lds + ATT_VB + (cur ^ 1) * 8192 + voff) = vrg[u ^ 1]; }
        __syncthreads();
      }
    }
    asm volatile("s_waitcnt vmcnt(0)" : "+v"(krg[0]), "+v"(vrg[0]), "+v"(krg[1]), "+v"(vrg[1]) :: "memory");
#undef ATT_GLD
#undef TILE_PROW
    if (DIFF) {
        const float lam = ((const float*)(F.ws + WS_LAM))[l]; const float omli = (l == 0) ? 0.8f : 0.64449093241f;
        const float i1 = 1.0f / swap_add(lrun[0]), i2 = lam / swap_add(lrun[NMAP - 1]);
        float ss = 0.f;
#pragma unroll
        for (int d0 = 0; d0 < 2; ++d0)
#pragma unroll
            for (int r = 0; r < 16; ++r) { const float y = o[0][d0][r] * i1 - o[NMAP - 1][d0][r] * i2; o[0][d0][r] = y; ss += y * y; }
        ss = swap_add(ss);
        const float rs = omli / sqrtf(ss * (1.0f / 64.0f) + EPS); const float* sg = FIN(IN_SUBLN) + l * 64;
#pragma unroll
        for (int d0 = 0; d0 < 2; ++d0)
#pragma unroll
            for (int rg = 0; rg < 4; ++rg) { const int dv = 32 * d0 + 8 * rg + 4 * hi; const f32x4 g4 = *(const f32x4*)(sg + dv);
                u32x2 w; w.x = pk2(o[0][d0][4 * rg] * rs * g4.x, o[0][d0][4 * rg + 1] * rs * g4.y); w.y = pk2(o[0][d0][4 * rg + 2] * rs * g4.z, o[0][d0][4 * rg + 3] * rs * g4.w);
                *(u32x2*)(Y + ygrow * DM + 768 + h * 64 + dv) = w; }
    } else {
        const float i1 = 1.0f / swap_add(lrun[0]);
#pragma unroll
        for (int d0 = 0; d0 < 2; ++d0)
#pragma unroll
            for (int rg = 0; rg < 4; ++rg) { const int dv = 32 * d0 + 8 * rg + 4 * hi;
                u32x2 w; w.x = pk2(o[0][d0][4 * rg] * i1, o[0][d0][4 * rg + 1] * i1); w.y = pk2(o[0][d0][4 * rg + 2] * i1, o[0][d0][4 * rg + 3] * i1);
                *(u32x2*)(Y + ygrow * DM + h * 64 + dv) = w; }
    }
}
template <int MODE> __device__ __forceinline__ void attn_unit_s(Frame& F, int l, int b, int h, int blk) {
    constexpr bool DIFF = (MODE == 0 || MODE == 2), LAT = (MODE < 2);
    constexpr int SQ = DIFF ? 9 : 0, SK = DIFF ? 10 : 1, SV = DIFF ? 11 : 2, NMAP = DIFF ? 2 : 1, NDS = DIFF ? 2 : 4;
    LAUNDER_IDS
    const int r32 = lane & 31, hi = lane >> 5;
    const bf16* P = (const bf16*)(F.ws + WS_A); bf16* Y = (bf16*)(F.ws + WS_B);
    LAS unsigned char* lds = F.lds;
    const int qtok = (LAT ? blk * 256 : 0) + wid * 32 + r32;
    const size_t qprow = (size_t)b * NKEY + (LAT ? 256 : 0) + qtok;
    const size_t ygrow = LAT ? (size_t)b * SEQ + qtok : (size_t)MLAT + b * 256 + qtok;
    int nt, nwin = 0, kr0 = 0;
    if (MODE == 0) nt = 132;
    else if (MODE == 1) { const int R = blk * 4; kr0 = min(max(R - 4, 0), 120); const int krl = min(max(R + 3 - 4, 0), 120) + 7; nwin = krl - kr0 + 1; nt = nwin + 4; }
    else nt = 4;
    const int qrow = blk * 4 + (wid >> 1), qcol = 32 * (wid & 1) + r32;
    const int r0q = min(max(qrow - 4, 0), 120), csq = min(max(qcol - 8, 0), 48);
    const int srow = tid >> 3, sch = tid & 7;
    const int koff = srow * 128 + ((sch ^ ((srow >> 1) & 7)) << 4);
    const int voff = (sch >> 2) * 4096 + (srow >> 3) * 512 + (srow & 7) * 64 + (sch & 3) * 16;
    const bf16* kvbase = P + (size_t)srow * NIN + h * 64 + sch * 8;
#define TILE_PROW(j) ((size_t)b * NKEY + ((MODE == 1) ? (((j) < nwin) ? 256 + (kr0 + (j)) * 64 : 64 * ((j) - nwin)) : 64 * (j)))
    bf16x8 qr[4];
#pragma unroll
    for (int d0 = 0; d0 < 4; ++d0) qr[d0] = *(const bf16x8*)(P + qprow * NIN + SQ * 256 + h * 64 + d0 * 16 + hi * 8);
    unsigned ipk[8] = {0u, 0u, 0u, 0u, 0u, 0u, 0u, 0u};
    if (MODE == 1) { LAS float* bl = (LAS float*)(lds + ATT_BIAS); const float* rp = FIN(IN_RPB) + (size_t)(l * 4 + h) * 465;
        for (int i = tid; i < 495; i += 512) { const int dr = i / 33, dc = i % 33; bl[i] = (dc < 31) ? rp[dr * 31 + dc] * LOG2E : ((dc == 32) ? -1e30f : 0.f); }
#pragma unroll
        for (int e = 0; e < 32; ++e) { const int r = e & 15, kc = (r & 3) + 8 * (r >> 2) + 4 * hi + 32 * (e >> 4);
            const unsigned off = ((unsigned)(kc - csq) < 16u) ? (unsigned)(((kc - qcol + 15) & 31) * 4) : 128u;
            ipk[e >> 2] |= off << (8 * (e & 3)); } }
    f32x16 o[NMAP][2]; float mrun[NMAP], lrun[NMAP];
#pragma unroll
    for (int mp = 0; mp < NMAP; ++mp) { mrun[mp] = -1e30f; lrun[mp] = 0.f;
#pragma unroll
        for (int d0 = 0; d0 < 2; ++d0)
#pragma unroll
            for (int r = 0; r < 16; ++r) o[mp][d0][r] = 0.f; }
    { const bf16* src = kvbase + TILE_PROW(0) * NIN; const v4u kk = *(const v4u*)(src + SK * 256), vv = *(const v4u*)(src + SV * 256);
      *(LAS v4u*)(lds + ATT_KB + koff) = kk; *(LAS v4u*)(lds + ATT_VB + voff) = vv; }
    __syncthreads();
    const int kfo = r32 * 128, ksw = (r32 >> 1) & 7;
    const int vb = ((lane >> 4) & 1) * 32 + (lane & 3) * 8 + (4 * hi + ((lane & 15) >> 2)) * 64;
    for (int j = 0; j < nt; ++j) {
        const int cur = j & 1;
        v4u kn, vn;
        if (j + 1 < nt) { const bf16* src = kvbase + TILE_PROW(j + 1) * NIN; kn = *(const v4u*)(src + SK * 256); vn = *(const v4u*)(src + SV * 256); }
        bool act = true;
        if (MODE == 1) { if (j < nwin) { const int d = kr0 + j - r0q; act = (d >= 0 && d < 8); } }
        if (act) {
            const LAS unsigned char* kb = lds + ATT_KB + cur * 8192; const LAS unsigned char* vbp = lds + ATT_VB + cur * 8192 + vb;
            bf16x8 vf[4][2];
#pragma unroll
            for (int ks = 0; ks < 4; ++ks)
#pragma unroll
                for (int d0 = 0; d0 < 2; ++d0) vf[ks][d0] = mk8(vtr(vbp + d0 * 4096 + ks * 1024), vtr(vbp + d0 * 4096 + ks * 1024 + 512));
#pragma unroll
            for (int mp = 0; mp < NMAP; ++mp) {
                f32x16 c0, c1;
#pragma unroll
                for (int r = 0; r < 16; ++r) { c0[r] = 0.f; c1[r] = 0.f; }
#pragma unroll
                for (int ds = 0; ds < NDS; ++ds) { const int dstep = mp * 2 + ds; const int chunk = 2 * dstep + hi;
                    const LAS unsigned char* kp = kb + kfo + ((chunk ^ ksw) << 4);
                    const bf16x8 k0 = *(const LAS bf16x8*)kp, k1 = *(const LAS bf16x8*)(kp + 4096);
                    c0 = MFMA32(k0, qr[dstep], c0); c1 = MFMA32(k1, qr[dstep], c1); }
                if (MODE == 1) { if (j < nwin) { const LAS unsigned char* bb = lds + ATT_BIAS + (kr0 + j - qrow + 7) * 132;
#pragma unroll
                    for (int r = 0; r < 16; ++r) { const unsigned o0 = (ipk[r >> 2] >> (8 * (r & 3))) & 0xFFu, o1 = (ipk[4 + (r >> 2)] >> (8 * (r & 3))) & 0xFFu;
                        c0[r] += *(const LAS float*)(bb + o0); c1[r] += *(const LAS float*)(bb + o1); } } }
                float rm = max3f(c0[0], c0[1], c1[0]), rm2 = max3f(c0[2], c0[3], c1[1]); rm = max3f(rm, c1[2], c1[3]);
#pragma unroll
                for (int r = 4; r < 16; r += 4) { rm = max3f(rm, c0[r], c0[r + 1]); rm2 = max3f(rm2, c0[r + 2], c0[r + 3]); rm = max3f(rm, c1[r], c1[r + 1]); rm2 = max3f(rm2, c1[r + 2], c1[r + 3]); }
                rm = swap_max(max2f(rm, rm2));
                if (__any(rm > mrun[mp] + 6.0f)) { const float mn = max2f(mrun[mp], rm), f = ex2(mrun[mp] - mn); mrun[mp] = mn; lrun[mp] *= f;
#pragma unroll
                    for (int r = 0; r < 16; ++r) { o[mp][0][r] *= f; o[mp][1][r] *= f; } }
                const float mm = mrun[mp]; float ps = 0.f;
#pragma unroll
                for (int r = 0; r < 16; ++r) { c0[r] = ex2(c0[r] - mm); c1[r] = ex2(c1[r] - mm); ps += c0[r] + c1[r]; }
                lrun[mp] += ps;
                const bf16x8 p0 = pack8(c0[0], c0[1], c0[2], c0[3], c0[4], c0[5], c0[6], c0[7]), p1 = pack8(c0[8], c0[9], c0[10], c0[11], c0[12], c0[13], c0[14], c0[15]);
                const bf16x8 p2 = pack8(c1[0], c1[1], c1[2], c1[3], c1[4], c1[5], c1[6], c1[7]), p3 = pack8(c1[8], c1[9], c1[10], c1[11], c1[12], c1[13], c1[14], c1[15]);
#pragma unroll
                for (int d0 = 0; d0 < 2; ++d0) { o[mp][d0] = MFMA32(vf[0][d0], p0, o[mp][d0]); o[mp][d0] = MFMA32(vf[1][d0], p1, o[mp][d0]); o[mp][d0] = MFMA32(vf[2][d0], p2, o[mp][d0]); o[mp][d0] = MFMA32(vf[3][d0], p3, o[mp][d0]); }
            }
        }
        if (j + 1 < nt) { *(LAS v4u*)(lds + ATT_KB + (cur ^ 1) * 8192 + koff) = kn; *(LAS v4u*)(lds + ATT_VB + (cur ^ 1) * 8192 + voff) = vn; }
        __syncthreads();
    }
#undef TILE_PROW
    if (DIFF) {
        const float lam = ((const float*)(F.ws + WS_LAM))[l]; const float omli = (l == 0) ? 0.8f : 0.64449093241f;
        const float i1 = 1.0f / swap_add(lrun[0]), i2 = lam / swap_add(lrun[NMAP - 1]);
        float ss = 0.f;
#pragma unroll
        for (int d0 = 0; d0 < 2; ++d0)
#pragma unroll
            for (int r = 0; r < 16; ++r) { const float y = o[0][d0][r] * i1 - o[NMAP - 1][d0][r] * i2; o[0][d0][r] = y; ss += y * y; }
        ss = swap_add(ss);
        const float rs = omli / sqrtf(ss * (1.0f / 64.0f) + EPS); const float* sg = FIN(IN_SUBLN) + l * 64;
#pragma unroll
        for (int d0 = 0; d0 < 2; ++d0)
#pragma unroll
            for (int rg = 0; rg < 4; ++rg) { const int dv = 32 * d0 + 8 * rg + 4 * hi; const f32x4 g4 = *(const f32x4*)(sg + dv);
                u32x2 w; w.x = pk2(o[0][d0][4 * rg] * rs * g4.x, o[0][d0][4 * rg + 1] * rs * g4.y); w.y = pk2(o[0][d0][4 * rg + 2] * rs * g4.z, o[0][d0][4 * rg + 3] * rs * g4.w);
                *(u32x2*)(Y + ygrow * DM + 768 + h * 64 + dv) = w; }
    } else {
        const float i1 = 1.0f / swap_add(lrun[0]);
#pragma unroll
        for (int d0 = 0; d0 < 2; ++d0)
#pragma unroll
            for (int rg = 0; rg < 4; ++rg) { const int dv = 32 * d0 + 8 * rg + 4 * hi;
                u32x2 w; w.x = pk2(o[0][d0][4 * rg] * i1, o[0][d0][4 * rg + 1] * i1); w.y = pk2(o[0][d0][4 * rg + 2] * i1, o[0][d0][4 * rg + 3] * i1);
                *(u32x2*)(Y + ygrow * DM + h * 64 + dv) = w; }
    }
}
#define SB() __builtin_amdgcn_sched_barrier(0)
constexpr int DF_KB = 0, DF_VB = 16384, DF_QB = 40960;
#define PSUM8(Y, B) (((f32x2_t){Y[B], Y[B + 1]} + (f32x2_t){Y[B + 2], Y[B + 3]}) + ((f32x2_t){Y[B + 4], Y[B + 5]} + (f32x2_t){Y[B + 6], Y[B + 7]}))
#ifndef DIFF_VAR
#define DIFF_VAR 0
#endif
template <int MP, bool HASPREV, int VAR>
__device__ __forceinline__ void diff_step(f32x16& X0, f32x16& X1, const f32x16& Y0, const f32x16& Y1, f32x16 (&o)[2][2], float (&mrun)[2], float (&lrun)[2], bool (&trk)[2], bool first, const LAS unsigned char* qp,
                                          const LAS unsigned char* kp, int ksw, int hi, const LAS unsigned char* vp) {
    constexpr int OM = 1 - MP;
    const int ch0 = ((4 * MP + hi) ^ ksw) << 4, ch1 = ((4 * MP + 2 + hi) ^ ksw) << 4;
    const bf16x8 k00 = *(const LAS bf16x8*)(kp + ch0), k01 = *(const LAS bf16x8*)(kp + ch0 + 4096), k10 = *(const LAS bf16x8*)(kp + ch1), k11 = *(const LAS bf16x8*)(kp + ch1 + 4096);
    f32x16 z;
#pragma unroll
    for (int r = 0; r < 16; ++r) z[r] = 0.f;
    const bf16x8 q0 = *(const LAS bf16x8*)(qp + (2 * MP) * 1024), q1 = *(const LAS bf16x8*)(qp + (2 * MP + 1) * 1024);
    bf16x8 pw0, pw1, pw2, pw3; f32x2_t ps2 = {0.f, 0.f};
    if (VAR == 1) { pw0 = q0; pw1 = q1; pw2 = q0; pw3 = q1; }
    if (VAR != 2) X0 = MFMA32(k00, q0, z); else { asm volatile("" :: "v"(k00), "v"(k01), "v"(k10), "v"(k11), "v"(q0), "v"(q1));
#pragma unroll
        for (int r = 0; r < 16; ++r) { X0[r] = 0.5f; X1[r] = 0.5f; } asm volatile("" : "+v"(X0), "+v"(X1)); }
    if (HASPREV && VAR != 1) { ps2 += PSUM8(Y0, 0); pw0 = pack8(Y0[0], Y0[1], Y0[2], Y0[3], Y0[4], Y0[5], Y0[6], Y0[7]); }
    SB();
    if (VAR != 2) X1 = MFMA32(k01, q0, z);
    if (HASPREV && VAR != 1) { ps2 += PSUM8(Y0, 8); pw1 = pack8(Y0[8], Y0[9], Y0[10], Y0[11], Y0[12], Y0[13], Y0[14], Y0[15]); }
    SB();
    if (VAR != 2) X0 = MFMA32(k10, q1, X0);
    if (HASPREV && VAR != 1) { ps2 += PSUM8(Y1, 0); pw2 = pack8(Y1[0], Y1[1], Y1[2], Y1[3], Y1[4], Y1[5], Y1[6], Y1[7]); }
    SB();
    if (VAR != 2) X1 = MFMA32(k11, q1, X1);
    if (VAR == 1) asm volatile("" :: "v"(X0), "v"(X1));
    if (HASPREV && VAR != 1) { ps2 += PSUM8(Y1, 8); pw3 = pack8(Y1[8], Y1[9], Y1[10], Y1[11], Y1[12], Y1[13], Y1[14], Y1[15]); lrun[OM] += ps2.x + ps2.y; }
    SB();
    if (!HASPREV) asm volatile("s_nop 15\n\ts_nop 7" : "+v"(X0), "+v"(X1));
    bf16x8 va0, va1, vb0, vb1;
    if (HASPREV) { va0 = mk8(vtr(vp), vtr(vp + 512)); va1 = mk8(vtr(vp + 4096), vtr(vp + 4096 + 512)); vb0 = mk8(vtr(vp + 1024), vtr(vp + 1024 + 512)); vb1 = mk8(vtr(vp + 4096 + 1024), vtr(vp + 4096 + 1024 + 512)); }
    float ra = 0.f, rb = 0.f;
    if (HASPREV) { if (VAR != 2) o[OM][0] = MFMA32(va0, pw0, o[OM][0]); else asm volatile("" :: "v"(va0)); }
    if (VAR != 1) { ra = max3f(X0[0], X0[1], X0[2]); rb = max3f(X0[3], X0[4], X0[5]); ra = max3f(ra, X0[6], X0[7]); rb = max3f(rb, X0[8], X0[9]); ra = max3f(ra, X0[10], X0[11]); }
    SB();
    if (HASPREV) { { if (VAR != 2) o[OM][1] = MFMA32(va1, pw0, o[OM][1]); else asm volatile("" :: "v"(va1)); } va0 = mk8(vtr(vp + 2048), vtr(vp + 2048 + 512)); va1 = mk8(vtr(vp + 4096 + 2048), vtr(vp + 4096 + 2048 + 512)); }
    if (VAR != 1) { rb = max3f(rb, X0[12], X0[13]); ra = max3f(ra, X0[14], X0[15]); rb = max3f(rb, X1[0], X1[1]); ra = max3f(ra, X1[2], X1[3]); rb = max3f(rb, X1[4], X1[5]); }
    SB();
    if (HASPREV) { if (VAR != 2) o[OM][0] = MFMA32(vb0, pw1, o[OM][0]); else asm volatile("" :: "v"(vb0)); }
    if (VAR != 1) { ra = max3f(ra, X1[6], X1[7]); rb = max3f(rb, X1[8], X1[9]); ra = max3f(ra, X1[10], X1[11]); rb = max3f(rb, X1[12], X1[13]); ra = max3f(ra, X1[14], X1[15]); }
    float rm = (VAR != 1) ? swap_max(max2f(ra, rb)) : 0.f;
    SB();
    if (HASPREV) { { if (VAR != 2) o[OM][1] = MFMA32(vb1, pw1, o[OM][1]); else asm volatile("" :: "v"(vb1)); } vb0 = mk8(vtr(vp + 3072), vtr(vp + 3072 + 512)); vb1 = mk8(vtr(vp + 4096 + 3072), vtr(vp + 4096 + 3072 + 512)); }
    { bool resc; if (!trk[MP]) resc = __any(rm > 30.0f) || (first && __any(rm < -30.0f)); else resc = __any(rm > mrun[MP] + 6.0f);
      if (resc) { const float mn = first ? rm : max2f(mrun[MP], rm), f = ex2(mrun[MP] - mn); mrun[MP] = mn; lrun[MP] *= f; trk[MP] = true;
#pragma unroll
          for (int r = 0; r < 16; ++r) { o[MP][0][r] *= f; o[MP][1][r] *= f; } } }
    if (trk[MP]) { const float mm = mrun[MP];
#pragma unroll
        for (int r = 0; r < 16; ++r) { X0[r] -= mm; X1[r] -= mm; } }
    SB();
    if (HASPREV) { if (VAR != 2) o[OM][0] = MFMA32(va0, pw2, o[OM][0]); else asm volatile("" :: "v"(va0)); }
#pragma unroll
    for (int r = 0; r < 8; ++r) { if (VAR != 1) X0[r] = ex2(X0[r]); }
    SB();
    if (HASPREV) { if (VAR != 2) o[OM][1] = MFMA32(va1, pw2, o[OM][1]); else asm volatile("" :: "v"(va1)); }
#pragma unroll
    for (int r = 8; r < 16; ++r) { if (VAR != 1) X0[r] = ex2(X0[r]); }
    SB();
    if (HASPREV) { if (VAR != 2) o[OM][0] = MFMA32(vb0, pw3, o[OM][0]); else asm volatile("" :: "v"(vb0)); }
#pragma unroll
    for (int r = 0; r < 8; ++r) { if (VAR != 1) X1[r] = ex2(X1[r]); }
    SB();
    if (HASPREV) { if (VAR != 2) o[OM][1] = MFMA32(vb1, pw3, o[OM][1]); else asm volatile("" :: "v"(vb1)); }
#pragma unroll
    for (int r = 8; r < 16; ++r) { if (VAR != 1) X1[r] = ex2(X1[r]); }
    SB();
}
template <int VAR> __device__ __forceinline__ void diff_unit(Frame& F, int l, int b, int h, int blk) {
    LAUNDER_IDS
    const int r32 = lane & 31, hi = lane >> 5;
    const bf16* P = (const bf16*)(F.ws + WS_A); bf16* Y = (bf16*)(F.ws + (VAR ? 390 * MiB : WS_B));
    LAS unsigned char* lds = F.lds;
    const int qtok = blk * 256 + wid * 32 + r32;
    const size_t qprow = (size_t)b * NKEY + 256 + qtok, ygrow = (size_t)b * SEQ + qtok;
    const int srow = tid >> 3, sch = tid & 7;
    const int koff = srow * 128 + ((sch ^ ((srow >> 1) & 7)) << 4);
    const int voff = (sch >> 2) * 4096 + (srow >> 3) * 512 + (srow & 7) * 64 + (sch & 3) * 16;
    const bf16* kvbase = P + ((size_t)b * NKEY + srow) * NIN + h * 64 + sch * 8;
    LAS unsigned char* qp = lds + DF_QB + wid * 4096 + lane * 16;
#pragma unroll
    for (int d0 = 0; d0 < 4; ++d0) *(LAS bf16x8*)(qp + d0 * 1024) = *(const bf16x8*)(P + qprow * NIN + 9 * 256 + h * 64 + d0 * 16 + hi * 8);
    f32x16 o[2][2]; float mrun[2] = {0.f, 0.f}, lrun[2] = {0.f, 0.f}; bool trk[2] = {false, false};
#pragma unroll
    for (int mp = 0; mp < 2; ++mp)
#pragma unroll
        for (int d0 = 0; d0 < 2; ++d0)
#pragma unroll
            for (int r = 0; r < 16; ++r) o[mp][d0][r] = 0.f;
    { const v4u kk = *(const v4u*)(kvbase + 10 * 256), vv = *(const v4u*)(kvbase + 11 * 256);
      *(LAS v4u*)(lds + DF_KB + koff) = kk; *(LAS v4u*)(lds + DF_VB + voff) = vv; }
    __syncthreads();
    const int ksw = (r32 >> 1) & 7;
    const int vb = ((lane >> 4) & 1) * 32 + (lane & 3) * 8 + (4 * hi + ((lane & 15) >> 2)) * 64;
    const LAS unsigned char* kp0 = lds + DF_KB + r32 * 128; const LAS unsigned char* vp0 = lds + DF_VB + vb;
    f32x16 A0, A1, B0, B1;
    int vs_prev = 0, vs_cur = 0, vs_next = 8192;
    diff_step<0, false, VAR>(A0, A1, A0, A1, o, mrun, lrun, trk, true, qp, kp0, ksw, hi, vp0);
    for (int j = 0; j < 132; ++j) {
        v4u kn, vn;
        if (j + 1 < 132) { const bf16* src = kvbase + (size_t)(64 * (j + 1)) * NIN; kn = *(const v4u*)(src + 10 * 256); vn = *(const v4u*)(src + 11 * 256); }
        const LAS unsigned char* kp = kp0 + (j & 1) * 8192;
        if (j > 0) diff_step<0, true, VAR>(A0, A1, B0, B1, o, mrun, lrun, trk, false, qp, kp, ksw, hi, vp0 + vs_prev);
        diff_step<1, true, VAR>(B0, B1, A0, A1, o, mrun, lrun, trk, j == 0, qp, kp, ksw, hi, vp0 + vs_cur);
        if (j + 1 < 132) { *(LAS v4u*)(lds + DF_KB + ((j + 1) & 1) * 8192 + koff) = kn; *(LAS v4u*)(lds + DF_VB + vs_next + voff) = vn; }
        __syncthreads();
        vs_prev = vs_cur; vs_cur = vs_next; vs_next = (vs_next == 16384) ? 0 : vs_next + 8192;
    }
    { const LAS unsigned char* vp = vp0 + vs_prev;
      float ps = 0.f;
#pragma unroll
      for (int r = 0; r < 16; ++r) ps += B0[r] + B1[r];
      lrun[1] += ps;
      const bf16x8 p0 = pack8(B0[0], B0[1], B0[2], B0[3], B0[4], B0[5], B0[6], B0[7]), p1 = pack8(B0[8], B0[9], B0[10], B0[11], B0[12], B0[13], B0[14], B0[15]);
      const bf16x8 p2 = pack8(B1[0], B1[1], B1[2], B1[3], B1[4], B1[5], B1[6], B1[7]), p3 = pack8(B1[8], B1[9], B1[10], B1[11], B1[12], B1[13], B1[14], B1[15]);
#pragma unroll
      for (int d0 = 0; d0 < 2; ++d0) {
          o[1][d0] = MFMA32(mk8(vtr(vp + d0 * 4096), vtr(vp + d0 * 4096 + 512)), p0, o[1][d0]);
          o[1][d0] = MFMA32(mk8(vtr(vp + d0 * 4096 + 1024), vtr(vp + d0 * 4096 + 1024 + 512)), p1, o[1][d0]);
          o[1][d0] = MFMA32(mk8(vtr(vp + d0 * 4096 + 2048), vtr(vp + d0 * 4096 + 2048 + 512)), p2, o[1][d0]);
          o[1][d0] = MFMA32(mk8(vtr(vp + d0 * 4096 + 3072), vtr(vp + d0 * 4096 + 3072 + 512)), p3, o[1][d0]); } }
    __syncthreads();
    { const float lam = ((const float*)(F.ws + WS_LAM))[l]; const float omli = (l == 0) ? 0.8f : 0.64449093241f;
      const float i1 = 1.0f / swap_add(lrun[0]), i2 = lam / swap_add(lrun[1]);
      float ss = 0.f;
#pragma unroll
      for (int d0 = 0; d0 < 2; ++d0)
#pragma unroll
          for (int r = 0; r < 16; ++r) { const float y = o[0][d0][r] * i1 - o[1][d0][r] * i2; o[0][d0][r] = y; ss += y * y; }
      ss = swap_add(ss);
      const float rs = omli / sqrtf(ss * (1.0f / 64.0f) + EPS); const float* sg = FIN(IN_SUBLN) + l * 64;
#pragma unroll
      for (int d0 = 0; d0 < 2; ++d0)
#pragma unroll
          for (int rg = 0; rg < 4; ++rg) { const int dv = 32 * d0 + 8 * rg + 4 * hi; const f32x4 g4 = *(const f32x4*)(sg + dv);
              u32x2 w; w.x = pk2(o[0][d0][4 * rg] * rs * g4.x, o[0][d0][4 * rg + 1] * rs * g4.y); w.y = pk2(o[0][d0][4 * rg + 2] * rs * g4.z, o[0][d0][4 * rg + 3] * rs * g4.w);
              *(u32x2*)(Y + ygrow * DM + 768 + h * 64 + dv) = w; } }
}
template <int MP, bool HASPREV>
__device__ __forceinline__ void diff3_step(f32x16 (&o)[2][2], float (&mrun)[2], float (&lrun)[2], bool (&trk)[2], bool first, const LAS unsigned char* qp, bf16x8 (&qf)[2], bf16x8 (&kf)[4], bf16x8 (&pw)[4],
                                           const LAS unsigned char* vp  , const LAS unsigned char* knext  , int kc0, int kc1  ) {
    constexpr int OM = 1 - MP;
    f32x16 z;
#pragma unroll
    for (int r = 0; r < 16; ++r) z[r] = 0.f;
    f32x16 X0, X1;
    bf16x8 va0, va1, vb0, vb1;
    X0 = MFMA32(kf[0], qf[0], z);
    if (HASPREV) { va0 = mk8(vtr(vp), vtr(vp + 512)); va1 = mk8(vtr(vp + 4096), vtr(vp + 4096 + 512)); }
    SB();
    X1 = MFMA32(kf[1], qf[0], z);
    if (HASPREV) { vb0 = mk8(vtr(vp + 1024), vtr(vp + 1024 + 512)); vb1 = mk8(vtr(vp + 4096 + 1024), vtr(vp + 4096 + 1024 + 512)); }
    SB();
    X0 = MFMA32(kf[2], qf[1], X0);
    SB();
    X1 = MFMA32(kf[3], qf[1], X1);
    SB();
    if (!HASPREV) asm volatile("s_nop 15\n\ts_nop 7" : "+v"(X0), "+v"(X1));
    qf[0] = *(const LAS bf16x8*)(qp + (2 * OM) * 1024); qf[1] = *(const LAS bf16x8*)(qp + (2 * OM + 1) * 1024);
    if (knext) { kf[0] = *(const LAS bf16x8*)(knext + kc0); kf[1] = *(const LAS bf16x8*)(knext + kc0 + 4096); kf[2] = *(const LAS bf16x8*)(knext + kc1); kf[3] = *(const LAS bf16x8*)(knext + kc1 + 4096); }
    float ra, rb;
    if (HASPREV) o[OM][0] = MFMA32(va0, pw[0], o[OM][0]);
    ra = max3f(X0[0], X0[1], X0[2]); rb = max3f(X0[3], X0[4], X0[5]); ra = max3f(ra, X0[6], X0[7]); rb = max3f(rb, X0[8], X0[9]); ra = max3f(ra, X0[10], X0[11]);
    SB();
    if (HASPREV) { o[OM][1] = MFMA32(va1, pw[0], o[OM][1]); va0 = mk8(vtr(vp + 2048), vtr(vp + 2048 + 512)); va1 = mk8(vtr(vp + 4096 + 2048), vtr(vp + 4096 + 2048 + 512)); }
    rb = max3f(rb, X0[12], X0[13]); ra = max3f(ra, X0[14], X0[15]); rb = max3f(rb, X1[0], X1[1]); ra = max3f(ra, X1[2], X1[3]); rb = max3f(rb, X1[4], X1[5]);
    SB();
    if (HASPREV) o[OM][0] = MFMA32(vb0, pw[1], o[OM][0]);
    ra = max3f(ra, X1[6], X1[7]); rb = max3f(rb, X1[8], X1[9]); ra = max3f(ra, X1[10], X1[11]); rb = max3f(rb, X1[12], X1[13]); ra = max3f(ra, X1[14], X1[15]);
    const float rm = swap_max(max2f(ra, rb));
    SB();
    if (HASPREV) { o[OM][1] = MFMA32(vb1, pw[1], o[OM][1]); vb0 = mk8(vtr(vp + 3072), vtr(vp + 3072 + 512)); vb1 = mk8(vtr(vp + 4096 + 3072), vtr(vp + 4096 + 3072 + 512)); }
    { bool resc; if (!trk[MP]) resc = __any(rm > 30.0f) || (first && __any(rm < -30.0f)); else resc = __any(rm > mrun[MP] + 6.0f);
      if (resc) { const float mn = first ? rm : max2f(mrun[MP], rm), f = ex2(mrun[MP] - mn); mrun[MP] = mn; lrun[MP] *= f; trk[MP] = true;
#pragma unroll
          for (int r = 0; r < 16; ++r) { o[MP][0][r] *= f; o[MP][1][r] *= f; } } }
    if (trk[MP]) { const float mm = mrun[MP];
#pragma unroll
        for (int r = 0; r < 16; ++r) { X0[r] -= mm; X1[r] -= mm; } }
    f32x2_t ps2 = {0.f, 0.f}; bf16x8 n0, n1, n2, n3;
    SB();
    if (HASPREV) o[OM][0] = MFMA32(va0, pw[2], o[OM][0]);
#pragma unroll
    for (int r = 0; r < 8; ++r) X0[r] = ex2(X0[r]);
    ps2 += PSUM8(X0, 0); n0 = pack8(X0[0], X0[1], X0[2], X0[3], X0[4], X0[5], X0[6], X0[7]);
    SB();
    if (HASPREV) o[OM][1] = MFMA32(va1, pw[2], o[OM][1]);
#pragma unroll
    for (int r = 8; r < 16; ++r) X0[r] = ex2(X0[r]);
    ps2 += PSUM8(X0, 8); n1 = pack8(X0[8], X0[9], X0[10], X0[11], X0[12], X0[13], X0[14], X0[15]);
    SB();
    if (HASPREV) o[OM][0] = MFMA32(vb0, pw[3], o[OM][0]);
#pragma unroll
    for (int r = 0; r < 8; ++r) X1[r] = ex2(X1[r]);
    ps2 += PSUM8(X1, 0); n2 = pack8(X1[0], X1[1], X1[2], X1[3], X1[4], X1[5], X1[6], X1[7]);
    SB();
    if (HASPREV) o[OM][1] = MFMA32(vb1, pw[3], o[OM][1]);
#pragma unroll
    for (int r = 8; r < 16; ++r) X1[r] = ex2(X1[r]);
    ps2 += PSUM8(X1, 8); n3 = pack8(X1[8], X1[9], X1[10], X1[11], X1[12], X1[13], X1[14], X1[15]);
    lrun[MP] += ps2.x + ps2.y;
    SB();
    pw[0] = n0; pw[1] = n1; pw[2] = n2; pw[3] = n3;
}
__device__ __forceinline__ void diff3_unit(Frame& F, int l, int b, int h, int blk) {
    LAUNDER_IDS
    const int r32 = lane & 31, hi = lane >> 5;
    const bf16* P = (const bf16*)(F.ws + WS_A); bf16* Y = (bf16*)(F.ws + WS_B);
    LAS unsigned char* lds = F.lds;
    const int qtok = blk * 256 + wid * 32 + r32;
    const size_t qprow = (size_t)b * NKEY + 256 + qtok;
    const int krow = tid >> 3, kch = (tid & 7) ^ ((krow >> 1) & 7);
    const int vrow = 8 * ((tid & 255) >> 5) + (((tid & 255) >> 2) & 7), vch = 4 * (tid >> 8) + (tid & 3);
    const unsigned kofs = (unsigned)((krow * NIN + 10 * 256 + h * 64 + kch * 8) * 2), vofs = (unsigned)((vrow * NIN + 11 * 256 + h * 64 + vch * 8) * 2);
    const char* pbase = (const char*)(P + (size_t)b * NKEY * NIN);
    const int dmaw = wid * 1024;
#define DF_DMA(tile, kbuf_off, vslot_off) do { \
        const char* tb_ = pbase + (size_t)(tile) * (64 * NIN * 2); \
        __builtin_amdgcn_global_load_lds((const unsigned*)(tb_ + kofs), (LAS unsigned*)(lds + DF_KB + (kbuf_off) + dmaw), 16, 0, 0); \
        __builtin_amdgcn_global_load_lds((const unsigned*)(tb_ + vofs), (LAS unsigned*)(lds + DF_VB + (vslot_off) + dmaw), 16, 0, 0); } while (0)
    LAS unsigned char* qp = lds + DF_QB + wid * 4096 + lane * 16;
#pragma unroll
    for (int d0 = 0; d0 < 4; ++d0) *(LAS bf16x8*)(qp + d0 * 1024) = *(const bf16x8*)(P + qprow * NIN + 9 * 256 + h * 64 + d0 * 16 + hi * 8);
    f32x16 o[2][2]; float mrun[2] = {0.f, 0.f}, lrun[2] = {0.f, 0.f}; bool trk[2] = {false, false};
#pragma unroll
    for (int mp = 0; mp < 2; ++mp)
#pragma unroll
        for (int d0 = 0; d0 < 2; ++d0)
#pragma unroll
            for (int r = 0; r < 16; ++r) o[mp][d0][r] = 0.f;
    DF_DMA(0, 0, 0);
    __syncthreads();
    DF_DMA(1, 8192, 8192);
    const int ksw = (r32 >> 1) & 7;
    const int kcA0 = (hi ^ ksw) << 4;
#define kcA1 (kcA0 ^ 32)
#define kcB0 (kcA0 ^ 64)
#define kcB1 (kcA0 ^ 96)
    const int vb = ((lane >> 4) & 1) * 32 + (lane & 3) * 8 + (4 * hi + ((lane & 15) >> 2)) * 64;
    const LAS unsigned char* kp0 = lds + DF_KB + r32 * 128; const LAS unsigned char* vp0 = lds + DF_VB + vb;
    bf16x8 kf[4], pw[4], qf[2];
    qf[0] = *(const LAS bf16x8*)(qp); qf[1] = *(const LAS bf16x8*)(qp + 1024);
    kf[0] = *(const LAS bf16x8*)(kp0 + kcA0); kf[1] = *(const LAS bf16x8*)(kp0 + kcA0 + 4096); kf[2] = *(const LAS bf16x8*)(kp0 + kcA1); kf[3] = *(const LAS bf16x8*)(kp0 + kcA1 + 4096);
#pragma unroll
    for (int i = 0; i < 4; ++i) pw[i] = kf[0];
    int vs_prev = 16384, vs_cur = 0, vs_next = 8192;
    for (int j = 0; j < 132; ++j) {
        const LAS unsigned char* kp = kp0 + (j & 1) * 8192;
        if (j > 0) diff3_step<0, true>(o, mrun, lrun, trk, false, qp, qf, kf, pw, vp0 + vs_prev, kp, kcB0, kcB1);
        else diff3_step<0, false>(o, mrun, lrun, trk, true, qp, qf, kf, pw, vp0, kp, kcB0, kcB1);
        __syncthreads();
        if (j + 2 < 132) DF_DMA(j + 2, (j & 1) * 8192, vs_prev);
        diff3_step<1, true>(o, mrun, lrun, trk, j == 0, qp, qf, kf, pw, vp0 + vs_cur, (j + 1 < 132) ? kp0 + ((j + 1) & 1) * 8192 : (const LAS unsigned char*)nullptr, kcA0, kcA1);
        vs_prev = vs_cur; vs_cur = vs_next; vs_next = (vs_next == 16384) ? 0 : vs_next + 8192;
    }
    { const LAS unsigned char* vp = vp0 + vs_prev;
#pragma unroll
      for (int d0 = 0; d0 < 2; ++d0) {
          o[1][d0] = MFMA32(mk8(vtr(vp + d0 * 4096), vtr(vp + d0 * 4096 + 512)), pw[0], o[1][d0]);
          o[1][d0] = MFMA32(mk8(vtr(vp + d0 * 4096 + 1024), vtr(vp + d0 * 4096 + 1024 + 512)), pw[1], o[1][d0]);
          o[1][d0] = MFMA32(mk8(vtr(vp + d0 * 4096 + 2048), vtr(vp + d0 * 4096 + 2048 + 512)), pw[2], o[1][d0]);
          o[1][d0] = MFMA32(mk8(vtr(vp + d0 * 4096 + 3072), vtr(vp + d0 * 4096 + 3072 + 512)), pw[3], o[1][d0]); } }
    __syncthreads();
#undef DF_DMA
#undef kcA1
#undef kcB0
#undef kcB1
    { int tid2 = F.tid; asm volatile("" : "+v"(tid2)); const size_t ygrow = (size_t)b * SEQ + blk * 256 + (tid2 >> 6) * 32 + (tid2 & 31);
      const float lam = ((const float*)(F.ws + WS_LAM))[l]; const float omli = (l == 0) ? 0.8f : 0.64449093241f;
      const float i1 = 1.0f / swap_add(lrun[0]), i2 = lam / swap_add(lrun[1]);
      float ss = 0.f;
#pragma unroll
      for (int d0 = 0; d0 < 2; ++d0)
#pragma unroll
          for (int r = 0; r < 16; ++r) { const float y = o[0][d0][r] * i1 - o[1][d0][r] * i2; o[0][d0][r] = y; ss += y * y; }
      ss = swap_add(ss);
      const float rs = omli / sqrtf(ss * (1.0f / 64.0f) + EPS); const float* sg = FIN(IN_SUBLN) + l * 64;
#pragma unroll
      for (int d0 = 0; d0 < 2; ++d0)
#pragma unroll
          for (int rg = 0; rg < 4; ++rg) { const int dv = 32 * d0 + 8 * rg + 4 * hi; const f32x4 g4 = *(const f32x4*)(sg + dv);
              u32x2 w; w.x = pk2(o[0][d0][4 * rg] * rs * g4.x, o[0][d0][4 * rg + 1] * rs * g4.y); w.y = pk2(o[0][d0][4 * rg + 2] * rs * g4.z, o[0][d0][4 * rg + 3] * rs * g4.w);
              *(u32x2*)(Y + ygrow * DM + 768 + h * 64 + dv) = w; } }
}
#ifndef D5_PROF
#define D5_PROF 0
#endif
#ifndef D5_PROF_WAVE
#define D5_PROF_WAVE 0
#endif
#ifndef D5_PROF_SEL
#define D5_PROF_SEL 0
#endif
constexpr int D5_KB = 0, D5_VB = 32768, D5_EX = 0;
__device__ __forceinline__ void diff5_unit(Frame& F, int l, int b, int h, int blk) {
    LAUNDER_IDS
    const int r32 = lane & 31, hi = lane >> 5, mp = wid & 1, qg = wid >> 1;
    const bf16* P = (const bf16*)(F.ws + WS_A); bf16* Y = (bf16*)(F.ws + WS_B);
    LAS unsigned char* lds = F.lds;
    const int qtok0 = blk * 256 + qg * 64 + r32;
    const int krow = tid >> 3, kch = (tid & 7) ^ ((krow >> 1) & 7);
    const int vrow = 8 * ((tid & 255) >> 5) + (((tid & 255) >> 2) & 7), vch = 4 * (tid >> 8) + (tid & 3);
    const unsigned kofs = (unsigned)((krow * NIN + 10 * 256 + h * 64 + kch * 8) * 2), vofs = (unsigned)((vrow * NIN + 11 * 256 + h * 64 + vch * 8) * 2);
    const char* pbase = (const char*)(P + (size_t)b * NKEY * NIN);
    const int dmaw = wid * 1024;
#define D5_DMA(tile) do { const int sl_ = ((tile) & 3) * 8192; const char* tb_ = pbase + (size_t)(tile) * (64 * NIN * 2); \
        __builtin_amdgcn_global_load_lds((const unsigned*)(tb_ + kofs), (LAS unsigned*)(lds + D5_KB + sl_ + dmaw), 16, 0, 0); \
        __builtin_amdgcn_global_load_lds((const unsigned*)(tb_ + vofs), (LAS unsigned*)(lds + D5_VB + sl_ + dmaw), 16, 0, 0); } while (0)
#define D5_DMA2(tile, slot) do { const char* tb_ = pbase + (size_t)(tile) * (64 * NIN * 2); \
        __builtin_amdgcn_global_load_lds((const unsigned*)(tb_ + kofs), (LAS unsigned*)(lds + D5_KB + (slot) * 8192 + dmaw), 16, 0, 0); \
        __builtin_amdgcn_global_load_lds((const unsigned*)(tb_ + vofs), (LAS unsigned*)(lds + D5_VB + (slot) * 8192 + dmaw), 16, 0, 0); } while (0)
#define D5_BAR(N) do { asm volatile("s_waitcnt vmcnt(" #N ")" ::: "memory"); asm volatile("s_waitcnt lgkmcnt(0)" ::: "memory"); __builtin_amdgcn_s_barrier(); asm volatile("" ::: "memory"); } while (0)
    bf16x8 q[2][2];
#pragma unroll
    for (int s = 0; s < 2; ++s)
#pragma unroll
        for (int d = 0; d < 2; ++d) q[s][d] = *(const bf16x8*)(P + ((size_t)b * NKEY + 256 + qtok0 + 32 * s) * NIN + 9 * 256 + h * 64 + (2 * mp + d) * 16 + hi * 8);
    f32x16 o[2][2]; float mrun[2] = {0.f, 0.f}, lrun[2] = {0.f, 0.f}; bool trk[2] = {false, false};
#pragma unroll
    for (int s = 0; s < 2; ++s)
#pragma unroll
        for (int d0 = 0; d0 < 2; ++d0)
#pragma unroll
            for (int r = 0; r < 16; ++r) o[s][d0][r] = 0.f;
    D5_DMA(0); D5_DMA(1); D5_DMA(2);
    D5_BAR(4);
    const int ksw = (r32 >> 1) & 7;
    const int kc0 = ((4 * mp + hi) ^ ksw) << 4, kc1 = ((4 * mp + 2 + hi) ^ ksw) << 4;
    const int vb = ((lane >> 4) & 1) * 32 + (lane & 3) * 8 + (4 * hi + ((lane & 15) >> 2)) * 64;
    f32x16 z;
#pragma unroll
    for (int r = 0; r < 16; ++r) z[r] = 0.f;
#if D5_PROF
    unsigned long long tacc = 0; unsigned long long t0_ = __builtin_amdgcn_s_memtime();
#define tA 0
#define tB 1
#define tC 2
#define tD 3
#define D5_STAMP(seg) do { const unsigned long long tn_ = __builtin_amdgcn_s_memtime(); if ((seg) == D5_PROF_SEL || D5_PROF_SEL == 4) tacc += tn_ - t0_; t0_ = tn_; } while (0)
#else
#define D5_STAMP(acc) do {} while (0)
#endif
    for (int j4 = 0; j4 < 132; j4 += 4) {
#pragma unroll
        for (int jj = 0; jj < 4; ++jj) {
        const int j = j4 + jj; constexpr int dummy_ = 0; (void)dummy_; const int cur = jj;
        if (j + 3 < 132) D5_DMA2(j + 3, (jj + 3) & 3);
        const LAS unsigned char* kp = lds + D5_KB + cur * 8192 + r32 * 128; const LAS unsigned char* vp = lds + D5_VB + cur * 8192 + vb;
        const bf16x8 kf0 = *(const LAS bf16x8*)(kp + kc0), kf1 = *(const LAS bf16x8*)(kp + kc0 + 4096), kf2 = *(const LAS bf16x8*)(kp + kc1), kf3 = *(const LAS bf16x8*)(kp + kc1 + 4096);
        f32x16 X[2][2];
        asm volatile("s_setprio 1");
#pragma unroll
        for (int s = 0; s < 2; ++s) { X[s][0] = MFMA32(kf0, q[s][0], z); X[s][1] = MFMA32(kf1, q[s][0], z); }
#pragma unroll
        for (int s = 0; s < 2; ++s) { X[s][0] = MFMA32(kf2, q[s][1], X[s][0]); X[s][1] = MFMA32(kf3, q[s][1], X[s][1]); }
        asm volatile("s_setprio 0\n\ts_nop 15\n\ts_nop 7" : "+v"(X[0][0]), "+v"(X[0][1]), "+v"(X[1][0]), "+v"(X[1][1]));
        D5_STAMP(tA);
        bf16x8 pw[2][4];
#pragma unroll
        for (int s = 0; s < 2; ++s) {
            f32x16& X0 = X[s][0]; f32x16& X1 = X[s][1];
            float ra = max3f(X0[0], X0[1], X0[2]), rb = max3f(X0[3], X0[4], X0[5]);
            ra = max3f(ra, X0[6], X0[7]); rb = max3f(rb, X0[8], X0[9]); ra = max3f(ra, X0[10], X0[11]); rb = max3f(rb, X0[12], X0[13]); ra = max3f(ra, X0[14], X0[15]);
            rb = max3f(rb, X1[0], X1[1]); ra = max3f(ra, X1[2], X1[3]); rb = max3f(rb, X1[4], X1[5]); ra = max3f(ra, X1[6], X1[7]); rb = max3f(rb, X1[8], X1[9]);
            ra = max3f(ra, X1[10], X1[11]); rb = max3f(rb, X1[12], X1[13]); ra = max3f(ra, X1[14], X1[15]);
            const float rm = swap_max(max2f(ra, rb));
            { bool resc; if (!trk[s]) resc = __any(rm > 30.0f) || (j == 0 && __any(rm < -30.0f)); else resc = __any(rm > mrun[s] + 6.0f);
              if (resc) { const float mn = (j == 0) ? rm : max2f(mrun[s], rm), f = ex2(mrun[s] - mn); mrun[s] = mn; lrun[s] *= f; trk[s] = true;
#pragma unroll
                  for (int r = 0; r < 16; ++r) { o[s][0][r] *= f; o[s][1][r] *= f; } } }
            if (trk[s]) { const float mm = mrun[s];
#pragma unroll
                for (int r = 0; r < 16; ++r) { X0[r] -= mm; X1[r] -= mm; } }
#pragma unroll
            for (int r = 0; r < 16; ++r) { X0[r] = ex2(X0[r]); X1[r] = ex2(X1[r]); }
            f32x2_t ps2 = (PSUM8(X0, 0) + PSUM8(X0, 8)) + (PSUM8(X1, 0) + PSUM8(X1, 8));
            lrun[s] += ps2.x + ps2.y;
            pw[s][0] = pack8(X0[0], X0[1], X0[2], X0[3], X0[4], X0[5], X0[6], X0[7]); pw[s][1] = pack8(X0[8], X0[9], X0[10], X0[11], X0[12], X0[13], X0[14], X0[15]);
            pw[s][2] = pack8(X1[0], X1[1], X1[2], X1[3], X1[4], X1[5], X1[6], X1[7]); pw[s][3] = pack8(X1[8], X1[9], X1[10], X1[11], X1[12], X1[13], X1[14], X1[15]);
        }
        asm volatile("" :: "v"(pw[0][0]), "v"(pw[0][3]), "v"(pw[1][0]), "v"(pw[1][3])); D5_STAMP(tB);
        { const unsigned va = (unsigned)(__UINTPTR_TYPE__)(lds + vb);
#define D5_TR(dst, OFF) asm volatile("ds_read_b64_tr_b16 %0, %1 offset:%c2" : "=&v"(dst) : "v"(va), "i"(OFF) : "memory")
#define D5_VO(ks, d0) (D5_VB + cur * 8192 + (d0) * 4096 + (ks) * 1024)
          s16x4 a00l, a00h, a01l, a01h, a10l, a10h, a11l, a11h, b00l, b00h, b01l, b01h, b10l, b10h, b11l, b11h;
          D5_TR(a00l, D5_VO(0, 0)); D5_TR(a00h, D5_VO(0, 0) + 512); D5_TR(a01l, D5_VO(0, 1)); D5_TR(a01h, D5_VO(0, 1) + 512);
          D5_TR(a10l, D5_VO(1, 0)); D5_TR(a10h, D5_VO(1, 0) + 512); D5_TR(a11l, D5_VO(1, 1)); D5_TR(a11h, D5_VO(1, 1) + 512);
          asm volatile("s_waitcnt lgkmcnt(0)" ::: "memory"); SB();
          D5_TR(b00l, D5_VO(2, 0)); D5_TR(b00h, D5_VO(2, 0) + 512); D5_TR(b01l, D5_VO(2, 1)); D5_TR(b01h, D5_VO(2, 1) + 512);
          D5_TR(b10l, D5_VO(3, 0)); D5_TR(b10h, D5_VO(3, 0) + 512); D5_TR(b11l, D5_VO(3, 1)); D5_TR(b11h, D5_VO(3, 1) + 512);
          SB();
          __builtin_amdgcn_s_setprio(1);
          { const bf16x8 v00 = mk8(a00l, a00h), v01 = mk8(a01l, a01h), v10 = mk8(a10l, a10h), v11 = mk8(a11l, a11h);
            o[0][0] = MFMA32(v00, pw[0][0], o[0][0]); o[1][0] = MFMA32(v00, pw[1][0], o[1][0]); o[0][1] = MFMA32(v01, pw[0][0], o[0][1]); o[1][1] = MFMA32(v01, pw[1][0], o[1][1]);
            o[0][0] = MFMA32(v10, pw[0][1], o[0][0]); o[1][0] = MFMA32(v10, pw[1][1], o[1][0]); o[0][1] = MFMA32(v11, pw[0][1], o[0][1]); o[1][1] = MFMA32(v11, pw[1][1], o[1][1]); }
          SB();
          asm volatile("s_waitcnt lgkmcnt(0)" ::: "memory"); SB();
          { const bf16x8 v20 = mk8(b00l, b00h), v21 = mk8(b01l, b01h), v30 = mk8(b10l, b10h), v31 = mk8(b11l, b11h);
            o[0][0] = MFMA32(v20, pw[0][2], o[0][0]); o[1][0] = MFMA32(v20, pw[1][2], o[1][0]); o[0][1] = MFMA32(v21, pw[0][2], o[0][1]); o[1][1] = MFMA32(v21, pw[1][2], o[1][1]);
            o[0][0] = MFMA32(v30, pw[0][3], o[0][0]); o[1][0] = MFMA32(v30, pw[1][3], o[1][0]); o[0][1] = MFMA32(v31, pw[0][3], o[0][1]); o[1][1] = MFMA32(v31, pw[1][3], o[1][1]); }
          __builtin_amdgcn_s_setprio(0);
#undef D5_TR
#undef D5_VO
        }
        asm volatile("s_nop 15\n\ts_nop 7" : "+v"(o[0][0]), "+v"(o[0][1]), "+v"(o[1][0]), "+v"(o[1][1])); D5_STAMP(tC);
        if (j + 3 < 132) D5_BAR(4); else D5_BAR(0);
        D5_STAMP(tD);
        }
    }
#if D5_PROF
    if (blockIdx.x == 0 && wid == D5_PROF_WAVE && lane == 0) { unsigned long long* pr = (unsigned long long*)(F.ws + WS_CTL) + 8192; if (pr[7] == 0) { pr[0] = tacc; pr[7] = 1; } }
#endif
#undef D5_DMA
#undef D5_DMA2
#undef D5_BAR
    const float lam = ((const float*)(F.ws + WS_LAM))[l]; const float omli = (l == 0) ? 0.8f : 0.64449093241f;
    const float il0 = 1.0f / swap_add(lrun[0]), il1 = 1.0f / swap_add(lrun[1]);
    LAS float* ex = (LAS float*)(lds + D5_EX) + (qg * 2 + mp) * 2048 + lane;
    { const int sg = 1 - mp; const float sc = (mp == 0) ? il1 : lam * il0;
#pragma unroll
      for (int d0 = 0; d0 < 2; ++d0)
#pragma unroll
          for (int r = 0; r < 16; ++r) ex[(d0 * 16 + r) * 64] = ((sg == 0) ? o[0][d0][r] : o[1][d0][r]) * sc; }
    __syncthreads();
    { const LAS float* exr = (const LAS float*)(lds + D5_EX) + (qg * 2 + (1 - mp)) * 2048 + lane;
      const int sk = mp;
      const float own = (mp == 0) ? il0 : lam * il1;
      float y[2][16]; float ss = 0.f;
#pragma unroll
      for (int d0 = 0; d0 < 2; ++d0)
#pragma unroll
          for (int r = 0; r < 16; ++r) { const float a = ((sk == 0) ? o[0][d0][r] : o[1][d0][r]) * own, pv = exr[(d0 * 16 + r) * 64];
              const float v = (mp == 0) ? a - pv : pv - a; y[d0][r] = v; ss += v * v; }
      ss = swap_add(ss);
      const float rs = omli / sqrtf(ss * (1.0f / 64.0f) + EPS); const float* sg = FIN(IN_SUBLN) + l * 64;
      const size_t ygrow = (size_t)b * SEQ + qtok0 + 32 * sk;
#pragma unroll
      for (int d0 = 0; d0 < 2; ++d0)
#pragma unroll
          for (int rg = 0; rg < 4; ++rg) { const int dv = 32 * d0 + 8 * rg + 4 * hi; const f32x4 g4 = *(const f32x4*)(sg + dv);
              u32x2 w; w.x = pk2(y[d0][4 * rg] * rs * g4.x, y[d0][4 * rg + 1] * rs * g4.y); w.y = pk2(y[d0][4 * rg + 2] * rs * g4.z, y[d0][4 * rg + 3] * rs * g4.w);
              *(u32x2*)(Y + ygrow * DM + 768 + h * 64 + dv) = w; } }
    __syncthreads();
}
constexpr int D6_KB = 0, D6_VB = 32768, D6_EX = 0;
__device__ __forceinline__ void diff6_unit(Frame& F, int l, int b, int h, int blk) {
    LAUNDER_IDS
    const int r32 = lane & 31, hi = lane >> 5, mp = wid & 1, qg = wid >> 1;
    const bool late = wid >= 4;
    const bf16* P = (const bf16*)(F.ws + WS_A); bf16* Y = (bf16*)(F.ws + WS_B);
    LAS unsigned char* lds = F.lds;
    const int qtok0 = blk * 256 + qg * 64 + r32;
    const int krow = tid >> 3, kch = (tid & 7) ^ ((krow >> 1) & 7);
    const int vrow = 8 * ((tid & 255) >> 5) + (((tid & 255) >> 2) & 7), vch = 4 * (tid >> 8) + (tid & 3);
    const unsigned kofs = (unsigned)((krow * NIN + 10 * 256 + h * 64 + kch * 8) * 2), vofs = (unsigned)((vrow * NIN + 11 * 256 + h * 64 + vch * 8) * 2);
    const char* pbase = (const char*)(P + (size_t)b * NKEY * NIN);
    const int dmaw = wid * 1024;
#define D6_DMA2(tile, slot) do { const char* tb_ = pbase + (size_t)(tile) * (64 * NIN * 2); \
        __builtin_amdgcn_global_load_lds((const unsigned*)(tb_ + kofs), (LAS unsigned*)(lds + D6_KB + (slot) * 8192 + dmaw), 16, 0, 0); \
        __builtin_amdgcn_global_load_lds((const unsigned*)(tb_ + vofs), (LAS unsigned*)(lds + D6_VB + (slot) * 8192 + dmaw), 16, 0, 0); } while (0)
#define D6_BAR(N) do { asm volatile("s_waitcnt vmcnt(" #N ")" ::: "memory"); asm volatile("s_waitcnt lgkmcnt(0)" ::: "memory"); __builtin_amdgcn_s_barrier(); asm volatile("" ::: "memory"); } while (0)
#define D6_BAR0() do { asm volatile("" ::: "memory"); __builtin_amdgcn_s_barrier(); asm volatile("" ::: "memory"); } while (0)
    bf16x8 q[2][2];
#pragma unroll
    for (int s = 0; s < 2; ++s)
#pragma unroll
        for (int d = 0; d < 2; ++d) q[s][d] = *(const bf16x8*)(P + ((size_t)b * NKEY + 256 + qtok0 + 32 * s) * NIN + 9 * 256 + h * 64 + (2 * mp + d) * 16 + hi * 8);
    f32x16 o[2][2]; float mrun[2] = {0.f, 0.f}, lrun[2] = {0.f, 0.f}; bool trk[2] = {false, false};
#pragma unroll
    for (int s = 0; s < 2; ++s)
#pragma unroll
        for (int d0 = 0; d0 < 2; ++d0)
#pragma unroll
            for (int r = 0; r < 16; ++r) o[s][d0][r] = 0.f;
    D6_DMA2(0, 0); D6_DMA2(1, 1); D6_DMA2(2, 2);
    D6_BAR(2);
    const int ksw = (r32 >> 1) & 7;
    const int kc0 = ((4 * mp + hi) ^ ksw) << 4, kc1 = ((4 * mp + 2 + hi) ^ ksw) << 4;
    const int vb = ((lane >> 4) & 1) * 32 + (lane & 3) * 8 + (4 * hi + ((lane & 15) >> 2)) * 64;
    f32x16 z;
#pragma unroll
    for (int r = 0; r < 16; ++r) z[r] = 0.f;
    f32x16 X[2][2];
#define D6_QK(slot) do { const LAS unsigned char* kp = lds + D6_KB + (slot) * 8192 + r32 * 128; \
        const bf16x8 kf0 = *(const LAS bf16x8*)(kp + kc0), kf1 = *(const LAS bf16x8*)(kp + kc0 + 4096), kf2 = *(const LAS bf16x8*)(kp + kc1), kf3 = *(const LAS bf16x8*)(kp + kc1 + 4096); \
        _Pragma("unroll") for (int s = 0; s < 2; ++s) { X[s][0] = MFMA32(kf0, q[s][0], z); X[s][1] = MFMA32(kf1, q[s][0], z); } \
        _Pragma("unroll") for (int s = 0; s < 2; ++s) { X[s][0] = MFMA32(kf2, q[s][1], X[s][0]); X[s][1] = MFMA32(kf3, q[s][1], X[s][1]); } \
        asm volatile("s_nop 15\n\ts_nop 7" : "+v"(X[0][0]), "+v"(X[0][1]), "+v"(X[1][0]), "+v"(X[1][1])); } while (0)
    D6_QK(0);
    if (late) D6_BAR0();
#if D5_PROF
    const unsigned long long t6_0 = __builtin_amdgcn_s_memtime(); unsigned long long t6a = 0, t6acc = 0;
#define D6_T0(seg) do { if (D5_PROF_SEL == (seg)) t6a = __builtin_amdgcn_s_memtime(); } while (0)
#define D6_T1(seg) do { if (D5_PROF_SEL == (seg)) t6acc += __builtin_amdgcn_s_memtime() - t6a; } while (0)
#else
#define D6_T0(seg) do {} while (0)
#define D6_T1(seg) do {} while (0)
#endif
    for (int j4 = 0; j4 < 132; j4 += 4) {
#pragma unroll
        for (int jj = 0; jj < 4; ++jj) {
        const int j = j4 + jj; const int cur = jj;
        D6_T0(0);
        bf16x8 pw[2][4];
#pragma unroll
        for (int s = 0; s < 2; ++s) {
            f32x16& X0 = X[s][0]; f32x16& X1 = X[s][1];
            float ra = max3f(X0[0], X0[1], X0[2]), rb = max3f(X0[3], X0[4], X0[5]);
            ra = max3f(ra, X0[6], X0[7]); rb = max3f(rb, X0[8], X0[9]); ra = max3f(ra, X0[10], X0[11]); rb = max3f(rb, X0[12], X0[13]); ra = max3f(ra, X0[14], X0[15]);
            rb = max3f(rb, X1[0], X1[1]); ra = max3f(ra, X1[2], X1[3]); rb = max3f(rb, X1[4], X1[5]); ra = max3f(ra, X1[6], X1[7]); rb = max3f(rb, X1[8], X1[9]);
            ra = max3f(ra, X1[10], X1[11]); rb = max3f(rb, X1[12], X1[13]); ra = max3f(ra, X1[14], X1[15]);
            const float rm = swap_max(max2f(ra, rb));
            { bool resc; if (!trk[s]) resc = __any(rm > 30.0f) || (j == 0 && __any(rm < -30.0f)); else resc = __any(rm > mrun[s] + 6.0f);
              if (resc) { const float mn = (j == 0) ? rm : max2f(mrun[s], rm), f = ex2(mrun[s] - mn); mrun[s] = mn; lrun[s] *= f; trk[s] = true;
#pragma unroll
                  for (int r = 0; r < 16; ++r) { o[s][0][r] *= f; o[s][1][r] *= f; } } }
            if (trk[s]) { const float mm = mrun[s];
#pragma unroll
                for (int r = 0; r < 16; ++r) { X0[r] -= mm; X1[r] -= mm; } }
#pragma unroll
            for (int r = 0; r < 16; ++r) { X0[r] = ex2(X0[r]); X1[r] = ex2(X1[r]); }
            f32x2_t ps2 = (PSUM8(X0, 0) + PSUM8(X0, 8)) + (PSUM8(X1, 0) + PSUM8(X1, 8));
            lrun[s] += ps2.x + ps2.y;
            pw[s][0] = pack8(X0[0], X0[1], X0[2], X0[3], X0[4], X0[5], X0[6], X0[7]); pw[s][1] = pack8(X0[8], X0[9], X0[10], X0[11], X0[12], X0[13], X0[14], X0[15]);
            pw[s][2] = pack8(X1[0], X1[1], X1[2], X1[3], X1[4], X1[5], X1[6], X1[7]); pw[s][3] = pack8(X1[8], X1[9], X1[10], X1[11], X1[12], X1[13], X1[14], X1[15]);
        }
        asm volatile("" : "+v"(pw[0][0]), "+v"(pw[0][1]), "+v"(pw[0][2]), "+v"(pw[0][3]), "+v"(pw[1][0]), "+v"(pw[1][1]), "+v"(pw[1][2]), "+v"(pw[1][3]));
        D6_T1(0); D6_T0(1);
        SB(); D6_BAR0(); SB();
        D6_T1(1); D6_T0(2);
        if (j + 3 < 132) D6_DMA2(j + 3, (jj + 3) & 3);
        { const unsigned va = (unsigned)(__UINTPTR_TYPE__)(lds + vb);
#define D6_TR(dst, OFF) asm volatile("ds_read_b64_tr_b16 %0, %1 offset:%c2" : "=&v"(dst) : "v"(va), "i"(OFF) : "memory")
#define D6_VO(ks, d0) (D6_VB + cur * 8192 + (d0) * 4096 + (ks) * 1024)
          s16x4 a00l, a00h, a01l, a01h, a10l, a10h, a11l, a11h, b00l, b00h, b01l, b01h, b10l, b10h, b11l, b11h;
          D6_TR(a00l, D6_VO(0, 0)); D6_TR(a00h, D6_VO(0, 0) + 512); D6_TR(a01l, D6_VO(0, 1)); D6_TR(a01h, D6_VO(0, 1) + 512);
          D6_TR(a10l, D6_VO(1, 0)); D6_TR(a10h, D6_VO(1, 0) + 512); D6_TR(a11l, D6_VO(1, 1)); D6_TR(a11h, D6_VO(1, 1) + 512);
          asm volatile("s_waitcnt lgkmcnt(0)" ::: "memory"); SB();
          D6_TR(b00l, D6_VO(2, 0)); D6_TR(b00h, D6_VO(2, 0) + 512); D6_TR(b01l, D6_VO(2, 1)); D6_TR(b01h, D6_VO(2, 1) + 512);
          D6_TR(b10l, D6_VO(3, 0)); D6_TR(b10h, D6_VO(3, 0) + 512); D6_TR(b11l, D6_VO(3, 1)); D6_TR(b11h, D6_VO(3, 1) + 512);
          SB();
          { const bf16x8 v00 = mk8(a00l, a00h), v01 = mk8(a01l, a01h), v10 = mk8(a10l, a10h), v11 = mk8(a11l, a11h);
            o[0][0] = MFMA32(v00, pw[0][0], o[0][0]); o[1][0] = MFMA32(v00, pw[1][0], o[1][0]); o[0][1] = MFMA32(v01, pw[0][0], o[0][1]); o[1][1] = MFMA32(v01, pw[1][0], o[1][1]);
            o[0][0] = MFMA32(v10, pw[0][1], o[0][0]); o[1][0] = MFMA32(v10, pw[1][1], o[1][0]); o[0][1] = MFMA32(v11, pw[0][1], o[0][1]); o[1][1] = MFMA32(v11, pw[1][1], o[1][1]); }
          SB();
          asm volatile("s_waitcnt lgkmcnt(0)" ::: "memory"); SB();
          { const bf16x8 v20 = mk8(b00l, b00h), v21 = mk8(b01l, b01h), v30 = mk8(b10l, b10h), v31 = mk8(b11l, b11h);
            o[0][0] = MFMA32(v20, pw[0][2], o[0][0]); o[1][0] = MFMA32(v20, pw[1][2], o[1][0]); o[0][1] = MFMA32(v21, pw[0][2], o[0][1]); o[1][1] = MFMA32(v21, pw[1][2], o[1][1]);
            o[0][0] = MFMA32(v30, pw[0][3], o[0][0]); o[1][0] = MFMA32(v30, pw[1][3], o[1][0]); o[0][1] = MFMA32(v31, pw[0][3], o[0][1]); o[1][1] = MFMA32(v31, pw[1][3], o[1][1]); }
#undef D6_TR
#undef D6_VO
        }
        SB();
        D6_QK((jj + 1) & 3);
        asm volatile("" : "+v"(o[0][0]), "+v"(o[0][1]), "+v"(o[1][0]), "+v"(o[1][1]));
        SB();
        D6_T1(2); D6_T0(3);
        if (j + 3 < 132) D6_BAR(2); else D6_BAR(0);
        D6_T1(3);
        }
    }
    if (!late) D6_BAR0();
#if D5_PROF
    if (blockIdx.x == 0 && wid == D5_PROF_WAVE && lane == 0) { unsigned long long* pr = (unsigned long long*)(F.ws + WS_CTL) + 8192; if (pr[7] == 0) { pr[0] = (D5_PROF_SEL == 4) ? __builtin_amdgcn_s_memtime() - t6_0 : t6acc; pr[7] = 1; } }
#endif
#undef D6_DMA2
#undef D6_BAR
#undef D6_BAR0
#undef D6_QK
    const float lam = ((const float*)(F.ws + WS_LAM))[l]; const float omli = (l == 0) ? 0.8f : 0.64449093241f;
    const float il0 = 1.0f / swap_add(lrun[0]), il1 = 1.0f / swap_add(lrun[1]);
    LAS float* ex = (LAS float*)(lds + D6_EX) + (qg * 2 + mp) * 2048 + lane;
    { const int sg = 1 - mp; const float sc = (mp == 0) ? il1 : lam * il0;
#pragma unroll
      for (int d0 = 0; d0 < 2; ++d0)
#pragma unroll
          for (int r = 0; r < 16; ++r) ex[(d0 * 16 + r) * 64] = ((sg == 0) ? o[0][d0][r] : o[1][d0][r]) * sc; }
    __syncthreads();
    { const LAS float* exr = (const LAS float*)(lds + D6_EX) + (qg * 2 + (1 - mp)) * 2048 + lane;
      const int sk = mp;
      const float own = (mp == 0) ? il0 : lam * il1;
      float y[2][16]; float ss = 0.f;
#pragma unroll
      for (int d0 = 0; d0 < 2; ++d0)
#pragma unroll
          for (int r = 0; r < 16; ++r) { const float a = ((sk == 0) ? o[0][d0][r] : o[1][d0][r]) * own, pv = exr[(d0 * 16 + r) * 64];
              const float v = (mp == 0) ? a - pv : pv - a; y[d0][r] = v; ss += v * v; }
      ss = swap_add(ss);
      const float rs = omli / sqrtf(ss * (1.0f / 64.0f) + EPS); const float* sg = FIN(IN_SUBLN) + l * 64;
      const size_t ygrow = (size_t)b * SEQ + qtok0 + 32 * sk;
#pragma unroll
      for (int d0 = 0; d0 < 2; ++d0)
#pragma unroll
          for (int rg = 0; rg < 4; ++rg) { const int dv = 32 * d0 + 8 * rg + 4 * hi; const f32x4 g4 = *(const f32x4*)(sg + dv);
              u32x2 w; w.x = pk2(y[d0][4 * rg] * rs * g4.x, y[d0][4 * rg + 1] * rs * g4.y); w.y = pk2(y[d0][4 * rg + 2] * rs * g4.z, y[d0][4 * rg + 3] * rs * g4.w);
              *(u32x2*)(Y + ygrow * DM + 768 + h * 64 + dv) = w; } }
    __syncthreads();
}
#ifndef D7_VAR
#define D7_VAR 0
#endif
#ifndef D7_YPRIO
#define D7_YPRIO 0
#endif
#ifndef D7_PRIO
#define D7_PRIO 0
#endif
constexpr int D7_KB = 0, D7_VB = 49152, D7_EX = 0;
constexpr int D7_FLAG = 98304;
template <bool FAST>
__device__ __forceinline__ bool diff7_unit(Frame& F, int l, int b, int h, int blk) {
    LAUNDER_IDS
    const int r32 = lane & 31, hi = lane >> 5, mp = wid & 1, qg = wid >> 1;
    const bool late = wid >= 4;
    const bf16* P = (const bf16*)(F.ws + WS_A); bf16* Y = (bf16*)(F.ws + WS_B);
    LAS unsigned char* lds = F.lds;
    const int qtok0 = blk * 256 + qg * 64 + r32;
    const int krow = tid >> 3, kch = (tid & 7) ^ ((krow >> 1) & 7);
    const int vrow = 8 * ((tid & 255) >> 5) + (((tid & 255) >> 2) & 7), vch = 4 * (tid >> 8) + (tid & 3);
    const unsigned kofs = (unsigned)((krow * NIN + 10 * 256 + h * 64 + kch * 8) * 2), vofs = (unsigned)((vrow * NIN + 11 * 256 + h * 64 + vch * 8) * 2);
    const char* pbase = (const char*)(P + (size_t)b * NKEY * NIN);
    const int dmaw = wid * 1024;
#define D7_DMA(tile, slot) do { const char* tb_ = pbase + (size_t)(tile) * (64 * NIN * 2); \
        __builtin_amdgcn_global_load_lds((const unsigned*)(tb_ + kofs), (LAS unsigned*)(lds + D7_KB + (slot) * 8192 + dmaw), 16, 0, 0); \
        __builtin_amdgcn_global_load_lds((const unsigned*)(tb_ + vofs), (LAS unsigned*)(lds + D7_VB + (slot) * 8192 + dmaw), 16, 0, 0); } while (0)
#define D7_TILE_BAR(bi, slot_m2) do { if ((bi) + 3 < 132) asm volatile("s_waitcnt vmcnt(4)" ::: "memory"); else asm volatile("s_waitcnt vmcnt(0)" ::: "memory"); \
        asm volatile("s_waitcnt lgkmcnt(0)" ::: "memory"); if (!(D7_VAR & 2)) __builtin_amdgcn_s_barrier(); asm volatile("" ::: "memory"); \
        if (!(D7_VAR & 1) && (bi) + 4 < 132) D7_DMA((bi) + 4, slot_m2); } while (0)
    bf16x8 q[2][2];
#pragma unroll
    for (int s = 0; s < 2; ++s)
#pragma unroll
        for (int d = 0; d < 2; ++d) q[s][d] = *(const bf16x8*)(P + ((size_t)b * NKEY + 256 + qtok0 + 32 * s) * NIN + 9 * 256 + h * 64 + (2 * mp + d) * 16 + hi * 8);
    f32x16 o[2][2]; float mrun[2] = {0.f, 0.f}, lrun[2] = {0.f, 0.f};
#pragma unroll
    for (int s = 0; s < 2; ++s)
#pragma unroll
        for (int d0 = 0; d0 < 2; ++d0)
#pragma unroll
            for (int r = 0; r < 16; ++r) o[s][d0][r] = 0.f;
    D7_DMA(0, 0); D7_DMA(1, 1); D7_DMA(2, 2); D7_DMA(3, 3);
    if (FAST && tid == 0) *(volatile LAS int*)(lds + D7_FLAG) = 0;
    asm volatile("s_waitcnt vmcnt(4) lgkmcnt(0)" ::: "memory"); __builtin_amdgcn_s_barrier(); asm volatile("" ::: "memory");
    D7_DMA(4, 4);
    const int ksw = (r32 >> 1) & 7;
    const unsigned lds0 = (unsigned)(__UINTPTR_TYPE__)lds;
    const unsigned ka0 = lds0 + D7_KB + r32 * 128 + (((4 * mp + hi) ^ ksw) << 4), ka1 = lds0 + D7_KB + r32 * 128 + (((4 * mp + 2 + hi) ^ ksw) << 4);
    const unsigned va0 = lds0 + D7_VB + ((lane >> 4) & 1) * 32 + (lane & 3) * 8 + (4 * hi + ((lane & 15) >> 2)) * 64;
    f32x16 z;
#pragma unroll
    for (int r = 0; r < 16; ++r) z[r] = 0.f;
    f32x16 X[2][2];
#define D7_R128(dst, addr, OFF) do { if (D7_VAR & 8) asm volatile("" : "=v"(dst)); else asm volatile("ds_read_b128 %0, %1 offset:%c2" : "=&v"(dst) : "v"(addr), "i"(OFF) : "memory"); } while (0)
#define D7_QK(slot) do { const unsigned k0_ = ka0 + (slot) * 8192, k1_ = ka1 + (slot) * 8192; bf16x8 kf0, kf1, kf2, kf3; \
        D7_R128(kf0, k0_, 0); D7_R128(kf1, k0_, 4096); D7_R128(kf2, k1_, 0); D7_R128(kf3, k1_, 4096); \
        asm volatile("s_waitcnt lgkmcnt(0)" ::: "memory"); SB(); \
        _Pragma("unroll") for (int s = 0; s < 2; ++s) { X[s][0] = MFMA32(kf0, q[s][0], z); X[s][1] = MFMA32(kf1, q[s][0], z); } \
        _Pragma("unroll") for (int s = 0; s < 2; ++s) { X[s][0] = MFMA32(kf2, q[s][1], X[s][0]); X[s][1] = MFMA32(kf3, q[s][1], X[s][1]); } \
        asm volatile("s_nop 15\n\ts_nop 7" : "+v"(X[0][0]), "+v"(X[0][1]), "+v"(X[1][0]), "+v"(X[1][1])); } while (0)
    D7_QK(0);
    int sj = 0;
#if D7_YPRIO
    if (late) asm volatile("s_setprio 1");
#endif
#if D5_PROF
    const unsigned long long t7_0 = __builtin_amdgcn_s_memtime(); unsigned long long t7a = 0, t7acc = 0;
#define D7_T0(seg) do { if (D5_PROF_SEL == (seg)) t7a = __builtin_amdgcn_s_memtime(); } while (0)
#define D7_T1(seg) do { if (D5_PROF_SEL == (seg)) t7acc += __builtin_amdgcn_s_memtime() - t7a; } while (0)
#else
#define D7_T0(seg) do {} while (0)
#define D7_T1(seg) do {} while (0)
#endif
#pragma unroll 1
    for (int j = 0; j < 132; ++j) {
        const int s1 = (sj == 5) ? 0 : sj + 1, sm1 = (sj == 0) ? 5 : sj - 1;
        bf16x8 pw[2][4];
        if (j > 0) D7_T1(5);
        D7_T0(0);
#pragma unroll
        for (int s = 0; s < 2; ++s) {
            f32x16& X0 = X[s][0]; f32x16& X1 = X[s][1];
            if (!FAST) {
            float ra = max3f(X0[0], X0[1], X0[2]), rb = max3f(X0[3], X0[4], X0[5]);
            ra = max3f(ra, X0[6], X0[7]); rb = max3f(rb, X0[8], X0[9]); ra = max3f(ra, X0[10], X0[11]); rb = max3f(rb, X0[12], X0[13]); ra = max3f(ra, X0[14], X0[15]);
            rb = max3f(rb, X1[0], X1[1]); ra = max3f(ra, X1[2], X1[3]); rb = max3f(rb, X1[4], X1[5]); ra = max3f(ra, X1[6], X1[7]); rb = max3f(rb, X1[8], X1[9]);
            ra = max3f(ra, X1[10], X1[11]); rb = max3f(rb, X1[12], X1[13]); ra = max3f(ra, X1[14], X1[15]);
            const float rm = swap_max(max2f(ra, rb));
            if (j == 0) mrun[s] = rm;
            else if (__any(rm > mrun[s] + 6.0f)) { const float mn = max2f(mrun[s], rm), f = ex2(mrun[s] - mn); mrun[s] = mn; lrun[s] *= f;
#pragma unroll
                for (int r = 0; r < 16; ++r) { o[s][0][r] *= f; o[s][1][r] *= f; } }
            { const float mm = mrun[s];
#pragma unroll
              for (int r = 0; r < 16; ++r) { X0[r] -= mm; X1[r] -= mm; } }
            }
            f32x2_t ps2;
#pragma unroll
            for (int r = 0; r < 16; ++r) if (!(D7_VAR & 32)) X0[r] = ex2(X0[r]);
            if (D7_VAR & 4) ps2 = (f32x2_t){X0[0], X0[1]}; else ps2 = PSUM8(X0, 0) + PSUM8(X0, 8);
            pw[s][0] = pack8(X0[0], X0[1], X0[2], X0[3], X0[4], X0[5], X0[6], X0[7]); pw[s][1] = pack8(X0[8], X0[9], X0[10], X0[11], X0[12], X0[13], X0[14], X0[15]);
            asm volatile("" : "+v"(pw[s][0]), "+v"(pw[s][1]), "+v"(ps2)); SB();
#pragma unroll
            for (int r = 0; r < 16; ++r) if (!(D7_VAR & 32)) X1[r] = ex2(X1[r]);
            if (!(D7_VAR & 4)) ps2 += PSUM8(X1, 0) + PSUM8(X1, 8);
            lrun[s] += ps2.x + ps2.y;
            pw[s][2] = pack8(X1[0], X1[1], X1[2], X1[3], X1[4], X1[5], X1[6], X1[7]); pw[s][3] = pack8(X1[8], X1[9], X1[10], X1[11], X1[12], X1[13], X1[14], X1[15]);
            asm volatile("" : "+v"(pw[s][2]), "+v"(pw[s][3]), "+v"(lrun[s])); SB();
        }
        asm volatile("" : "+v"(pw[0][0]), "+v"(pw[0][1]), "+v"(pw[0][2]), "+v"(pw[0][3]), "+v"(pw[1][0]), "+v"(pw[1][1]), "+v"(pw[1][2]), "+v"(pw[1][3]));
        SB();
        D7_T1(0); D7_T0(1);
        if (late) D7_TILE_BAR(j + 1, sm1);
        SB();
        D7_T1(1); D7_T0(2);
#if D7_PRIO
        asm volatile("s_setprio 1");
#endif
        { const unsigned va = va0 + sj * 8192;
#define D7_TR(dst, OFF) do { if (D7_VAR & 8) asm volatile("" : "=v"(dst)); else asm volatile("ds_read_b64_tr_b16 %0, %1 offset:%c2" : "=&v"(dst) : "v"(va), "i"(OFF) : "memory"); } while (0)
#define D7_VO(ks, d0) ((d0) * 4096 + (ks) * 1024)
          s16x4 a00l, a00h, a01l, a01h, a10l, a10h, a11l, a11h, b00l, b00h, b01l, b01h, b10l, b10h, b11l, b11h;
          D7_TR(a00l, D7_VO(0, 0)); D7_TR(a00h, D7_VO(0, 0) + 512); D7_TR(a01l, D7_VO(0, 1)); D7_TR(a01h, D7_VO(0, 1) + 512);
          D7_TR(a10l, D7_VO(1, 0)); D7_TR(a10h, D7_VO(1, 0) + 512); D7_TR(a11l, D7_VO(1, 1)); D7_TR(a11h, D7_VO(1, 1) + 512);
          asm volatile("s_waitcnt lgkmcnt(0)" ::: "memory"); SB();
          D7_TR(b00l, D7_VO(2, 0)); D7_TR(b00h, D7_VO(2, 0) + 512); D7_TR(b01l, D7_VO(2, 1)); D7_TR(b01h, D7_VO(2, 1) + 512);
          D7_TR(b10l, D7_VO(3, 0)); D7_TR(b10h, D7_VO(3, 0) + 512); D7_TR(b11l, D7_VO(3, 1)); D7_TR(b11h, D7_VO(3, 1) + 512);
          SB();
          { const bf16x8 v00 = mk8(a00l, a00h), v01 = mk8(a01l, a01h), v10 = mk8(a10l, a10h), v11 = mk8(a11l, a11h);
            o[0][0] = MFMA32(v00, pw[0][0], o[0][0]); o[1][0] = MFMA32(v00, pw[1][0], o[1][0]); o[0][1] = MFMA32(v01, pw[0][0], o[0][1]); o[1][1] = MFMA32(v01, pw[1][0], o[1][1]);
            o[0][0] = MFMA32(v10, pw[0][1], o[0][0]); o[1][0] = MFMA32(v10, pw[1][1], o[1][0]); o[0][1] = MFMA32(v11, pw[0][1], o[0][1]); o[1][1] = MFMA32(v11, pw[1][1], o[1][1]); }
          SB();
          asm volatile("s_waitcnt lgkmcnt(0)" ::: "memory"); SB();
          { const bf16x8 v20 = mk8(b00l, b00h), v21 = mk8(b01l, b01h), v30 = mk8(b10l, b10h), v31 = mk8(b11l, b11h);
            o[0][0] = MFMA32(v20, pw[0][2], o[0][0]); o[1][0] = MFMA32(v20, pw[1][2], o[1][0]); o[0][1] = MFMA32(v21, pw[0][2], o[0][1]); o[1][1] = MFMA32(v21, pw[1][2], o[1][1]);
            o[0][0] = MFMA32(v30, pw[0][3], o[0][0]); o[1][0] = MFMA32(v30, pw[1][3], o[1][0]); o[0][1] = MFMA32(v31, pw[0][3], o[0][1]); o[1][1] = MFMA32(v31, pw[1][3], o[1][1]); }
#undef D7_TR
#undef D7_VO
        }
        SB();
        D7_QK(s1);
        asm volatile("" : "+v"(o[0][0]), "+v"(o[0][1]), "+v"(o[1][0]), "+v"(o[1][1]));
#if D7_PRIO
        asm volatile("s_setprio 0");
#endif
        SB();
        D7_T1(2); D7_T0(3);
        if (!late) D7_TILE_BAR(j + 1, sm1);
        SB();
        D7_T1(3); D7_T0(5);
        sj = s1;
    }
#if D5_PROF
    if (FAST && blockIdx.x == 0 && wid == D5_PROF_WAVE && lane == 0) { unsigned long long* pr = (unsigned long long*)(F.ws + WS_CTL) + 8192; if (pr[7] == 0) { pr[0] = (D5_PROF_SEL == 4) ? __builtin_amdgcn_s_memtime() - t7_0 : t7acc; pr[7] = 1; } }
#endif
#if D7_YPRIO
    asm volatile("s_setprio 0");
#endif
    asm volatile("s_waitcnt vmcnt(0)" ::: "memory");
    __syncthreads();
#undef D7_DMA
#undef D7_TILE_BAR
#undef D7_QK
#undef D7_R128
    const float lam = ((const float*)(F.ws + WS_LAM))[l]; const float omli = (l == 0) ? 0.8f : 0.64449093241f;
    const float l0 = swap_add(lrun[0]), l1 = swap_add(lrun[1]);
    const float il0 = 1.0f / l0, il1 = 1.0f / l1;
    if (FAST) { bool bad = !(l0 > 7.9e-31f && l0 < 1.3e33f) || !(l1 > 7.9e-31f && l1 < 1.3e33f);
#ifdef D7_FORCE_REDO
        bad = bad || ((blk & 7) == 3 && wid == 5);
#endif
        if (__any(bad) && lane == 0) *(volatile LAS int*)(lds + D7_FLAG) = 1; }
    LAS float* ex = (LAS float*)(lds + D7_EX) + (qg * 2 + mp) * 2048 + lane;
    { const int sg = 1 - mp; const float sc = (mp == 0) ? il1 : lam * il0;
#pragma unroll
      for (int d0 = 0; d0 < 2; ++d0)
#pragma unroll
          for (int r = 0; r < 16; ++r) ex[(d0 * 16 + r) * 64] = ((sg == 0) ? o[0][d0][r] : o[1][d0][r]) * sc; }
    __syncthreads();
    const bool redo = FAST && (*(volatile LAS int*)(lds + D7_FLAG) != 0);
    { const LAS float* exr = (const LAS float*)(lds + D7_EX) + (qg * 2 + (1 - mp)) * 2048 + lane;
      const int sk = mp;
      const float own = (mp == 0) ? il0 : lam * il1;
      float y[2][16]; float ss = 0.f;
#pragma unroll
      for (int d0 = 0; d0 < 2; ++d0)
#pragma unroll
          for (int r = 0; r < 16; ++r) { const float a = ((sk == 0) ? o[0][d0][r] : o[1][d0][r]) * own, pv = exr[(d0 * 16 + r) * 64];
              const float v = (mp == 0) ? a - pv : pv - a; y[d0][r] = v; ss += v * v; }
      ss = swap_add(ss);
      const float rs = omli / sqrtf(ss * (1.0f / 64.0f) + EPS); const float* sg = FIN(IN_SUBLN) + l * 64;
      const size_t ygrow = (size_t)b * SEQ + qtok0 + 32 * sk;
#pragma unroll
      for (int d0 = 0; d0 < 2; ++d0)
#pragma unroll
          for (int rg = 0; rg < 4; ++rg) { const int dv = 32 * d0 + 8 * rg + 4 * hi; const f32x4 g4 = *(const f32x4*)(sg + dv);
              u32x2 w; w.x = pk2(y[d0][4 * rg] * rs * g4.x, y[d0][4 * rg + 1] * rs * g4.y); w.y = pk2(y[d0][4 * rg + 2] * rs * g4.z, y[d0][4 * rg + 3] * rs * g4.w);
              *(u32x2*)(Y + ygrow * DM + 768 + h * 64 + dv) = w; } }
    __syncthreads();
    return redo;
}
#define D8_VAR 0
#define D8_PRIO 0
constexpr int D8_KB = 0, D8_VB = 65536, D8_EX = 0;
constexpr int D8_FLAG = MISC_OFF + 128;
template <bool FAST>
__device__ __forceinline__ bool diff8_unit(Frame& F, int l, int b, int h, int blk) {
    LAUNDER_IDS
    const int r32 = lane & 31, hi = lane >> 5, mp = wid & 1, qg = wid >> 1;
    const bool late = wid >= 4;
    const bf16* P = (const bf16*)(F.ws + WS_A); bf16* Y = (bf16*)(F.ws + WS_B);
    LAS unsigned char* lds = F.lds;
    const int qtok0 = blk * 256 + qg * 64 + r32;
    const int krow = tid >> 3, kch = (tid & 7) ^ ((krow >> 1) & 7);
    const int vrow = 8 * ((tid & 255) >> 5) + (((tid & 255) >> 2) & 7), vch = 4 * (tid >> 8) + (tid & 3);
    const unsigned kofs = (unsigned)((krow * NIN + 10 * 256 + h * 64 + kch * 8) * 2), vofs = (unsigned)((vrow * NIN + 11 * 256 + h * 64 + vch * 8) * 2);
    const char* pbase = (const char*)(P + (size_t)b * NKEY * NIN);
    const int dmaw = wid * 1024;
#define D8_DMA(tile, slot) do { const char* tb_ = pbase + (size_t)(tile) * (64 * NIN * 2); \
        __builtin_amdgcn_global_load_lds((const unsigned*)(tb_ + kofs), (LAS unsigned*)(lds + D8_KB + (slot) * 8192 + dmaw), 16, 0, 0); \
        __builtin_amdgcn_global_load_lds((const unsigned*)(tb_ + vofs), (LAS unsigned*)(lds + D8_VB + (slot) * 8192 + dmaw), 16, 0, 0); } while (0)
#define D8_TILE_BAR(t0) do { asm volatile("s_waitcnt vmcnt(0) lgkmcnt(0)" ::: "memory"); __builtin_amdgcn_s_barrier(); asm volatile("" ::: "memory"); \
        if ((t0) < 132) D8_DMA((t0), (t0) & 7); if ((t0) + 1 < 132) D8_DMA((t0) + 1, ((t0) + 1) & 7); } while (0)
    bf16x8 q[2][2];
#pragma unroll
    for (int s = 0; s < 2; ++s)
#pragma unroll
        for (int d = 0; d < 2; ++d) q[s][d] = *(const bf16x8*)(P + ((size_t)b * NKEY + 256 + qtok0 + 32 * s) * NIN + 9 * 256 + h * 64 + (2 * mp + d) * 16 + hi * 8);
    f32x16 o[2][2]; float mrun[2] = {0.f, 0.f}, lrun[2] = {0.f, 0.f};
#pragma unroll
    for (int s = 0; s < 2; ++s)
#pragma unroll
        for (int d0 = 0; d0 < 2; ++d0)
#pragma unroll
            for (int r = 0; r < 16; ++r) o[s][d0][r] = 0.f;
    D8_DMA(0, 0); D8_DMA(1, 1); D8_DMA(2, 2);
    if (FAST && tid == 0) *(volatile LAS int*)(lds + D8_FLAG) = 0;
    asm volatile("s_waitcnt vmcnt(0) lgkmcnt(0)" ::: "memory"); __builtin_amdgcn_s_barrier(); asm volatile("" ::: "memory");
    D8_DMA(3, 3); D8_DMA(4, 4);
    const int ksw = (r32 >> 1) & 7;
    const unsigned lds0 = (unsigned)(__UINTPTR_TYPE__)lds;
    const unsigned ka0 = lds0 + D8_KB + r32 * 128 + (((4 * mp + hi) ^ ksw) << 4), ka1 = lds0 + D8_KB + r32 * 128 + (((4 * mp + 2 + hi) ^ ksw) << 4);
    const unsigned va0 = lds0 + D8_VB + ((lane >> 4) & 1) * 32 + (lane & 3) * 8 + (4 * hi + ((lane & 15) >> 2)) * 64;
    f32x16 z;
#pragma unroll
    for (int r = 0; r < 16; ++r) z[r] = 0.f;
    f32x16 X[2][2];
#define D8_R128(dst, addr, OFF) do { if (D8_VAR & 8) asm volatile("" : "=v"(dst)); else asm volatile("ds_read_b128 %0, %1 offset:%c2" : "=&v"(dst) : "v"(addr), "i"(OFF) : "memory"); } while (0)
#define D8_QK(slot) do { const unsigned k0_ = ka0 + (slot) * 8192, k1_ = ka1 + (slot) * 8192; bf16x8 kf0, kf1, kf2, kf3; \
        D8_R128(kf0, k0_, 0); D8_R128(kf1, k0_, 4096); D8_R128(kf2, k1_, 0); D8_R128(kf3, k1_, 4096); \
        asm volatile("s_waitcnt lgkmcnt(0)" ::: "memory"); SB(); \
        _Pragma("unroll") for (int s = 0; s < 2; ++s) { X[s][0] = MFMA32(kf0, q[s][0], z); X[s][1] = MFMA32(kf1, q[s][0], z); } \
        _Pragma("unroll") for (int s = 0; s < 2; ++s) { X[s][0] = MFMA32(kf2, q[s][1], X[s][0]); X[s][1] = MFMA32(kf3, q[s][1], X[s][1]); } \
        asm volatile("s_nop 15\n\ts_nop 7" : "+v"(X[0][0]), "+v"(X[0][1]), "+v"(X[1][0]), "+v"(X[1][1])); } while (0)
    D8_QK(0);
    int sj = 0;
#if D5_PROF
    const unsigned long long t7_0 = __builtin_amdgcn_s_memtime(); unsigned long long t7a = 0, t7acc = 0;
#define D8_T0(seg) do { if (D5_PROF_SEL == (seg)) t7a = __builtin_amdgcn_s_memtime(); } while (0)
#define D8_T1(seg) do { if (D5_PROF_SEL == (seg)) t7acc += __builtin_amdgcn_s_memtime() - t7a; } while (0)
#else
#define D8_T0(seg) do {} while (0)
#define D8_T1(seg) do {} while (0)
#endif
#pragma unroll 1
    for (int j = 0; j < 132; ++j) {
        const int s1 = (sj + 1) & 7;
        bf16x8 pw[2][4];
        if (j > 0) D8_T1(5);
        D8_T0(0);
#pragma unroll
        for (int s = 0; s < 2; ++s) {
            f32x16& X0 = X[s][0]; f32x16& X1 = X[s][1];
            if (!FAST) {
            float ra = max3f(X0[0], X0[1], X0[2]), rb = max3f(X0[3], X0[4], X0[5]);
            ra = max3f(ra, X0[6], X0[7]); rb = max3f(rb, X0[8], X0[9]); ra = max3f(ra, X0[10], X0[11]); rb = max3f(rb, X0[12], X0[13]); ra = max3f(ra, X0[14], X0[15]);
            rb = max3f(rb, X1[0], X1[1]); ra = max3f(ra, X1[2], X1[3]); rb = max3f(rb, X1[4], X1[5]); ra = max3f(ra, X1[6], X1[7]); rb = max3f(rb, X1[8], X1[9]);
            ra = max3f(ra, X1[10], X1[11]); rb = max3f(rb, X1[12], X1[13]); ra = max3f(ra, X1[14], X1[15]);
            const float rm = swap_max(max2f(ra, rb));
            if (j == 0) mrun[s] = rm;
            else if (__any(rm > mrun[s] + 6.0f)) { const float mn = max2f(mrun[s], rm), f = ex2(mrun[s] - mn); mrun[s] = mn; lrun[s] *= f;
#pragma unroll
                for (int r = 0; r < 16; ++r) { o[s][0][r] *= f; o[s][1][r] *= f; } }
            { const float mm = mrun[s];
#pragma unroll
              for (int r = 0; r < 16; ++r) { X0[r] -= mm; X1[r] -= mm; } }
            }
            f32x2_t ps2;
#pragma unroll
            for (int r = 0; r < 16; ++r) if (!(D8_VAR & 32)) X0[r] = ex2(X0[r]);
            if (D8_VAR & 4) ps2 = (f32x2_t){X0[0], X0[1]}; else ps2 = PSUM8(X0, 0) + PSUM8(X0, 8);
            pw[s][0] = pack8(X0[0], X0[1], X0[2], X0[3], X0[4], X0[5], X0[6], X0[7]); pw[s][1] = pack8(X0[8], X0[9], X0[10], X0[11], X0[12], X0[13], X0[14], X0[15]);
            asm volatile("" : "+v"(pw[s][0]), "+v"(pw[s][1]), "+v"(ps2)); SB();
#pragma unroll
            for (int r = 0; r < 16; ++r) if (!(D8_VAR & 32)) X1[r] = ex2(X1[r]);
            if (!(D8_VAR & 4)) ps2 += PSUM8(X1, 0) + PSUM8(X1, 8);
            lrun[s] += ps2.x + ps2.y;
            pw[s][2] = pack8(X1[0], X1[1], X1[2], X1[3], X1[4], X1[5], X1[6], X1[7]); pw[s][3] = pack8(X1[8], X1[9], X1[10], X1[11], X1[12], X1[13], X1[14], X1[15]);
            asm volatile("" : "+v"(pw[s][2]), "+v"(pw[s][3]), "+v"(lrun[s])); SB();
        }
        asm volatile("" : "+v"(pw[0][0]), "+v"(pw[0][1]), "+v"(pw[0][2]), "+v"(pw[0][3]), "+v"(pw[1][0]), "+v"(pw[1][1]), "+v"(pw[1][2]), "+v"(pw[1][3]));
        SB();
        D8_T1(0); D8_T0(1);
        if (late && !(j & 1)) D8_TILE_BAR(j + 5);
        SB();
        D8_T1(1); D8_T0(2);
#if D8_PRIO
        asm volatile("s_setprio 1");
#endif
        { const unsigned va = va0 + sj * 8192;
#define D8_TR(dst, OFF) do { if (D8_VAR & 8) asm volatile("" : "=v"(dst)); else asm volatile("ds_read_b64_tr_b16 %0, %1 offset:%c2" : "=&v"(dst) : "v"(va), "i"(OFF) : "memory"); } while (0)
#define D8_VO(ks, d0) ((d0) * 4096 + (ks) * 1024)
          s16x4 a00l, a00h, a01l, a01h, a10l, a10h, a11l, a11h, b00l, b00h, b01l, b01h, b10l, b10h, b11l, b11h;
          D8_TR(a00l, D8_VO(0, 0)); D8_TR(a00h, D8_VO(0, 0) + 512); D8_TR(a01l, D8_VO(0, 1)); D8_TR(a01h, D8_VO(0, 1) + 512);
          D8_TR(a10l, D8_VO(1, 0)); D8_TR(a10h, D8_VO(1, 0) + 512); D8_TR(a11l, D8_VO(1, 1)); D8_TR(a11h, D8_VO(1, 1) + 512);
          asm volatile("s_waitcnt lgkmcnt(0)" ::: "memory"); SB();
          D8_TR(b00l, D8_VO(2, 0)); D8_TR(b00h, D8_VO(2, 0) + 512); D8_TR(b01l, D8_VO(2, 1)); D8_TR(b01h, D8_VO(2, 1) + 512);
          D8_TR(b10l, D8_VO(3, 0)); D8_TR(b10h, D8_VO(3, 0) + 512); D8_TR(b11l, D8_VO(3, 1)); D8_TR(b11h, D8_VO(3, 1) + 512);
          SB();
          { const bf16x8 v00 = mk8(a00l, a00h), v01 = mk8(a01l, a01h), v10 = mk8(a10l, a10h), v11 = mk8(a11l, a11h);
            o[0][0] = MFMA32(v00, pw[0][0], o[0][0]); o[1][0] = MFMA32(v00, pw[1][0], o[1][0]); o[0][1] = MFMA32(v01, pw[0][0], o[0][1]); o[1][1] = MFMA32(v01, pw[1][0], o[1][1]);
            o[0][0] = MFMA32(v10, pw[0][1], o[0][0]); o[1][0] = MFMA32(v10, pw[1][1], o[1][0]); o[0][1] = MFMA32(v11, pw[0][1], o[0][1]); o[1][1] = MFMA32(v11, pw[1][1], o[1][1]); }
          SB();
          asm volatile("s_waitcnt lgkmcnt(0)" ::: "memory"); SB();
          { const bf16x8 v20 = mk8(b00l, b00h), v21 = mk8(b01l, b01h), v30 = mk8(b10l, b10h), v31 = mk8(b11l, b11h);
            o[0][0] = MFMA32(v20, pw[0][2], o[0][0]); o[1][0] = MFMA32(v20, pw[1][2], o[1][0]); o[0][1] = MFMA32(v21, pw[0][2], o[0][1]); o[1][1] = MFMA32(v21, pw[1][2], o[1][1]);
            o[0][0] = MFMA32(v30, pw[0][3], o[0][0]); o[1][0] = MFMA32(v30, pw[1][3], o[1][0]); o[0][1] = MFMA32(v31, pw[0][3], o[0][1]); o[1][1] = MFMA32(v31, pw[1][3], o[1][1]); }
#undef D8_TR
#undef D8_VO
        }
        SB();
        D8_QK(s1);
        asm volatile("" : "+v"(o[0][0]), "+v"(o[0][1]), "+v"(o[1][0]), "+v"(o[1][1]));
#if D8_PRIO
        asm volatile("s_setprio 0");
#endif
        SB();
        D8_T1(2); D8_T0(3);
        if (!late && (j & 1)) D8_TILE_BAR(j + 4);
        SB();
        D8_T1(3); D8_T0(5);
        sj = s1;
    }
#if D5_PROF
    if (FAST && blockIdx.x == 0 && wid == D5_PROF_WAVE && lane == 0) { unsigned long long* pr = (unsigned long long*)(F.ws + WS_CTL) + 8192; if (pr[7] == 0) { pr[0] = (D5_PROF_SEL == 4) ? __builtin_amdgcn_s_memtime() - t7_0 : t7acc; pr[7] = 1; } }
#endif
    asm volatile("s_waitcnt vmcnt(0)" ::: "memory");
    __syncthreads();
#undef D8_DMA
#undef D8_TILE_BAR
#undef D8_QK
#undef D8_R128
    const float lam = ((const float*)(F.ws + WS_LAM))[l]; const float omli = (l == 0) ? 0.8f : 0.64449093241f;
    const float l0 = swap_add(lrun[0]), l1 = swap_add(lrun[1]);
    const float il0 = 1.0f / l0, il1 = 1.0f / l1;
    if (FAST) { bool bad = !(l0 > 7.9e-31f && l0 < 1.3e33f) || !(l1 > 7.9e-31f && l1 < 1.3e33f);
#ifdef D8_FORCE_REDO
        bad = bad || ((blk & 7) == 3 && wid == 5);
#endif
        if (__any(bad) && lane == 0) *(volatile LAS int*)(lds + D8_FLAG) = 1; }
    LAS float* ex = (LAS float*)(lds + D8_EX) + (qg * 2 + mp) * 2048 + lane;
    { const int sg = 1 - mp; const float sc = (mp == 0) ? il1 : lam * il0;
#pragma unroll
      for (int d0 = 0; d0 < 2; ++d0)
#pragma unroll
          for (int r = 0; r < 16; ++r) ex[(d0 * 16 + r) * 64] = ((sg == 0) ? o[0][d0][r] : o[1][d0][r]) * sc; }
    __syncthreads();
    const bool redo = FAST && (*(volatile LAS int*)(lds + D8_FLAG) != 0);
    { const LAS float* exr = (const LAS float*)(lds + D8_EX) + (qg * 2 + (1 - mp)) * 2048 + lane;
      const int sk = mp;
      const float own = (mp == 0) ? il0 : lam * il1;
      float y[2][16]; float ss = 0.f;
#pragma unroll
      for (int d0 = 0; d0 < 2; ++d0)
#pragma unroll
          for (int r = 0; r < 16; ++r) { const float a = ((sk == 0) ? o[0][d0][r] : o[1][d0][r]) * own, pv = exr[(d0 * 16 + r) * 64];
              const float v = (mp == 0) ? a - pv : pv - a; y[d0][r] = v; ss += v * v; }
      ss = swap_add(ss);
      const float rs = omli / sqrtf(ss * (1.0f / 64.0f) + EPS); const float* sg = FIN(IN_SUBLN) + l * 64;
      const size_t ygrow = (size_t)b * SEQ + qtok0 + 32 * sk;
#pragma unroll
      for (int d0 = 0; d0 < 2; ++d0)
#pragma unroll
          for (int rg = 0; rg < 4; ++rg) { const int dv = 32 * d0 + 8 * rg + 4 * hi; const f32x4 g4 = *(const f32x4*)(sg + dv);
              u32x2 w; w.x = pk2(y[d0][4 * rg] * rs * g4.x, y[d0][4 * rg + 1] * rs * g4.y); w.y = pk2(y[d0][4 * rg + 2] * rs * g4.z, y[d0][4 * rg + 3] * rs * g4.w);
              *(u32x2*)(Y + ygrow * DM + 768 + h * 64 + dv) = w; } }
    __syncthreads();
    return redo;
}
#define D9_VAR 0
#define D9_PRIO 0
constexpr int D9_KB = 0, D9_VB = 49152, D9_EX = 0;
constexpr int D9_FLAG = 98304 + 64;
template <bool FAST>
__device__ __forceinline__ bool diff9_unit(Frame& F, int l, int b, int h, int blk) {
    LAUNDER_IDS
    const int r32 = lane & 31, hi = lane >> 5, mp = wid & 1, qg = wid >> 1;
    const bool late = wid >= 4;
    const bf16* P = (const bf16*)(F.ws + WS_A); bf16* Y = (bf16*)(F.ws + WS_B);
    LAS unsigned char* lds = F.lds;
    const int qtok0 = blk * 256 + qg * 64 + r32;
    const int krow = tid >> 3, kch = (tid & 7) ^ ((krow >> 1) & 7);
    const int vrow = 8 * ((tid & 255) >> 5) + (((tid & 255) >> 2) & 7), vch = 4 * (tid >> 8) + (tid & 3);
    const unsigned kofs = (unsigned)((krow * NIN + 10 * 256 + h * 64 + kch * 8) * 2), vofs = (unsigned)((vrow * NIN + 11 * 256 + h * 64 + vch * 8) * 2);
    const char* pbase = (const char*)(P + (size_t)b * NKEY * NIN);
    const int dmaw = wid * 1024;
#define D9_DMA(tile, slot) do { const char* tb_ = pbase + (size_t)(tile) * (64 * NIN * 2); \
        __builtin_amdgcn_global_load_lds((const unsigned*)(tb_ + kofs), (LAS unsigned*)(lds + D9_KB + (slot) * 8192 + dmaw), 16, 0, 0); \
        __builtin_amdgcn_global_load_lds((const unsigned*)(tb_ + vofs), (LAS unsigned*)(lds + D9_VB + (slot) * 8192 + dmaw), 16, 0, 0); } while (0)
#define D9_TILE_BAR(bi, slot_m2) do { if ((bi) + 3 < 132) asm volatile("s_waitcnt vmcnt(4)" ::: "memory"); else asm volatile("s_waitcnt vmcnt(0)" ::: "memory"); \
        asm volatile("s_waitcnt lgkmcnt(0)" ::: "memory"); if (!(D9_VAR & 2)) __builtin_amdgcn_s_barrier(); asm volatile("" ::: "memory"); \
        if (!(D9_VAR & 1) && (bi) + 4 < 132) D9_DMA((bi) + 4, slot_m2); } while (0)
    bf16x8 q[2][2];
#pragma unroll
    for (int s = 0; s < 2; ++s)
#pragma unroll
        for (int d = 0; d < 2; ++d) q[s][d] = *(const bf16x8*)(P + ((size_t)b * NKEY + 256 + qtok0 + 32 * s) * NIN + 9 * 256 + h * 64 + (2 * mp + d) * 16 + hi * 8);
    f32x16 o[2][2]; float mrun[2] = {0.f, 0.f}, lrun[2] = {0.f, 0.f};
#pragma unroll
    for (int s = 0; s < 2; ++s)
#pragma unroll
        for (int d0 = 0; d0 < 2; ++d0)
#pragma unroll
            for (int r = 0; r < 16; ++r) o[s][d0][r] = 0.f;
    D9_DMA(0, 0); D9_DMA(1, 1); D9_DMA(2, 2); D9_DMA(3, 3);
    if (FAST && tid == 0) *(volatile LAS int*)(lds + D9_FLAG) = 0;
    asm volatile("s_waitcnt vmcnt(4) lgkmcnt(0)" ::: "memory"); __builtin_amdgcn_s_barrier(); asm volatile("" ::: "memory");
    D9_DMA(4, 4);
    const int ksw = (r32 >> 1) & 7;
    const unsigned lds0 = (unsigned)(__UINTPTR_TYPE__)lds;
    const unsigned ka0 = lds0 + D9_KB + r32 * 128 + (((4 * mp + hi) ^ ksw) << 4), ka1 = lds0 + D9_KB + r32 * 128 + (((4 * mp + 2 + hi) ^ ksw) << 4);
    const unsigned va0 = lds0 + D9_VB + ((lane >> 4) & 1) * 32 + (lane & 3) * 8 + (4 * hi + ((lane & 15) >> 2)) * 64;
    f32x16 z;
#pragma unroll
    for (int r = 0; r < 16; ++r) z[r] = 0.f;
    f32x16 X[2][2];
#define D9_R128(dst, addr, OFF) do { if (D9_VAR & 8) asm volatile("" : "=v"(dst)); else asm volatile("ds_read_b128 %0, %1 offset:%c2" : "=&v"(dst) : "v"(addr), "i"(OFF) : "memory"); } while (0)
#define D9_QK(slot) do { const unsigned k0_ = ka0 + (slot) * 8192, k1_ = ka1 + (slot) * 8192; bf16x8 kf0, kf1, kf2, kf3; \
        D9_R128(kf0, k0_, 0); D9_R128(kf1, k0_, 4096); D9_R128(kf2, k1_, 0); D9_R128(kf3, k1_, 4096); \
        asm volatile("s_waitcnt lgkmcnt(0)" ::: "memory"); SB(); \
        _Pragma("unroll") for (int s = 0; s < 2; ++s) { X[s][0] = MFMA32(kf0, q[s][0], z); X[s][1] = MFMA32(kf1, q[s][0], z); } \
        _Pragma("unroll") for (int s = 0; s < 2; ++s) { X[s][0] = MFMA32(kf2, q[s][1], X[s][0]); X[s][1] = MFMA32(kf3, q[s][1], X[s][1]); } \
        asm volatile("s_nop 15\n\ts_nop 7" : "+v"(X[0][0]), "+v"(X[0][1]), "+v"(X[1][0]), "+v"(X[1][1])); } while (0)
    D9_QK(0);
    int sj = 0;
#if D5_PROF
    const unsigned long long t7_0 = __builtin_amdgcn_s_memtime(); unsigned long long t7a = 0, t7acc = 0;
#define D9_T0(seg) do { if (D5_PROF_SEL == (seg)) t7a = __builtin_amdgcn_s_memtime(); } while (0)
#define D9_T1(seg) do { if (D5_PROF_SEL == (seg)) t7acc += __builtin_amdgcn_s_memtime() - t7a; } while (0)
#else
#define D9_T0(seg) do {} while (0)
#define D9_T1(seg) do {} while (0)
#endif
#define D9_SOFTMAX(s) do { f32x16& X0 = X[s][0]; f32x16& X1 = X[s][1]; \
        if (!FAST) { \
            float ra = max3f(X0[0], X0[1], X0[2]), rb = max3f(X0[3], X0[4], X0[5]); \
            ra = max3f(ra, X0[6], X0[7]); rb = max3f(rb, X0[8], X0[9]); ra = max3f(ra, X0[10], X0[11]); rb = max3f(rb, X0[12], X0[13]); ra = max3f(ra, X0[14], X0[15]); \
            rb = max3f(rb, X1[0], X1[1]); ra = max3f(ra, X1[2], X1[3]); rb = max3f(rb, X1[4], X1[5]); ra = max3f(ra, X1[6], X1[7]); rb = max3f(rb, X1[8], X1[9]); \
            ra = max3f(ra, X1[10], X1[11]); rb = max3f(rb, X1[12], X1[13]); ra = max3f(ra, X1[14], X1[15]); \
            const float rm = swap_max(max2f(ra, rb)); \
            if (j == 0) mrun[s] = rm; \
            else if (__any(rm > mrun[s] + 6.0f)) { const float mn = max2f(mrun[s], rm), f = ex2(mrun[s] - mn); mrun[s] = mn; lrun[s] *= f; \
                _Pragma("unroll") for (int r = 0; r < 16; ++r) { o[s][0][r] *= f; o[s][1][r] *= f; } } \
            { const float mm = mrun[s]; _Pragma("unroll") for (int r = 0; r < 16; ++r) { X0[r] -= mm; X1[r] -= mm; } } \
        } \
        f32x2_t ps2; \
        _Pragma("unroll") for (int r = 0; r < 16; ++r) X0[r] = ex2(X0[r]); \
        ps2 = PSUM8(X0, 0) + PSUM8(X0, 8); \
        pw[0] = pack8(X0[0], X0[1], X0[2], X0[3], X0[4], X0[5], X0[6], X0[7]); pw[1] = pack8(X0[8], X0[9], X0[10], X0[11], X0[12], X0[13], X0[14], X0[15]); \
        asm volatile("" : "+v"(pw[0]), "+v"(pw[1]), "+v"(ps2)); SB(); \
        _Pragma("unroll") for (int r = 0; r < 16; ++r) X1[r] = ex2(X1[r]); \
        ps2 += PSUM8(X1, 0) + PSUM8(X1, 8); \
        lrun[s] += ps2.x + ps2.y; \
        pw[2] = pack8(X1[0], X1[1], X1[2], X1[3], X1[4], X1[5], X1[6], X1[7]); pw[3] = pack8(X1[8], X1[9], X1[10], X1[11], X1[12], X1[13], X1[14], X1[15]); \
        asm volatile("" : "+v"(pw[2]), "+v"(pw[3]), "+v"(lrun[s])); SB(); } while (0)
#define D9_TR(dst, OFF) asm volatile("ds_read_b64_tr_b16 %0, %1 offset:%c2" : "=&v"(dst) : "v"(va), "i"(OFF) : "memory")
#define D9_VO(ks, d0) ((d0) * 4096 + (ks) * 1024)
#define D9_LOADS() do { const unsigned va = va0 + sj * 8192, k0_ = ka0 + s1 * 8192, k1_ = ka1 + s1 * 8192; \
        D9_TR(a00l, D9_VO(0, 0)); D9_TR(a00h, D9_VO(0, 0) + 512); D9_TR(a01l, D9_VO(0, 1)); D9_TR(a01h, D9_VO(0, 1) + 512); \
        D9_TR(a10l, D9_VO(1, 0)); D9_TR(a10h, D9_VO(1, 0) + 512); D9_TR(a11l, D9_VO(1, 1)); D9_TR(a11h, D9_VO(1, 1) + 512); \
        D9_R128(kf0, k0_, 0); D9_R128(kf1, k0_, 4096); D9_R128(kf2, k1_, 0); D9_R128(kf3, k1_, 4096); \
        D9_TR(b00l, D9_VO(2, 0)); D9_TR(b00h, D9_VO(2, 0) + 512); D9_TR(b01l, D9_VO(2, 1)); D9_TR(b01h, D9_VO(2, 1) + 512); \
        D9_TR(b10l, D9_VO(3, 0)); D9_TR(b10h, D9_VO(3, 0) + 512); D9_TR(b11l, D9_VO(3, 1)); D9_TR(b11h, D9_VO(3, 1) + 512); \
        asm volatile("s_waitcnt lgkmcnt(0)" : "+v"(a00l), "+v"(a00h), "+v"(a01l), "+v"(a01h), "+v"(a10l), "+v"(a10h), "+v"(a11l), "+v"(a11h) :: "memory"); \
        asm volatile("" : "+v"(b00l), "+v"(b00h), "+v"(b01l), "+v"(b01h), "+v"(b10l), "+v"(b10h), "+v"(b11l), "+v"(b11h)); \
        asm volatile("" : "+v"(kf0), "+v"(kf1), "+v"(kf2), "+v"(kf3)); SB(); } while (0)
#define D9_BLOCK(s) do { \
        { const bf16x8 v00 = mk8(a00l, a00h), v01 = mk8(a01l, a01h), v10 = mk8(a10l, a10h), v11 = mk8(a11l, a11h); \
          o[s][0] = MFMA32(v00, pw[0], o[s][0]); o[s][1] = MFMA32(v01, pw[0], o[s][1]); X[s][0] = MFMA32(kf0, q[s][0], z); X[s][1] = MFMA32(kf1, q[s][0], z); \
          o[s][0] = MFMA32(v10, pw[1], o[s][0]); o[s][1] = MFMA32(v11, pw[1], o[s][1]); X[s][0] = MFMA32(kf2, q[s][1], X[s][0]); X[s][1] = MFMA32(kf3, q[s][1], X[s][1]); } \
        { const bf16x8 v20 = mk8(b00l, b00h), v21 = mk8(b01l, b01h), v30 = mk8(b10l, b10h), v31 = mk8(b11l, b11h); \
          o[s][0] = MFMA32(v20, pw[2], o[s][0]); o[s][1] = MFMA32(v21, pw[2], o[s][1]); o[s][0] = MFMA32(v30, pw[3], o[s][0]); o[s][1] = MFMA32(v31, pw[3], o[s][1]); } \
        asm volatile("" : "+v"(o[s][0]), "+v"(o[s][1]), "+v"(X[s][0]), "+v"(X[s][1])); SB(); } while (0)
#pragma unroll 1
    for (int j = 0; j < 132; ++j) {
        const int s1 = (sj == 5) ? 0 : sj + 1, sm1 = (sj == 0) ? 5 : sj - 1;
        bf16x8 pw[4];
        s16x4 a00l, a00h, a01l, a01h, a10l, a10h, a11l, a11h, b00l, b00h, b01l, b01h, b10l, b10h, b11l, b11h; bf16x8 kf0, kf1, kf2, kf3;
        D9_SOFTMAX(0);
        SB(); D9_LOADS(); D9_BLOCK(0); SB();
        if (late) D9_TILE_BAR(j + 1, sm1);
        SB();
        D9_SOFTMAX(1);
        SB(); D9_BLOCK(1); SB();
        if (!late) D9_TILE_BAR(j + 1, sm1);
        SB();
        sj = s1;
    }
#undef D9_SOFTMAX
#undef D9_BLOCK
#undef D9_LOADS
#undef D9_TR
#undef D9_VO
    asm volatile("s_waitcnt vmcnt(0)" ::: "memory");
    __syncthreads();
#undef D9_DMA
#undef D9_TILE_BAR
#undef D9_QK
#undef D9_R128
    const float lam = ((const float*)(F.ws + WS_LAM))[l]; const float omli = (l == 0) ? 0.8f : 0.64449093241f;
    const float l0 = swap_add(lrun[0]), l1 = swap_add(lrun[1]);
    const float il0 = 1.0f / l0, il1 = 1.0f / l1;
    if (FAST) { bool bad = !(l0 > 7.9e-31f && l0 < 1.3e33f) || !(l1 > 7.9e-31f && l1 < 1.3e33f);
#ifdef D9_FORCE_REDO
        bad = bad || ((blk & 7) == 3 && wid == 5);
#endif
        if (__any(bad) && lane == 0) *(volatile LAS int*)(lds + D9_FLAG) = 1; }
    LAS float* ex = (LAS float*)(lds + D9_EX) + (qg * 2 + mp) * 2048 + lane;
    { const int sg = 1 - mp; const float sc = (mp == 0) ? il1 : lam * il0;
#pragma unroll
      for (int d0 = 0; d0 < 2; ++d0)
#pragma unroll
          for (int r = 0; r < 16; ++r) ex[(d0 * 16 + r) * 64] = ((sg == 0) ? o[0][d0][r] : o[1][d0][r]) * sc; }
    __syncthreads();
    const bool redo = FAST && (*(volatile LAS int*)(lds + D9_FLAG) != 0);
    { const LAS float* exr = (const LAS float*)(lds + D9_EX) + (qg * 2 + (1 - mp)) * 2048 + lane;
      const int sk = mp;
      const float own = (mp == 0) ? il0 : lam * il1;
      float y[2][16]; float ss = 0.f;
#pragma unroll
      for (int d0 = 0; d0 < 2; ++d0)
#pragma unroll
          for (int r = 0; r < 16; ++r) { const float a = ((sk == 0) ? o[0][d0][r] : o[1][d0][r]) * own, pv = exr[(d0 * 16 + r) * 64];
              const float v = (mp == 0) ? a - pv : pv - a; y[d0][r] = v; ss += v * v; }
      ss = swap_add(ss);
      const float rs = omli / sqrtf(ss * (1.0f / 64.0f) + EPS); const float* sg = FIN(IN_SUBLN) + l * 64;
      const size_t ygrow = (size_t)b * SEQ + qtok0 + 32 * sk;
#pragma unroll
      for (int d0 = 0; d0 < 2; ++d0)
#pragma unroll
          for (int rg = 0; rg < 4; ++rg) { const int dv = 32 * d0 + 8 * rg + 4 * hi; const f32x4 g4 = *(const f32x4*)(sg + dv);
              u32x2 w; w.x = pk2(y[d0][4 * rg] * rs * g4.x, y[d0][4 * rg + 1] * rs * g4.y); w.y = pk2(y[d0][4 * rg + 2] * rs * g4.z, y[d0][4 * rg + 3] * rs * g4.w);
              *(u32x2*)(Y + ygrow * DM + 768 + h * 64 + dv) = w; } }
    __syncthreads();
    return redo;
}
constexpr int LRU_XB = 0, LRU_XB_PITCH = 528, LRU_XF = 34816, LRU_CW = 34816 + 65536;
template <bool FINAL> __device__ __forceinline__ void lru_unit(Frame& F, int l, int unit) {
    LAUNDER_IDS
#ifdef LRUPROF
    const unsigned long long tl0 = __builtin_amdgcn_s_memtime(); unsigned long long tl1 = 0, tl2 = 0;
#endif
    const int b = unit / 132, g = unit % 132; const bool isctx = g < 4;
    const int seqlen = isctx ? 256 : 8192, t0 = isctx ? 64 * g : 64 * (g - 4);
    const size_t prow0 = (size_t)b * NKEY + (isctx ? 0 : 256);
    const int gc0 = isctx ? 4 * g : 16 + 4 * (g - 4);
    const bf16* P = (const bf16*)(F.ws + WS_A); bf16* Y = (bf16*)(F.ws + WS_B);
    LAS unsigned char* lds = F.lds;
    LAS float* cwl = (LAS float*)(lds + LRU_CW);
    const int ct = tid >> 5, cg = tid & 31;
    v4u xin[4][4];
#pragma unroll
    for (int ci = 0; ci < 4; ++ci)
#pragma unroll
        for (int j = 0; j < 4; ++j) { const int tt = t0 + 16 * ci + ct + j - 1;
            xin[ci][j] = (tt >= 0 && tt < seqlen) ? *(const v4u*)(P + (prow0 + tt) * NIN + 768 + cg * 8) : (v4u){0u, 0u, 0u, 0u}; }
    for (int i = tid; i < 1280; i += 512) cwl[i] = (i < 1024) ? FIN(IN_CONVW)[l * 1024 + i] : FIN(IN_CONVB)[l * 256 + (i - 1024)];
    const int kblk = wid >> 1, dp = wid & 1, d16 = lane & 15, tg = lane >> 4;
    const bf16* WG = (const bf16*)(F.ws + WS_LRUW) + (size_t)l * 65536;
    bf16x8 bw[2][2][2][2];
    float spv[2][2], brv[2][2], biv[2][2];
#pragma unroll
    for (int dir = 0; dir < 2; ++dir)
#pragma unroll
        for (int dtl = 0; dtl < 2; ++dtl) { const int dcol = 16 * (2 * dp + dtl) + d16, ch = kblk * 64 + dcol;
#pragma unroll
            for (int gt = 0; gt < 2; ++gt)
#pragma unroll
                for (int s2 = 0; s2 < 2; ++s2) bw[dir][gt][dtl][s2] = *(const bf16x8*)(WG + ((size_t)((dir * 2 + gt) * 4 + kblk) * 64 + dcol) * 64 + 32 * s2 + 8 * tg);
            spv[dir][dtl] = ((const float*)(F.ws + WS_LAM + 4096))[(l * 2 + dir) * 256 + ch];
            brv[dir][dtl] = FIN(IN_GATEB)[((size_t)((l * 2 + dir) * 2 + 0) * 4 + kblk) * 64 + dcol];
            biv[dir][dtl] = FIN(IN_GATEB)[((size_t)((l * 2 + dir) * 2 + 1) * 4 + kblk) * 64 + dcol]; }
    unsigned short gcur[2][4], gnxt[2][4];
#define LRU_GLD(dst, cix) do { _Pragma("unroll") for (int dtl_ = 0; dtl_ < 2; ++dtl_) _Pragma("unroll") for (int r_ = 0; r_ < 4; ++r_) \
        dst[dtl_][r_] = *(const unsigned short*)(P + (prow0 + t0 + 16 * (cix) + 4 * tg + r_) * NIN + 1024 + kblk * 64 + 16 * (2 * dp + dtl_) + d16); } while (0)
    if (FINAL) LRU_GLD(gcur, 0);
    __syncthreads();
#ifdef LRUPROF
    tl1 = __builtin_amdgcn_s_memtime();
#endif
#pragma unroll
    for (int ci = 0; ci < 4; ++ci) { float acc8[8];
#pragma unroll
        for (int e = 0; e < 8; ++e) acc8[e] = cwl[1024 + cg * 8 + e];
#pragma unroll
        for (int j = 0; j < 4; ++j) { const v4u w = xin[ci][j]; const LAS float* cw = cwl + j * 256 + cg * 8;
            acc8[0] += cw[0] * bflo(w.x); acc8[1] += cw[1] * bfhi(w.x); acc8[2] += cw[2] * bflo(w.y); acc8[3] += cw[3] * bfhi(w.y);
            acc8[4] += cw[4] * bflo(w.z); acc8[5] += cw[5] * bfhi(w.z); acc8[6] += cw[6] * bflo(w.w); acc8[7] += cw[7] * bfhi(w.w); }
        const int row = 16 * ci + ct;
        v4u o; o.x = pk2(acc8[0], acc8[1]); o.y = pk2(acc8[2], acc8[3]); o.z = pk2(acc8[4], acc8[5]); o.w = pk2(acc8[6], acc8[7]);
        *(LAS v4u*)(lds + LRU_XB + row * LRU_XB_PITCH + cg * 16) = o;
        LAS float* xf = (LAS float*)(lds + LRU_XF) + row * 256 + cg * 8;
        *(LAS f32x4*)xf = (f32x4){acc8[0], acc8[1], acc8[2], acc8[3]}; *(LAS f32x4*)(xf + 4) = (f32x4){acc8[4], acc8[5], acc8[6], acc8[7]}; }
    __syncthreads();
#ifdef LRUPROF
    tl2 = __builtin_amdgcn_s_memtime();
#endif
    for (int ci = 0; ci < 4; ++ci) {
        const int tc = t0 + 16 * ci;
        if (FINAL) LRU_GLD(gnxt, min(ci + 1, 3));
        bf16x8 af[2];
#pragma unroll
        for (int s = 0; s < 2; ++s) af[s] = *(const LAS bf16x8*)(lds + LRU_XB + (16 * ci + d16) * LRU_XB_PITCH + (kblk * 64 + 32 * s + 8 * tg) * 2);
        const int gc = gc0 + ci;
        float hsum[2][4];
#pragma unroll
        for (int dtl = 0; dtl < 2; ++dtl)
#pragma unroll
            for (int r = 0; r < 4; ++r) hsum[dtl][r] = 0.f;
#pragma unroll
        for (int dir = 0; dir < 2; ++dir)
#pragma unroll
            for (int dtl = 0; dtl < 2; ++dtl) {
                const int ch = kblk * 64 + 16 * (2 * dp + dtl) + d16;
                f32x4 gr = (f32x4){0.f, 0.f, 0.f, 0.f}, gi = (f32x4){0.f, 0.f, 0.f, 0.f};
#pragma unroll
                for (int s = 0; s < 2; ++s) { gr = MFMA16(af[s], bw[dir][0][dtl][s], gr); gi = MFMA16(af[s], bw[dir][1][dtl][s], gi); }
                float a[4], u[4];
#pragma unroll
                for (int r = 0; r < 4; ++r) { const float rr = sigmoidf_(gr[r] + brv[dir][dtl]), ii = sigmoidf_(gi[r] + biv[dir][dtl]);
                    a[r] = ex2(rr * spv[dir][dtl]);
                    const float xv = ((const LAS float*)(lds + LRU_XF))[(16 * ci + 4 * tg + r) * 256 + ch];
                    u[r] = __builtin_amdgcn_sqrtf(1.0f - a[r] * a[r]) * (ii * xv); }
                float hl[4], pp[4];
                if (dir == 0) { pp[0] = a[0]; hl[0] = u[0];
#pragma unroll
                    for (int r = 1; r < 4; ++r) { pp[r] = a[r] * pp[r - 1]; hl[r] = a[r] * hl[r - 1] + u[r]; } }
                else { pp[3] = a[3]; hl[3] = u[3];
#pragma unroll
                    for (int r = 2; r >= 0; --r) { pp[r] = a[r] * pp[r + 1]; hl[r] = a[r] * hl[r + 1] + u[r]; } }
                const float Ag = (dir == 0) ? pp[3] : pp[0], Ug = (dir == 0) ? hl[3] : hl[0];
                float Aq[4], Uq[4];
#pragma unroll
                for (int q = 0; q < 4; ++q) { Aq[q] = __shfl(Ag, d16 + 16 * q); Uq[q] = __shfl(Ug, d16 + 16 * q); }
                if (!FINAL) {
                    float At = 1.f, Ut = 0.f;
                    if (dir == 0) {
#pragma unroll
                        for (int q = 0; q < 4; ++q) { Ut = Aq[q] * Ut + Uq[q]; At *= Aq[q]; } }
                    else {
#pragma unroll
                        for (int q = 3; q >= 0; --q) { Ut = Aq[q] * Ut + Uq[q]; At *= Aq[q]; } }
                    if (tg == 0) { f32x2_t v = {At, Ut}; *(f32x2_t*)((float*)(F.ws + WS_LSUM) + ((size_t)((b * 528 + gc) * 2 + dir) * 256 + ch) * 2) = v; }
                    float c0 = 0.f, Pp = 1.f;
                    if (dir == 0) {
#pragma unroll
                        for (int q = 0; q < 3; ++q) { c0 = (q < tg) ? Aq[q] * c0 + Uq[q] : c0; Pp = (q < tg) ? Pp * Aq[q] : Pp; } }
                    else {
#pragma unroll
                        for (int q = 3; q >= 1; --q) { c0 = (q > tg) ? Aq[q] * c0 + Uq[q] : c0; Pp = (q > tg) ? Pp * Aq[q] : Pp; } }
                    v4u w4; w4.x = pk2(hl[0] + pp[0] * c0, hl[1] + pp[1] * c0); w4.y = pk2(hl[2] + pp[2] * c0, hl[3] + pp[3] * c0);
                    w4.z = pk2(pp[0] * Pp, pp[1] * Pp); w4.w = pk2(pp[2] * Pp, pp[3] * Pp);
                    ((v4u*)F.out)[((((size_t)(unit * 4 + ci) * 2 + dir) * 8 + wid) * 2 + dtl) * 64 + lane] = w4;
                } else {
                    float c = ((const float*)(F.ws + WS_LCIN))[(size_t)((b * 528 + gc) * 2 + dir) * 256 + ch];
                    if (dir == 0) {
#pragma unroll
                        for (int q = 0; q < 3; ++q) c = (q < tg) ? Aq[q] * c + Uq[q] : c; }
                    else {
#pragma unroll
                        for (int q = 3; q >= 1; --q) c = (q > tg) ? Aq[q] * c + Uq[q] : c; }
#pragma unroll
                    for (int r = 0; r < 4; ++r) hsum[dtl][r] += hl[r] + pp[r] * c;
                }
            }
        if (FINAL) {
#pragma unroll
            for (int dtl = 0; dtl < 2; ++dtl) { const int ch = kblk * 64 + 16 * (2 * dp + dtl) + d16;
#pragma unroll
                for (int r = 0; r < 4; ++r) { const int t = tc + 4 * tg + r;
                    const float gv = __uint_as_float((unsigned)gcur[dtl][r] << 16);
                    const size_t grow = isctx ? (size_t)MLAT + b * 256 + t : (size_t)b * SEQ + t;
                    Y[grow * DM + 256 + ch] = (bf16)f2bf(hsum[dtl][r] * gelu_tanh(gv)); } }
#pragma unroll
            for (int dtl = 0; dtl < 2; ++dtl)
#pragma unroll
                for (int r = 0; r < 4; ++r) gcur[dtl][r] = gnxt[dtl][r];
        }
    }
#ifdef LRUPROF
    if (FINAL && blockIdx.x == 0 && wid == 0 && lane == 0) { unsigned long long* pr = (unsigned long long*)(F.ws + WS_CTL) + 8192; if (pr[7] == 0) { const unsigned long long te = __builtin_amdgcn_s_memtime();
        pr[0] = (LRUPROF == 0) ? tl1 - tl0 : (LRUPROF == 1) ? tl2 - tl1 : (LRUPROF == 2) ? te - tl2 : te - tl0; pr[7] = 1; } }
#endif
    __syncthreads();
}

#ifndef DBG_NOINTER
#define DBG_NOINTER 0
#endif
__device__ __forceinline__ float ret_lg2(const float* rd, int l, int dir, int h) { const float x = rd[(l * 2 + dir) * 4 + h]; return -log1pf(expf(-x)) * LOG2E; }
__device__ __forceinline__ int tr_off(int token, int ch  ) { return (ch >> 2) * 8192 + (token >> 3) * 512 + (token & 7) * 64 + (ch & 3) * 16; }
__device__ __forceinline__ void ret_m1_unit(Frame& F, int l, int unit) {
    LAUNDER_IDS
    const int r32 = lane & 31, hi = lane >> 5;
    const int hp = unit & 1, cc = (unit >> 1) % 66, b = unit / 132;
    const bf16* P = (const bf16*)(F.ws + WS_A); LAS unsigned char* lds = F.lds;
    const size_t prow0 = (size_t)b * NKEY + 128 * cc;
    { const int hs = tid >> 8, tt = tid & 255, h = 2 * hp + hs;
      const float lgf = ret_lg2(FIN(IN_RETDECAY), l, 0, h), lgb = ret_lg2(FIN(IN_RETDECAY), l, 1, h);
      LAS unsigned char* base = lds + hs * 49152;
#pragma unroll
      for (int i = 0; i < 4; ++i) { const int idx = tt + 256 * i, row = idx >> 3, ch = idx & 7;
          const bf16* src = P + (prow0 + row) * NIN + h * 64 + ch * 8;
          const v4u kk = *(const v4u*)(src + 6 * 256), vv = *(const v4u*)(src + 7 * 256);
          const int off = tr_off(row, ch);
          *(LAS v4u*)(base + off) = vv;
          const float df = ex2((float)(127 - row) * lgf), db = ex2((float)row * lgb);
          v4u kf, kb2;
          kf.x = pk2(bflo(kk.x) * df, bfhi(kk.x) * df); kf.y = pk2(bflo(kk.y) * df, bfhi(kk.y) * df); kf.z = pk2(bflo(kk.z) * df, bfhi(kk.z) * df); kf.w = pk2(bflo(kk.w) * df, bfhi(kk.w) * df);
          kb2.x = pk2(bflo(kk.x) * db, bfhi(kk.x) * db); kb2.y = pk2(bflo(kk.y) * db, bfhi(kk.y) * db); kb2.z = pk2(bflo(kk.z) * db, bfhi(kk.z) * db); kb2.w = pk2(bflo(kk.w) * db, bfhi(kk.w) * db);
          *(LAS v4u*)(base + 16384 + off) = kf; *(LAS v4u*)(base + 32768 + off) = kb2; } }
    __syncthreads();
    { const int hs = wid >> 2, h = 2 * hp + hs, et = (wid >> 1) & 1, dt = wid & 1;
      const LAS unsigned char* base = lds + hs * 49152;
      const int vb = ((lane >> 4) & 1) * 32 + (lane & 3) * 8 + (4 * hi + ((lane & 15) >> 2)) * 64;
      f32x16 accf, accb;
#pragma unroll
      for (int r = 0; r < 16; ++r) { accf[r] = 0.f; accb[r] = 0.f; }
#pragma unroll
      for (int ks = 0; ks < 8; ++ks) {
          const bf16x8 va = mk8(vtr(base + et * 8192 + ks * 1024 + vb), vtr(base + et * 8192 + ks * 1024 + 512 + vb));
          const bf16x8 kf = mk8(vtr(base + 16384 + dt * 8192 + ks * 1024 + vb), vtr(base + 16384 + dt * 8192 + ks * 1024 + 512 + vb));
          const bf16x8 kb2 = mk8(vtr(base + 32768 + dt * 8192 + ks * 1024 + vb), vtr(base + 32768 + dt * 8192 + ks * 1024 + 512 + vb));
          accf = MFMA32(va, kf, accf); accb = MFMA32(va, kb2, accb); }
      float* KV = (float*)(F.ws + WS_KVT) + (size_t)(((b * 4 + h) * 66 + cc) * 2) * 4096;
#pragma unroll
      for (int r = 0; r < 16; ++r) { const int e = 32 * et + crow(r, hi), d = 32 * dt + r32; KV[e * 64 + d] = accf[r]; KV[4096 + e * 64 + d] = accb[r]; } }
    __syncthreads();
#undef LRU_GLD
}
__device__ __forceinline__ void lru_final_unit(Frame& F, int l, int unit) {
    LAUNDER_IDS
    const int b = unit / 132, g = unit % 132; const bool isctx = g < 4;
    const int t0 = isctx ? 64 * g : 64 * (g - 4);
    const size_t prow0 = (size_t)b * NKEY + (isctx ? 0 : 256);
    const int gc0 = isctx ? 4 * g : 16 + 4 * (g - 4);
    const bf16* P = (const bf16*)(F.ws + WS_A); bf16* Y = (bf16*)(F.ws + WS_B);
    const int kblk = wid >> 1, dp = wid & 1, d16 = lane & 15, tg = lane >> 4;
    const v4u* HP = (const v4u*)F.out; const float* CIN = (const float*)(F.ws + WS_LCIN);
    v4u wv[4][2][2]; float cv[4][2][2]; unsigned short gq[4][2][4];
#pragma unroll
    for (int ci = 0; ci < 4; ++ci) {
#pragma unroll
        for (int dir = 0; dir < 2; ++dir)
#pragma unroll
            for (int dtl = 0; dtl < 2; ++dtl) { const int ch = kblk * 64 + 16 * (2 * dp + dtl) + d16;
                wv[ci][dir][dtl] = HP[((((size_t)(unit * 4 + ci) * 2 + dir) * 8 + wid) * 2 + dtl) * 64 + lane];
                cv[ci][dir][dtl] = CIN[(size_t)((b * 528 + gc0 + ci) * 2 + dir) * 256 + ch]; }
#pragma unroll
        for (int dtl = 0; dtl < 2; ++dtl)
#pragma unroll
            for (int r = 0; r < 4; ++r) gq[ci][dtl][r] = *(const unsigned short*)(P + (prow0 + t0 + 16 * ci + 4 * tg + r) * NIN + 1024 + kblk * 64 + 16 * (2 * dp + dtl) + d16);
    }
#pragma unroll
    for (int ci = 0; ci < 4; ++ci) {
#pragma unroll
        for (int dtl = 0; dtl < 2; ++dtl) { const int ch = kblk * 64 + 16 * (2 * dp + dtl) + d16;
            const v4u w0 = wv[ci][0][dtl], w1 = wv[ci][1][dtl];
            const f32x4 hf = bf4((u32x2){w0.x, w0.y}), pf = bf4((u32x2){w0.z, w0.w}), hb = bf4((u32x2){w1.x, w1.y}), pb = bf4((u32x2){w1.z, w1.w});
            const f32x4 h4 = (hf + pf * cv[ci][0][dtl]) + (hb + pb * cv[ci][1][dtl]);
#pragma unroll
            for (int r = 0; r < 4; ++r) { const int t = t0 + 16 * ci + 4 * tg + r;
                const float gv = __uint_as_float((unsigned)gq[ci][dtl][r] << 16);
                const size_t grow = isctx ? (size_t)MLAT + b * 256 + t : (size_t)b * SEQ + t;
                Y[grow * DM + 256 + ch] = (bf16)f2bf(h4[r] * gelu_tanh(gv)); } }
    }
}
__device__ __forceinline__ void ret_m3_unit(Frame& F, int l, int b, int cc, int hp_lo, int hp_hi) {
    LAUNDER_IDS
    const int r32 = lane & 31, hi = lane >> 5;
    const bf16* P = (const bf16*)(F.ws + WS_A); bf16* Y = (bf16*)(F.ws + WS_B); LAS unsigned char* lds = F.lds;
    const size_t prow0 = (size_t)b * NKEY + 128 * cc;
    { const int hs = tid >> 8, tt = tid & 255;
#pragma unroll
      for (int hp = 0; hp < 2; ++hp) if (hp >= hp_lo && hp < hp_hi) { const int h = 2 * hp + hs; LAS unsigned char* base = lds + h * 32768;
#pragma unroll
        for (int i = 0; i < 4; ++i) { const int idx = tt + 256 * i, row = idx >> 3, ch = idx & 7;
          const bf16* src = P + (prow0 + row) * NIN + h * 64 + ch * 8;
          const v4u kk = *(const v4u*)(src + 6 * 256), vv = *(const v4u*)(src + 7 * 256);
          *(LAS v4u*)(base + row * 128 + ((ch ^ ((row >> 1) & 7)) << 4)) = kk; *(LAS v4u*)(base + 16384 + tr_off(row, ch)) = vv; } } }
    const int hs = wid >> 2, qt = wid & 3;
    const int qi = 32 * qt + r32;
    __syncthreads();
    const int vb = ((lane >> 4) & 1) * 32 + (lane & 3) * 8 + (4 * hi + ((lane & 15) >> 2)) * 64;
#pragma unroll
    for (int hp = 0; hp < 2; ++hp) if (hp >= hp_lo && hp < hp_hi) {
    const int h = 2 * hp + hs;
    bf16x8 qr[4];
#pragma unroll
    for (int d0 = 0; d0 < 4; ++d0) qr[d0] = *(const bf16x8*)(P + (prow0 + qi) * NIN + 5 * 256 + h * 64 + d0 * 16 + hi * 8);
    const float lgf = ret_lg2(FIN(IN_RETDECAY), l, 0, h), lgb = ret_lg2(FIN(IN_RETDECAY), l, 1, h);
    const LAS unsigned char* base = lds + h * 32768;
    f32x16 o[2];
#pragma unroll
    for (int r = 0; r < 16; ++r) { o[0][r] = 0.f; o[1][r] = 0.f; }
#pragma unroll
    for (int kt = 0; kt < 4; ++kt) {
        f32x16 c;
#pragma unroll
        for (int r = 0; r < 16; ++r) c[r] = 0.f;
#pragma unroll
        for (int ds = 0; ds < 4; ++ds) { const int key = 32 * kt + r32, chunk = 2 * ds + hi;
            const bf16x8 kf = *(const LAS bf16x8*)(base + key * 128 + ((chunk ^ ((key >> 1) & 7)) << 4));
            c = MFMA32(kf, qr[ds], c); }
#pragma unroll
        for (int r = 0; r < 16; ++r) { const int kj = 32 * kt + crow(r, hi); const int dd = qi - kj;
            const float e = (dd >= 0) ? (float)dd * lgf : (float)(-dd - 1) * lgb; c[r] *= ex2(e); }
        const bf16x8 p0 = pack8(c[0], c[1], c[2], c[3], c[4], c[5], c[6], c[7]), p1 = pack8(c[8], c[9], c[10], c[11], c[12], c[13], c[14], c[15]);
#pragma unroll
        for (int et = 0; et < 2; ++et) {
            const bf16x8 v0 = mk8(vtr(base + 16384 + et * 8192 + (2 * kt) * 1024 + vb), vtr(base + 16384 + et * 8192 + (2 * kt) * 1024 + 512 + vb));
            const bf16x8 v1 = mk8(vtr(base + 16384 + et * 8192 + (2 * kt + 1) * 1024 + vb), vtr(base + 16384 + et * 8192 + (2 * kt + 1) * 1024 + 512 + vb));
            o[et] = MFMA32(v0, p0, o[et]); o[et] = MFMA32(v1, p1, o[et]); }
    }
    { const bf16* SI = (const bf16*)(F.ws + WS_SIN) + (size_t)(((b * 4 + h) * 66 + cc) * 2) * 4096;
      const float df = ex2((float)(qi + 1) * lgf), db = ex2((float)(127 - qi) * lgb);
#pragma unroll
      for (int et = 0; et < 2; ++et) { f32x16 xf, xb;
#pragma unroll
          for (int r = 0; r < 16; ++r) { xf[r] = 0.f; xb[r] = 0.f; }
#pragma unroll
          for (int ds = 0; ds < 4; ++ds) { const bf16x8 sf = *(const bf16x8*)(SI + (32 * et + r32) * 64 + 16 * ds + 8 * hi), sb = *(const bf16x8*)(SI + 4096 + (32 * et + r32) * 64 + 16 * ds + 8 * hi);
              xf = MFMA32(sf, qr[ds], xf); xb = MFMA32(sb, qr[ds], xb); }
#pragma unroll
          for (int r = 0; r < 16; ++r) o[et][r] += DBG_NOINTER ? 0.f : df * xf[r] + db * xb[r]; } }
    float ss = 0.f;
#pragma unroll
    for (int et = 0; et < 2; ++et)
#pragma unroll
        for (int r = 0; r < 16; ++r) ss += o[et][r] * o[et][r];
    ss = swap_add(ss);
    const float rs = 1.0f / sqrtf(ss * (1.0f / 64.0f) + EPS);
    const size_t prow = prow0 + qi;
    const size_t grow = (cc < 2) ? (size_t)MLAT + b * 256 + 128 * cc + qi : (size_t)b * SEQ + 128 * (cc - 2) + qi;
#pragma unroll
    for (int et = 0; et < 2; ++et)
#pragma unroll
        for (int rg = 0; rg < 4; ++rg) { const int e = 32 * et + 8 * rg + 4 * hi;
            const u32x2 gw = *(const u32x2*)(P + prow * NIN + 8 * 256 + h * 64 + e);
            const float g0 = bflo(gw.x), g1 = bfhi(gw.x), g2 = bflo(gw.y), g3 = bfhi(gw.y);
            u32x2 w; w.x = pk2(o[et][4 * rg] * rs * (g0 * sigmoidf_(g0)), o[et][4 * rg + 1] * rs * (g1 * sigmoidf_(g1)));
            w.y = pk2(o[et][4 * rg + 2] * rs * (g2 * sigmoidf_(g2)), o[et][4 * rg + 3] * rs * (g3 * sigmoidf_(g3)));
            *(u32x2*)(Y + grow * DM + 512 + h * 64 + e) = w; }
    }
    __syncthreads();
}
__device__ __forceinline__ void m2_phase(Frame& F, int l) {
    LAUNDER_IDS
    for (int item = blockIdx.x; item < 64; item += F.G) {
        const int seg = tid >> 5, ci = tid & 31, chain = item * 32 + ci, b = chain >> 9, dir = (chain >> 8) & 1, ch = chain & 255;
        const float* SUM = (const float*)(F.ws + WS_LSUM); float* CIN = (float*)(F.ws + WS_LCIN);
        LAS float* sA = (LAS float*)F.lds; LAS float* sU = sA + 512;
        float A[33], U[33];
#pragma unroll
        for (int i = 0; i < 33; ++i) { const int pos = seg * 33 + i; const int gc = (dir == 0) ? pos : ((pos < 16) ? 15 - pos : 543 - pos);
            const f32x2_t v = *(const f32x2_t*)(SUM + ((size_t)((b * 528 + gc) * 2 + dir) * 256 + ch) * 2); A[i] = v.x; U[i] = v.y; }
        float As = 1.f, Us = 0.f;
#pragma unroll
        for (int i = 0; i < 33; ++i) { Us = A[i] * Us + U[i]; As *= A[i]; }
        sA[seg * 32 + ci] = As; sU[seg * 32 + ci] = Us;
        __syncthreads();
        float c = 0.f;
        for (int s = 0; s < 15; ++s) { const float a2 = sA[s * 32 + ci], u2 = sU[s * 32 + ci]; c = (s < seg) ? a2 * c + u2 : c; }
#pragma unroll
        for (int i = 0; i < 33; ++i) { const int pos = seg * 33 + i; const int gc = (dir == 0) ? pos : ((pos < 16) ? 15 - pos : 543 - pos);
            CIN[(size_t)((b * 528 + gc) * 2 + dir) * 256 + ch] = c; c = A[i] * c + U[i]; }
        __syncthreads();
    }
    for (int idx = F.vcu * 512 + tid; idx < 131072; idx += F.G * 512) {
        const int chain = idx >> 12, el = idx & 4095, bh = chain >> 1, dir = chain & 1, h = bh & 3;
        const float c128 = ex2(128.0f * ret_lg2(FIN(IN_RETDECAY), l, dir, h));
        const float* KV = (const float*)(F.ws + WS_KVT) + (size_t)bh * 66 * 2 * 4096 + dir * 4096 + el;
        bf16* SI = (bf16*)(F.ws + WS_SIN) + (size_t)bh * 66 * 2 * 4096 + dir * 4096 + el;
        float S = 0.f;
        for (int p0 = 0; p0 < 66; p0 += 33) { float kv[33];
#pragma unroll
            for (int i = 0; i < 33; ++i) { const int pos = p0 + i; const int cc = (dir == 0) ? pos : ((pos < 2) ? 1 - pos : 67 - pos); kv[i] = KV[(size_t)cc * 8192]; }
#pragma unroll
            for (int i = 0; i < 33; ++i) { const int pos = p0 + i; const int cc = (dir == 0) ? pos : ((pos < 2) ? 1 - pos : 67 - pos); SI[(size_t)cc * 8192] = (bf16)f2bf(S); S = c128 * S + kv[i]; } }
    }
}
constexpr size_t WS_DBG = 452 * MiB;
#ifndef DBG_PROBE
#define DBG_PROBE 0
#endif
#ifndef DBG_NOINTER
#define DBG_NOINTER 0
#endif
#ifndef DBG_LAYER
#define DBG_LAYER -1
#endif
constexpr int CW_DBG = 12288;
#ifndef NAIVE_RET
#define NAIVE_RET 0
#endif
#ifndef NAIVE_LRU
#define NAIVE_LRU 0
#endif
__device__ __forceinline__ void chain_tok(int b, int dir, int pos, size_t& prow, size_t& grow) {
    int isctx = pos < 256, t = isctx ? pos : pos - 256;
    if (dir == 1) t = isctx ? 255 - t : 8191 - t;
    prow = (size_t)b * NKEY + (isctx ? 0 : 256) + t; grow = isctx ? (size_t)MLAT + b * 256 + t : (size_t)b * SEQ + t;
}
__device__ __forceinline__ void naive_ret(Frame& F, int l) {
    LAUNDER_IDS
    const bf16* P = (const bf16*)(F.ws + WS_A); bf16* Y = (bf16*)(F.ws + WS_B); float* T = (float*)(F.ws + WS_DBG);
    LAS float* red = (LAS float*)F.lds;
    for (int item = blockIdx.x; item < 32; item += F.G) {
        const int dir = item & 1, h = (item >> 1) & 3, b = item >> 3, e = tid & 63, dg = tid >> 6;
        const float gam = ex2(ret_lg2(FIN(IN_RETDECAY), l, dir, h));
        float S[8];
#pragma unroll
        for (int i = 0; i < 8; ++i) S[i] = 0.f;
        for (int pos = 0; pos < 8448; ++pos) {
            size_t prow, grow; chain_tok(b, dir, pos, prow, grow);
#if DBG_PROBE == 1
            if ((pos & 127) == 0 && (DBG_LAYER < 0 || l == DBG_LAYER)) { const int cc = (dir == 0) ? (pos >> 7) : ((pos < 256) ? 1 - (pos >> 7) : 65 - ((pos - 256) >> 7));
                const bf16* SI = (const bf16*)(F.ws + WS_SIN) + (size_t)((((b * 4 + h) * 66 + cc) * 2) + dir) * 4096;
                float md = 0.f, ms = 0.f;
#pragma unroll
                for (int i = 0; i < 8; ++i) { const float sv = bf2f(SI[e * 64 + dg * 8 + i]); md = fmaxf(md, fabsf(sv - S[i])); ms = fmaxf(ms, fabsf(S[i])); }
                atomicMax((unsigned*)(F.ws + WS_CTL) + CW_DBG, __float_as_uint(md)); atomicMax((unsigned*)(F.ws + WS_CTL) + CW_DBG + 1, __float_as_uint(ms)); }
#endif
#if DBG_NOINTER
            if ((pos & 127) == 0) {
#pragma unroll
                for (int i = 0; i < 8; ++i) S[i] = 0.f; }
#endif
            const bf16* pr = P + prow * NIN + h * 64;
            const v4u qw = *(const v4u*)(pr + 5 * 256 + dg * 8), kw = *(const v4u*)(pr + 6 * 256 + dg * 8);
            const float v = bf2f(pr[7 * 256 + e]);
            const float q[8] = {bflo(qw.x), bfhi(qw.x), bflo(qw.y), bfhi(qw.y), bflo(qw.z), bfhi(qw.z), bflo(qw.w), bfhi(qw.w)};
            const float k[8] = {bflo(kw.x), bfhi(kw.x), bflo(kw.y), bfhi(kw.y), bflo(kw.z), bfhi(kw.z), bflo(kw.w), bfhi(kw.w)};
            float part = 0.f;
            if (dir == 0) {
#pragma unroll
                for (int i = 0; i < 8; ++i) { S[i] = gam * S[i] + k[i] * v; part += q[i] * S[i]; } }
            else {
#pragma unroll
                for (int i = 0; i < 8; ++i) { part += q[i] * S[i]; S[i] = gam * S[i] + k[i] * v; } }
            red[dg * 64 + e] = part;
            __syncthreads();
            if (dg == 0) { float o = 0.f;
#pragma unroll
                for (int i = 0; i < 8; ++i) o += red[i * 64 + e];
                T[((size_t)dir * MALL + grow) * 256 + h * 64 + e] = o; }
            __syncthreads();
        }
    }
}
__device__ __forceinline__ void naive_ret_combine(Frame& F, int l) {
    LAUNDER_IDS
    const bf16* P = (const bf16*)(F.ws + WS_A); bf16* Y = (bf16*)(F.ws + WS_B); const float* T = (const float*)(F.ws + WS_DBG);
    const int gw = F.vcu * NWAVES + wid, NGW = F.G * NWAVES;
    for (int it = gw; it < MALL * 4; it += NGW) {
        const int grow = it >> 2, h = it & 3;
        if (l == 1 && grow >= MLAT) continue;
        const size_t prow = (grow < MLAT) ? (size_t)(grow >> 13) * NKEY + 256 + (grow & 8191) : (size_t)((grow - MLAT) >> 8) * NKEY + ((grow - MLAT) & 255);
        const float o = T[(size_t)grow * 256 + h * 64 + lane] + T[((size_t)MALL + grow) * 256 + h * 64 + lane];
        const float ss = wave_sum(o * o); const float rs = 1.0f / sqrtf(ss * (1.0f / 64.0f) + EPS);
        const float g = bf2f(P[prow * NIN + 8 * 256 + h * 64 + lane]);
#if DBG_PROBE == 2
        if (DBG_LAYER < 0 || l == DBG_LAYER) { const float mine = bf2f(Y[(size_t)grow * DM + 512 + h * 64 + lane]), ref = o * rs * (g * sigmoidf_(g));
            atomicMax((unsigned*)(F.ws + WS_CTL) + CW_DBG, __float_as_uint(fabsf(mine - ref))); atomicMax((unsigned*)(F.ws + WS_CTL) + CW_DBG + 1, __float_as_uint(fabsf(ref))); }
#else
        Y[(size_t)grow * DM + 512 + h * 64 + lane] = (bf16)f2bf(o * rs * (g * sigmoidf_(g)));
#endif
    }
}
__device__ __forceinline__ void naive_lru(Frame& F, int l) {
    LAUNDER_IDS
    const bf16* P = (const bf16*)(F.ws + WS_A); float* T = (float*)(F.ws + WS_DBG);
    LAS float* xs = (LAS float*)F.lds;
    for (int item = blockIdx.x; item < 16; item += F.G) {
        const int b = item >> 2, k = item & 3, dir = (tid >> 6) & 1, d = tid & 63, ch = k * 64 + d; const bool on = tid < 128;
        const float* cw = FIN(IN_CONVW) + l * 1024; const float cb = FIN(IN_CONVB)[l * 256 + ch];
        const float* wr_ = FIN(IN_GATEW) + ((size_t)((l * 2 + dir) * 2 + 0) * 4 + k) * 4096;
        const float* wi_ = FIN(IN_GATEW) + ((size_t)((l * 2 + dir) * 2 + 1) * 4 + k) * 4096;
        const float br = FIN(IN_GATEB)[((size_t)((l * 2 + dir) * 2 + 0) * 4 + k) * 64 + d], bi = FIN(IN_GATEB)[((size_t)((l * 2 + dir) * 2 + 1) * 4 + k) * 64 + d];
        const float sp = log1pf(expf(-FIN(IN_LRULAM)[(l * 2 + dir) * 256 + ch]));
        float hst = 0.f;
        for (int pos = 0; pos < 8448; ++pos) {
            size_t prow, grow; chain_tok(b, dir, pos, prow, grow);
            const int isctx = pos < 256; int t = isctx ? pos : pos - 256; if (dir == 1) t = isctx ? 255 - t : 8191 - t;
            const int seqlen = isctx ? 256 : 8192;
            float xb = cb;
#pragma unroll
            for (int j = 0; j < 4; ++j) { const int tt = t + j - 1; if (tt >= 0 && tt < seqlen) xb += cw[j * 256 + ch] * bf2f(P[(prow + (tt - t)) * NIN + 768 + ch]); }
            if (on) xs[dir * 64 + d] = xb;
            __syncthreads();
            if (on) { float pr_ = br, pi_ = bi;
                for (int c = 0; c < 64; ++c) { const float xv = xs[dir * 64 + c]; pr_ += xv * wr_[c * 64 + d]; pi_ += xv * wi_[c * 64 + d]; }
                const float r = 1.0f / (1.0f + expf(-pr_)), ii = 1.0f / (1.0f + expf(-pi_));
                const float la = -8.0f * r * sp, a = expf(la), u = sqrtf(-expm1f(2.0f * la)) * (ii * xb);
                hst = a * hst + u;
                T[((size_t)dir * MALL + grow) * 256 + ch] = hst; }
            __syncthreads();
        }
    }
}
__device__ __forceinline__ void naive_lru_combine(Frame& F, int l) {
    LAUNDER_IDS
    const bf16* P = (const bf16*)(F.ws + WS_A); bf16* Y = (bf16*)(F.ws + WS_B); const float* T = (const float*)(F.ws + WS_DBG);
    const int gw = F.vcu * NWAVES + wid, NGW = F.G * NWAVES;
    for (int it = gw; it < MALL * 4; it += NGW) {
        const int grow = it >> 2, k = it & 3, ch = k * 64 + lane;
        if (l == 1 && grow >= MLAT) continue;
        const size_t prow = (grow < MLAT) ? (size_t)(grow >> 13) * NKEY + 256 + (grow & 8191) : (size_t)((grow - MLAT) >> 8) * NKEY + ((grow - MLAT) & 255);
        const float hsum = T[(size_t)grow * 256 + ch] + T[((size_t)MALL + grow) * 256 + ch];
        const float g = bf2f(P[prow * NIN + 1024 + ch]);
        const float z = 0.7978845608028654f * (g + 0.044715f * g * g * g);
        Y[(size_t)grow * DM + 256 + ch] = (bf16)f2bf(hsum * 0.5f * g * (1.0f + tanhf(z)));
    }
}
struct Args { const float* in[23]; float* out; unsigned char* ws; int ph_lo, ph_hi; };
__device__ __forceinline__ int fetch_item(Frame& F, unsigned* ctr) {
    volatile LAS int* slot = (volatile LAS int*)(F.lds + MISC_OFF + 64);
    __syncthreads();
    if (F.tid == 0) *slot = (int)__hip_atomic_fetch_add(ctr, 1u, __ATOMIC_RELAXED, __HIP_MEMORY_SCOPE_AGENT);
    __syncthreads();
    return *slot;
}
__device__ __forceinline__ void group_barrier(Frame& F, unsigned* cnt, unsigned n) {
    VM_WAIT(); __syncthreads();
    if (F.tid == 0) { __builtin_amdgcn_fence(__ATOMIC_RELEASE, "agent"); VM_WAIT();
        (void)__hip_atomic_fetch_add(cnt, 1u, __ATOMIC_RELAXED, __HIP_MEMORY_SCOPE_AGENT);
        unsigned sp = 0; while (__hip_atomic_load(cnt, __ATOMIC_RELAXED, __HIP_MEMORY_SCOPE_AGENT) < n) { __builtin_amdgcn_s_sleep(2); if (++sp > (1u << 22)) break; }
        __builtin_amdgcn_fence(__ATOMIC_ACQUIRE, "agent"); VM_WAIT(); }
    __syncthreads();
}
struct OneUnitOrder {
    int pm, pn;
    __device__ bool next(int i, pg8::Unit& u) const { if (i != 0) return false; u.pm = pm; u.pn = pn; return true; }
    __device__ __forceinline__ void a_ready(const pg8::Unit&) const {}
    __device__ __forceinline__ void done(const pg8::Unit&) const {}
};
constexpr int NCTXW = 16;
__global__ void __launch_bounds__(NWAVES * 64, 2) hybrid_fwd(Args args) {
    extern __shared__ __attribute__((aligned(16))) unsigned char lds_raw[];
    Frame F;
    F.lds = (LAS unsigned char*)lds_raw;
    F.tid = threadIdx.x; F.lane = F.tid & 63; F.wave = __builtin_amdgcn_readfirstlane(F.tid >> 6);
    F.G = gridDim.x; { const int bx = blockIdx.x; F.vcu = (F.G % 8 == 0) ? (bx % 8) * (F.G / 8) + bx / 8 : bx; }
    F.kin = (const float* const __attribute__((address_space(4)))*)__builtin_amdgcn_kernarg_segment_ptr();
    F.out = args.out; F.ws = args.ws;
    unsigned* ctl = (unsigned*)(F.ws + WS_CTL);
    for (int u = F.tid; u < (LDS_BYTES - LDSCTL_OFF) / 4; u += NWAVES * 64) ((LAS unsigned*)(F.lds + LDSCTL_OFF))[u] = 0u;
    __syncthreads();
    XcdBarrier bar = xcd_barrier_post(ctl + CW_BAR, (volatile LAS unsigned*)(F.lds + MISC_OFF) + 8);
    const int lo = args.ph_lo, hi = args.ph_hi; int ph = 0;
#ifdef KCLK
    const unsigned long long kclk0 = __builtin_amdgcn_s_memtime();
#endif
#ifdef KFREQ
    const unsigned long long kfc0 = __builtin_amdgcn_s_memtime(), kfr0 = __builtin_amdgcn_s_memrealtime();
#endif
#ifdef BARBENCH
    {
        xcd_barrier(bar);
        const unsigned long long tb0 = __builtin_amdgcn_s_memrealtime();
        for (int i = 0; i < 16; ++i) xcd_barrier(bar);
        const unsigned long long tb1 = __builtin_amdgcn_s_memrealtime();
        if (blockIdx.x == 0 && F.tid == 0) F.out[0] = 1.0e4f * rintf((float)(tb1 - tb0) * (1.0f / 16.0f) * 0.01f * 4.0f) * 0.25f;
        return;
    }
#endif
#ifdef UBENCH
    {
        float a0 = F.tid * 1e-3f, a1 = a0 + 1.f, a2 = a0 + 2.f, a3 = a0 + 3.f, a4 = a0 + 4.f, a5 = a0 + 5.f, a6 = a0 + 6.f, a7 = a0 + 7.f;
        f32x16 c0, c1, c2, c3;
#pragma unroll
        for (int r = 0; r < 16; ++r) { c0[r] = a0; c1[r] = a1; c2[r] = a2; c3[r] = a3; }
        bf16x8 fa, fb;
#pragma unroll
        for (int r = 0; r < 8; ++r) { fa[r] = (short)(0x3c00 + F.lane); fb[r] = (short)(0x3c10 + F.lane); }
        const int role = (F.wave == 0) ? UB_R0 : (F.wave == 4) ? UB_R4 : (F.wave == 1) ? UB_R1 : 0;
        __syncthreads();
        unsigned long long t0 = 0, t1 = 0, best = ~0ull; int ninst = 1;
#define UB8(INS) INS(0) INS(1) INS(2) INS(3) INS(4) INS(5) INS(6) INS(7)
#define UB_EXP(i) "v_exp_f32 %" #i ", %" #i "\n\t"
#define UB_MAX(i) "v_max3_f32 %" #i ", %" #i ", %" #i ", %" #i "\n\t"
#define UB_CVT(i) "v_cvt_pk_bf16_f32 %" #i ", %" #i ", %" #i "\n\t"
#define UB_ADD(i) "v_add_f32 %" #i ", %" #i ", %" #i "\n\t"
#define UB_FMA(i) "v_fma_f32 %" #i ", %" #i ", %" #i ", %" #i "\n\t"
#define UB_RUN(INS) for (int it = 0; it < 16; ++it) asm volatile(UB8(INS) UB8(INS) UB8(INS) UB8(INS) : "+v"(a0), "+v"(a1), "+v"(a2), "+v"(a3), "+v"(a4), "+v"(a5), "+v"(a6), "+v"(a7))
        for (int rep = 0; rep < 8; ++rep) {
        __syncthreads();
        if (role == 1) { t0 = __builtin_amdgcn_s_memtime(); UB_RUN(UB_EXP); t1 = __builtin_amdgcn_s_memtime(); ninst = 512; }
        else if (role == 2) { t0 = __builtin_amdgcn_s_memtime(); UB_RUN(UB_MAX); t1 = __builtin_amdgcn_s_memtime(); ninst = 512; }
        else if (role == 4) { t0 = __builtin_amdgcn_s_memtime(); UB_RUN(UB_CVT); t1 = __builtin_amdgcn_s_memtime(); ninst = 512; }
        else if (role == 6) { t0 = __builtin_amdgcn_s_memtime(); UB_RUN(UB_ADD); t1 = __builtin_amdgcn_s_memtime(); ninst = 512; }
        else if (role == 7) { t0 = __builtin_amdgcn_s_memtime(); UB_RUN(UB_FMA); t1 = __builtin_amdgcn_s_memtime(); ninst = 512; }
        else if (role == 5) { f32x2_t p0 = {a0, a1}, p1 = {a2, a3}, p2 = {a4, a5}, p3 = {a6, a7};
            t0 = __builtin_amdgcn_s_memtime();
            for (int it = 0; it < 16; ++it) asm volatile("v_pk_add_f32 %0, %0, %0\n\tv_pk_add_f32 %1, %1, %1\n\tv_pk_add_f32 %2, %2, %2\n\tv_pk_add_f32 %3, %3, %3\n\tv_pk_add_f32 %0, %0, %0\n\tv_pk_add_f32 %1, %1, %1\n\tv_pk_add_f32 %2, %2, %2\n\tv_pk_add_f32 %3, %3, %3\n\t"
                                                         "v_pk_add_f32 %0, %0, %0\n\tv_pk_add_f32 %1, %1, %1\n\tv_pk_add_f32 %2, %2, %2\n\tv_pk_add_f32 %3, %3, %3\n\tv_pk_add_f32 %0, %0, %0\n\tv_pk_add_f32 %1, %1, %1\n\tv_pk_add_f32 %2, %2, %2\n\tv_pk_add_f32 %3, %3, %3\n\t"
                                                         : "+v"(p0), "+v"(p1), "+v"(p2), "+v"(p3));
            t1 = __builtin_amdgcn_s_memtime(); ninst = 256; a0 = p0.x + p1.y + p2.x + p3.y; }
        else if (role == 3) { t0 = __builtin_amdgcn_s_memtime();
            for (int it = 0; it < 16; ++it) asm volatile("v_mfma_f32_32x32x16_bf16 %0, %4, %5, %0\n\tv_mfma_f32_32x32x16_bf16 %1, %4, %5, %1\n\tv_mfma_f32_32x32x16_bf16 %2, %4, %5, %2\n\tv_mfma_f32_32x32x16_bf16 %3, %4, %5, %3\n\t"
                                                         "v_mfma_f32_32x32x16_bf16 %0, %4, %5, %0\n\tv_mfma_f32_32x32x16_bf16 %1, %4, %5, %1\n\tv_mfma_f32_32x32x16_bf16 %2, %4, %5, %2\n\tv_mfma_f32_32x32x16_bf16 %3, %4, %5, %3\n\t"
                                                         : "+v"(c0), "+v"(c1), "+v"(c2), "+v"(c3) : "v"(fa), "v"(fb));
            asm volatile("s_nop 15\n\ts_nop 15" : "+v"(c0), "+v"(c1), "+v"(c2), "+v"(c3));
            t1 = __builtin_amdgcn_s_memtime(); ninst = 128; }
        if (t1 - t0 < best) best = t1 - t0;
        }
        __syncthreads();
        float keep = a0 + a1 + a2 + a3 + a4 + a5 + a6 + a7 + c0[0] + c1[1] + c2[2] + c3[3];
        if (keep == 12345.6789f) F.out[1] = keep;
        if (blockIdx.x == 0 && F.wave == UB_REP && F.lane == 0) F.out[0] = rintf((float)best / (float)ninst * 2.0f) * 0.5f * 1.0e4f;
        return;
    }
#endif
#ifndef D7A
#define D7A true
#define D7B 1
#endif
#ifndef DIFF_IMPL
#define DIFF_IMPL 7
#endif
#ifndef UMASK
#define UMASK 0xFF
#endif
#ifndef PHMASK
#define PHMASK 0xFFFF
#endif
#ifndef REPEAT_MASK
#define REPEAT_MASK 0
#endif
#ifndef REPEAT_UMASK
#define REPEAT_UMASK 0xFF
#endif
#define PHASE_BEGIN(kind) if ((((PHMASK) >> (kind)) & 1) && ph >= lo && ph < hi) { for (int rep_ = 0; rep_ <= (((REPEAT_MASK) >> (kind)) & 1); ++rep_) { if (rep_) xcd_barrier(bar);
#ifdef PHPROF
#define PH_STAMP(i) do { if (blockIdx.x == 0 && F.tid == 0) ((unsigned long long*)(F.ws + WS_CTL))[8300 + (i)] = __builtin_amdgcn_s_memrealtime(); } while (0)
#else
#define PH_STAMP(i) do {} while (0)
#endif
#define PHASE_END(last) } if (!(last) && ph + 1 < hi) xcd_barrier(bar); } ++ph; PH_STAMP(ph);

    PH_STAMP(0);
    PHASE_BEGIN(0) p0a(F); PHASE_END(false)
    PHASE_BEGIN(1) p0b(F); PHASE_END(false)
    for (int l = 0; l < 2; ++l) {
        const int M = (l == 0) ? MALL : MLAT;
        PHASE_BEGIN(2) {
            pg8::Gemm g{(const pg8::bf16_t*)(F.ws + WS_B), (const pg8::bf16_t*)(F.ws + WS_WIN + l * SZ_WIN), MALL, NIN, DM}; pg8::StaticOrder S; S.init(MALL, NIN, F.G, (int)blockIdx.x);
            const float* tab = (const float*)(F.ws + WS_TAB);
            pg8::EpiInProj E{(pg8::bf16_t*)(F.ws + WS_A), tab, tab + 2048, tab + 4096, tab + 5120};
            pg8::gemm_phase<pg8::EpiInProj, pg8::StaticOrder, true, true>(F.lds, g, S, E);
        } PHASE_END(false)
        PHASE_BEGIN(3) {
            unsigned* ctr = ctl + CW_Q + 64 * l + 16 * rep_;
            const int n_diff = 512, n_na = 512, n_ret = 528, n_lru = 528, n_cx = (l == 0) ? 32 : 0;
            const int total = n_diff + n_na + n_ret + n_lru + n_cx;
            for (;;) {
                int it = fetch_item(F, ctr);
                if (it >= total) break;
#ifdef REPEAT_M1_LO
                if (rep_ && (it < REPEAT_M1_LO || it >= REPEAT_M1_HI)) continue;
#endif
                if (it < n_diff) { if (UMASK & 1) { if (rep_ && DIFF_VAR) diff_unit<DIFF_VAR>(F, l, it >> 7, (it >> 5) & 3, it & 31); else { if (DIFF_IMPL == 9) { if (diff9_unit<D7A>(F, l, it >> 7, (it >> 5) & 3, it & 31)) { if (D7B) diff9_unit<false>(F, l, it >> 7, (it >> 5) & 3, it & 31); } } else if (DIFF_IMPL == 8) { if (diff8_unit<D7A>(F, l, it >> 7, (it >> 5) & 3, it & 31)) { if (D7B) diff8_unit<false>(F, l, it >> 7, (it >> 5) & 3, it & 31); } } else if (DIFF_IMPL == 7) { if (diff7_unit<D7A>(F, l, it >> 7, (it >> 5) & 3, it & 31)) { if (D7B) diff7_unit<false>(F, l, it >> 7, (it >> 5) & 3, it & 31); } } else if (DIFF_IMPL == 6) diff6_unit(F, l, it >> 7, (it >> 5) & 3, it & 31); else if (DIFF_IMPL == 5) diff5_unit(F, l, it >> 7, (it >> 5) & 3, it & 31); else if (DIFF_IMPL == 3) diff3_unit(F, l, it >> 7, (it >> 5) & 3, it & 31); else diff_unit<0>(F, l, it >> 7, (it >> 5) & 3, it & 31); } } continue; } it -= n_diff;
                if (it < n_na) { if (UMASK & 2) attn_unit<1>(F, l, it >> 7, (it >> 5) & 3, it & 31); continue; } it -= n_na;
                if (it < n_lru) { if (UMASK & 8) lru_unit<false>(F, l, it); continue; } it -= n_lru;
                if (it < n_cx) { if (it < 16) { if (UMASK & 16) attn_unit_s<2>(F, l, it >> 2, it & 3, 0); } else { if (UMASK & 32) attn_unit<3>(F, l, (it - 16) >> 2, it & 3, 0); } continue; } it -= n_cx;
                if (UMASK & 4) ret_m1_unit(F, l, it);
            }
        } PHASE_END(false)
        PHASE_BEGIN(4) m2_phase(F, l); PHASE_END(false)
        PHASE_BEGIN(5) {
            unsigned* ctr3 = ctl + CW_Q + 64 * l + 32 + 8 * rep_;
            for (;;) {
                const int it = fetch_item(F, ctr3);
                if (it >= 528 + 256 + 16) break;
                if (it >= 528) { const int u = it - 528;
                    if ((!NAIVE_RET || DBG_PROBE == 2) && (UMASK & 64) && (!rep_ || (REPEAT_UMASK & 64))) {
                        if (u < 256) ret_m3_unit(F, l, u >> 6, 2 + (u & 63), 0, 2);
                        else if (l == 0) { const int v = u - 256; ret_m3_unit(F, l, v >> 2, (v >> 1) & 1, v & 1, (v & 1) + 1); } } }
                else { const int u = it; if (!NAIVE_LRU && (UMASK & 128) && (!rep_ || (REPEAT_UMASK & 128)) && (l == 0 || (u % 132) >= 4)) lru_final_unit(F, l, u); }
            }
#if NAIVE_RET
            naive_ret(F, l); xcd_barrier(bar); naive_ret_combine(F, l);
#endif
#if NAIVE_LRU
            xcd_barrier(bar); naive_lru(F, l); xcd_barrier(bar); naive_lru_combine(F, l);
#endif
        } PHASE_END(false)
        PHASE_BEGIN(6) {
            pg8::Gemm g{(const pg8::bf16_t*)(F.ws + WS_B), (const pg8::bf16_t*)(F.ws + WS_WOUT + l * SZ_WOUT), MLAT, DM, DM}; pg8::StaticOrder S; S.init(MLAT, DM, F.G, (int)blockIdx.x);
            pg8::EpiPlain E{(pg8::bf16_t*)(F.ws + WS_A), DM};
            pg8::gemm_phase<pg8::EpiPlain, pg8::StaticOrder, true, true>(F.lds, g, S, E);
        } PHASE_END(false)
        PHASE_BEGIN(7) {
            if (l == 0 && F.G > 2 * NCTXW) {
                if ((int)blockIdx.x < NCTXW) {
                    pg8::Gemm g{(const pg8::bf16_t*)(F.ws + WS_B), (const pg8::bf16_t*)(F.ws + WS_WOUT), MALL, DM, DM}; OneUnitOrder S{128 + ((int)blockIdx.x >> 2), (int)blockIdx.x & 3};
                    pg8::EpiPlain E{(pg8::bf16_t*)(F.ws + WS_A), DM};
                    pg8::gemm_phase<pg8::EpiPlain, OneUnitOrder, false, true>(F.lds, g, S, E);
                    group_barrier(F, ctl + CW_Q + 128, NCTXW);
                    e2_phase(F, 0, MLAT, MALL, (int)blockIdx.x, NCTXW);
                } else e2_phase(F, 0, 0, MLAT, (int)blockIdx.x - NCTXW, F.G - NCTXW);
            } else if (l == 0) {
                e2_phase(F, 0, 0, MALL, F.vcu, F.G);
            } else e2_phase(F, l, 0, MLAT, F.vcu, F.G);
        } PHASE_END(false)
        PHASE_BEGIN(8) {
            pg8::Gemm g{(const pg8::bf16_t*)(F.ws + WS_B), (const pg8::bf16_t*)(F.ws + WS_WF1 + l * SZ_WF1), M, 2 * DFF, DM}; pg8::StaticOrder S; S.init(M, 2 * DFF, F.G, (int)blockIdx.x);
            pg8::EpiSwiGLU E{(pg8::bf16_t*)(F.ws + WS_A), DFF};
            pg8::gemm_phase<pg8::EpiSwiGLU, pg8::StaticOrder, true, true>(F.lds, g, S, E);
        } PHASE_END(false)
        PHASE_BEGIN(9) {
            pg8::Gemm g{(const pg8::bf16_t*)(F.ws + WS_A), (const pg8::bf16_t*)(F.ws + WS_WF2 + l * SZ_WF2), MLAT, DM, DFF}; pg8::StaticOrder S; S.init(MLAT, DM, F.G, (int)blockIdx.x);
            pg8::EpiPlain E{(pg8::bf16_t*)(F.ws + WS_B), DM};
            pg8::gemm_phase<pg8::EpiPlain, pg8::StaticOrder, true, true>(F.lds, g, S, E);
        } PHASE_END(false)
        PHASE_BEGIN(10) {
            if (l == 0) {
                constexpr int NC2 = 2 * NCTXW, E3_R1 = MLAT - 36 * NC2;
                if ((int)blockIdx.x < NC2) {
                    const int uu = (int)blockIdx.x & (NCTXW - 1), ks = (int)blockIdx.x / NCTXW;
                    pg8::bf16_t* part2 = (pg8::bf16_t*)(F.ws + WS_KVT) - (size_t)MLAT * DM;
                    pg8::Gemm g{(const pg8::bf16_t*)(F.ws + WS_A) + ks * (DFF / 2), (const pg8::bf16_t*)(F.ws + WS_WF2) + ks * (DFF / 2), MALL, DM, DFF / 2, DFF}; OneUnitOrder S{128 + (uu >> 2), uu & 3};
                    pg8::EpiPlain E{ks ? part2 : (pg8::bf16_t*)(F.ws + WS_B), DM};
                    pg8::gemm_phase<pg8::EpiPlain, OneUnitOrder, false, true>(F.lds, g, S, E);
                    group_barrier(F, ctl + CW_Q + 192, NC2);
                    e3_rows<false, true>(F, 0, MLAT, MALL, (int)blockIdx.x, NC2, (const bf16*)part2);
                    e3_phase(F, 0, E3_R1, MLAT, (int)blockIdx.x, NC2);
                } else e3_phase(F, 0, 0, E3_R1, (int)blockIdx.x - NC2, F.G - NC2);
            } else e3_phase(F, l, 0, MLAT, F.vcu, F.G);
        } PHASE_END(l == 1)
    }
#ifdef KCLK
    if (blockIdx.x == 0 && F.tid == 0) { const float cyc = (float)(__builtin_amdgcn_s_memtime() - kclk0); F.out[0] = 1000.0f * rintf(cyc * (1.0f / (float)KCLK)); }
#endif
#ifdef PHPROF
    if (blockIdx.x == 0 && F.tid == 0) { const unsigned long long* pr = (const unsigned long long*)(F.ws + WS_CTL) + 8300; const float us = (float)(pr[PHPROF + 1] - pr[PHPROF]) * 0.01f;
        F.out[0] = 1000.0f * rintf(log2f(fmaxf(us, 0.01f)) * (float)PHPROF_Q); }
#endif
#ifdef KFREQ
    if (blockIdx.x == 0 && F.tid == 0) { const float cyc = (float)(__builtin_amdgcn_s_memtime() - kfc0), rt = (float)(__builtin_amdgcn_s_memrealtime() - kfr0); const float mhz = cyc / rt * 100.0f;
        F.out[0] = 1000.0f * rintf((mhz - (float)KFREQ) * (1.0f / (float)KFSTEP)); }
#endif
#ifndef D5_PROF_Q
#define D5_PROF_Q 6
#endif
#ifdef LRUPROF
    xcd_barrier(bar);
    if (blockIdx.x == 0 && F.tid == 0) { const unsigned long long* pr = (const unsigned long long*)(F.ws + WS_CTL) + 8192; F.out[0] = 1000.0f * rintf(log2f(fmaxf((float)pr[0], 1.0f)) * (float)LRUPROF_Q); }
#endif
#if D5_PROF
    xcd_barrier(bar);
    if (blockIdx.x == 0 && F.tid == 0) { const unsigned long long* pr = (const unsigned long long*)(F.ws + WS_CTL) + 8192; { const float v_ = (float)pr[0] * (1.0f / 132.0f); F.out[0] = 1000.0f * rintf(log2f(fmaxf(v_, 1.0f)) * (float)D5_PROF_Q); }     F.out[1] = 0.f; }
#endif
#if DBG_PROBE
    xcd_barrier(bar);
    if (blockIdx.x == 0 && F.tid == 0) { const float md = __uint_as_float(ctl[CW_DBG]), ms = __uint_as_float(ctl[CW_DBG + 1]); F.out[0] = 1.0e4f * md / fmaxf(ms, 1e-20f); F.out[1] = 0.f; }
#endif
}
constexpr int N_PHASES = 2 + 2 * 9;

#ifndef MK_N_LAUNCHES
#define MK_N_LAUNCHES 1
#endif
extern "C" void kernel_launch(void* const* d_in, const int* in_sizes, int n_in, void* d_out, int out_size, void* d_ws, size_t ws_size, hipStream_t stream) {
    static int grid = 0;
    if (grid == 0) {
        if (n_in != 23 || in_sizes[0] != MLAT * DM || out_size != MLAT * DM || ws_size < WS_END) { fprintf(stderr, "kernel_launch: unexpected shapes (n_in %d, in0 %d, out %d, ws %zu); nothing launched\n", n_in, n_in > 0 ? in_sizes[0] : -1, out_size, ws_size); grid = -1; return; }
        int dev = 0, cus = 0, per_cu = 0;
        if (hipGetDevice(&dev) != hipSuccess || hipDeviceGetAttribute(&cus, hipDeviceAttributeMultiprocessorCount, dev) != hipSuccess) { fprintf(stderr, "kernel_launch: device query failed\n"); grid = -1; return; }
        if (hipFuncSetAttribute((const void*)hybrid_fwd, hipFuncAttributeMaxDynamicSharedMemorySize, LDS_BYTES) != hipSuccess) { fprintf(stderr, "kernel_launch: hipFuncSetAttribute failed\n"); grid = -1; return; }
        if (hipOccupancyMaxActiveBlocksPerMultiprocessor(&per_cu, (const void*)hybrid_fwd, NWAVES * 64, LDS_BYTES) != hipSuccess || per_cu < 1) { fprintf(stderr, "kernel_launch: occupancy query reports %d workgroups per CU\n", per_cu); }
        (void)hipGetLastError();
        grid = cus;
    }
    if (grid < 0) return;
    if (hipMemsetAsync((char*)d_ws + WS_CTL, 0, CTL_ZERO_BYTES, stream) != hipSuccess) { fprintf(stderr, "kernel_launch: memset failed\n"); return; }
    Args a{};
    for (int i = 0; i < 23; ++i) a.in[i] = (const float*)d_in[i];
    a.out = (float*)d_out; a.ws = (unsigned char*)d_ws;
#if MK_N_LAUNCHES == 1
    a.ph_lo = 0; a.ph_hi = N_PHASES;
    hipLaunchKernelGGL(hybrid_fwd, dim3(grid), dim3(NWAVES * 64), LDS_BYTES, stream, a);
#else
    for (int p = 0; p < N_PHASES; ++p) { a.ph_lo = p; a.ph_hi = p + 1; hipLaunchKernelGGL(hybrid_fwd, dim3(grid), dim3(NWAVES * 64), LDS_BYTES, stream, a); }
#endif
    const hipError_t le = hipPeekAtLastError();
    if (le != hipSuccess) fprintf(stderr, "kernel_launch: launch failed: %s\n", hipGetErrorName(le));
}
```

```cpp
#include <hip/hip_runtime.h>
#include <cstdio>
#include <cstdint>
namespace pg8 {
#define PG8_LAS __attribute__((address_space(3)))
typedef unsigned short bf16_t;
typedef short bf16x8 __attribute__((ext_vector_type(8)));
typedef float f32x4 __attribute__((ext_vector_type(4)));
typedef unsigned u32x4 __attribute__((ext_vector_type(4)));
constexpr int BM = 256, BK = 64, HALF = 128, HTB = HALF * BK * 2  , STAGE_BYTES = 8 * HTB, NXCD = 8, WGM = 8;

__host__ __device__ __forceinline__ int lds_byte(int r, int c) { const int st = (r >> 4) * 2 + (c >> 5), rr = r & 15, cc = c & 31, ob = rr * 64 + cc * 2; return st * 1024 + (ob ^ (((ob >> 9) & 1) << 5)); }
__host__ __device__ __forceinline__ void stage_rc(int b, int& R, int& C) { const int st = b / 1024, sb = b % 1024, swz = sb ^ (((sb >> 9) & 1) << 5); R = (st >> 1) * 16 + swz / 64; C = (st & 1) * 32 + (swz % 64) / 2; }
__host__ __device__ __forceinline__ int perm32(int rho) { const int n = rho >> 4, i = rho & 15; return 8 * (i >> 2) + 4 * n + (i & 3); }

struct Unit { int pm, pn; };
struct Gemm { const bf16_t* A; const bf16_t* Bt; int M, N, K; int ld = 0; };

struct StaticOrder {
    int nM, nN, nwg, G, c;
    __host__ __device__ void init(int M, int N, int G_, int c_) { nM = M / BM; nN = N / BM; nwg = nM * nN; G = G_; c = c_; }
    __host__ __device__ bool next(int i, Unit& u) const {
        const long L = (long)i * G + c; if (L >= nwg) return false;
        int wgid = (int)L; { const int q = nwg / NXCD, r = nwg % NXCD, xcd = wgid % NXCD, off = wgid / NXCD; wgid = (xcd < r ? xcd * (q + 1) : r * (q + 1) + (xcd - r) * q) + off; }
        const int nig = WGM * nN, gid = wgid / nig, fm = gid * WGM, gsz = (nM - fm) < WGM ? (nM - fm) : WGM;
        u.pm = fm + ((wgid % nig) % gsz); u.pn = (wgid % nig) / gsz; return true;
    }
    __device__ __forceinline__ void a_ready(const Unit&) const {}
    __device__ __forceinline__ void done(const Unit&) const {}
};

__device__ __forceinline__ unsigned cvt_pk_bf16(float lo, float hi) { unsigned r; asm volatile("v_cvt_pk_bf16_f32 %0, %1, %2" : "=v"(r) : "v"(lo), "v"(hi)); return r; }
typedef float f32x2 __attribute__((ext_vector_type(2)));
typedef unsigned u32x2 __attribute__((ext_vector_type(2)));
constexpr float LOG2E_F = 1.4426950408889634f;
struct EpiPlain {
    static constexpr bool PERM = true, AFTER_DRAIN = false;
    bf16_t* O; int ldc;
    __device__ __forceinline__ void operator()(const f32x4 (&acc)[2][2][4][2], const Unit& u, int wr, int wc, int fr, int fq) const {
        const int row0 = u.pm * BM + wr * 64 + fr, col0 = u.pn * BM + wc * 32 + 8 * fq;
#pragma unroll
        for (int ai = 0; ai < 2; ++ai)
#pragma unroll
            for (int m = 0; m < 4; ++m) { bf16_t* rowp = O + (size_t)(row0 + ai * HALF + m * 16) * ldc + col0;
#pragma unroll
                for (int bj = 0; bj < 2; ++bj) { const f32x4 v0 = acc[ai][bj][m][0], v1 = acc[ai][bj][m][1];
                    u32x4 w; w.x = cvt_pk_bf16(v0[0], v0[1]); w.y = cvt_pk_bf16(v0[2], v0[3]); w.z = cvt_pk_bf16(v1[0], v1[1]); w.w = cvt_pk_bf16(v1[2], v1[3]);
                    *(u32x4*)(rowp + bj * HALF) = w; } }
    }
};
struct EpiSwiGLU {
    static constexpr bool PERM = true, AFTER_DRAIN = false;
    bf16_t* O; int ldc;
    __device__ __forceinline__ static float silu_mul(float g, float uu) { return g * __builtin_amdgcn_rcpf(1.0f + __builtin_amdgcn_exp2f(-g * LOG2E_F)) * uu; }
    __device__ __forceinline__ void operator()(const f32x4 (&acc)[2][2][4][2], const Unit& u, int wr, int wc, int fr, int fq) const {
        const int row0 = u.pm * BM + wr * 64 + fr, col0 = u.pn * HALF + wc * 32 + 8 * fq;
#pragma unroll
        for (int ai = 0; ai < 2; ++ai)
#pragma unroll
            for (int m = 0; m < 4; ++m) { bf16_t* rowp = O + (size_t)(row0 + ai * HALF + m * 16) * ldc + col0;
                const f32x4 g0 = acc[ai][0][m][0], g1 = acc[ai][0][m][1], u0 = acc[ai][1][m][0], u1 = acc[ai][1][m][1];
                u32x4 w; w.x = cvt_pk_bf16(silu_mul(g0[0], u0[0]), silu_mul(g0[1], u0[1])); w.y = cvt_pk_bf16(silu_mul(g0[2], u0[2]), silu_mul(g0[3], u0[3]));
                w.z = cvt_pk_bf16(silu_mul(g1[0], u1[0]), silu_mul(g1[1], u1[1])); w.w = cvt_pk_bf16(silu_mul(g1[2], u1[2]), silu_mul(g1[3], u1[3]));
                *(u32x4*)rowp = w; }
    }
};
struct EpiInProj {
    static constexpr bool PERM = true, AFTER_DRAIN = false;
    bf16_t* P; const float* tabRc; const float* tabRs; const float* tabDc; const float* tabDs;
    __device__ __forceinline__ void operator()(const f32x4 (&acc)[2][2][4][2], const Unit& u, int wr, int wc, int fr, int fq) const {
        asm volatile("" : "+v"(fr), "+v"(fq));
        const int sec = u.pn; const bool isctx = u.pm >= 128;
        int tbase; size_t prow0;
        if (!isctx) { const int b = u.pm >> 5; tbase = (u.pm & 31) * 256; prow0 = (size_t)b * 8448 + 256 + tbase; }
        else { const int b = u.pm - 128; tbase = 0; prow0 = (size_t)b * 8448; }
        float sc = 1.0f;
        if (sec == 0) sc = 0.125f * LOG2E_F; else if (sec == 6) sc = 0.125f; else if (sec == 9) sc = 0.17677669529663687f * LOG2E_F;
        const int mode = (sec == 5 || sec == 6) ? 1 : ((sec == 9 || sec == 10) ? 2 : 0);
        const int rbase = wr * 64 + fr;
#pragma unroll
        for (int bj = 0; bj < 2; ++bj) {
            const int pcol = 128 * bj + 32 * wc + 8 * fq, hh = pcol >> 6, ph = pcol & 63;
            if (mode == 0) {
#pragma unroll
                for (int ai = 0; ai < 2; ++ai)
#pragma unroll
                    for (int m = 0; m < 4; ++m) { const int row = rbase + 128 * ai + 16 * m;
                        const f32x4 v0 = acc[ai][bj][m][0] * sc, v1 = acc[ai][bj][m][1] * sc;
                        u32x4 w; w.x = cvt_pk_bf16(v0[0], v0[1]); w.y = cvt_pk_bf16(v0[2], v0[3]); w.z = cvt_pk_bf16(v1[0], v1[1]); w.w = cvt_pk_bf16(v1[2], v1[3]);
                        *(u32x4*)(P + (prow0 + row) * 3072 + sec * 256 + pcol) = w; }
            } else {
                int G, jb, col1, col2, tw; bool userow; const float *tc, *ts;
                if (mode == 1) { G = ph >> 3; jb = (4 * G) & 15; userow = G < 4; col1 = sec * 256 + hh * 64 + 4 * G; col2 = col1 + 32; tw = 16; tc = tabRc; ts = tabRs; }
                else { const int mp = ph >> 5, pm_ = ph & 31; G = pm_ >> 3; jb = (4 * G) & 7; userow = G < 2; col1 = sec * 256 + hh * 64 + mp * 32 + 4 * G; col2 = col1 + 16; tw = 8; tc = tabDc; ts = tabDs; }
#pragma unroll
                for (int ai = 0; ai < 2; ++ai)
#pragma unroll
                    for (int m = 0; m < 4; ++m) { const int row = rbase + 128 * ai + 16 * m; const int t = tbase + row;
                        const int pos = userow ? (t >> 6) : (t & 63);
                        f32x4 c4 = (f32x4){1.f, 1.f, 1.f, 1.f}, s4 = (f32x4){0.f, 0.f, 0.f, 0.f};
                        if (!isctx) { c4 = *(const f32x4*)(tc + pos * tw + jb); s4 = *(const f32x4*)(ts + pos * tw + jb); }
                        const f32x4 x1 = acc[ai][bj][m][0] * sc, x2 = acc[ai][bj][m][1] * sc;
                        const f32x4 o1 = x1 * c4 - x2 * s4, o2 = x2 * c4 + x1 * s4;
                        u32x2 w1, w2; w1.x = cvt_pk_bf16(o1[0], o1[1]); w1.y = cvt_pk_bf16(o1[2], o1[3]); w2.x = cvt_pk_bf16(o2[0], o2[1]); w2.y = cvt_pk_bf16(o2[2], o2[3]);
                        bf16_t* rp = P + (prow0 + row) * 3072;
                        *(u32x2*)(rp + col1) = w1; *(u32x2*)(rp + col2) = w2; asm volatile("" ::: "memory"); }
            }
        }
    }
};
template <class Epi, class Sched, bool ALIGN_EPI = false, bool SP2 = false>
__device__ __forceinline__ void gemm_phase(PG8_LAS unsigned char* lds, const Gemm g, const Sched& S, const Epi& E) {
    int tid_ = threadIdx.x; asm volatile("" : "+v"(tid_)); const int tid = tid_, wid = __builtin_amdgcn_readfirstlane(tid >> 6), lane = tid & 63, wr = wid >> 2, wc = wid & 3, fr = lane & 15, fq = lane >> 4;
    const int K = g.K, nt = K / BK, LD = g.ld ? g.ld : g.K;
    unsigned voffA[2], voffB[2];
#pragma unroll
    for (int i = 0; i < 2; ++i) { int R, C; stage_rc(tid * 16 + i * 8192, R, C); const int Rb = Epi::PERM ? ((R & ~31) + perm32(R & 31)) : R;
        voffA[i] = (unsigned)(R * LD + C) * 2u; voffB[i] = (unsigned)(Rb * LD + C) * 2u; }
    const size_t kstep = (size_t)(BK * 2);
    const size_t hstep = (size_t)HALF * LD * 2;
    const size_t tstep = 2 * hstep;
    const unsigned ldsw = (unsigned)wid * 1024u;
    const int aoff = lds_byte(wr * 64 + fr, fq * 8), boff = lds_byte(wc * 32 + fr, fq * 8);
#define PG8_SA(b, h) (((b) * 2 + (h)) * HTB)
#define PG8_SB(b, h) ((4 + (b) * 2 + (h)) * HTB)
#define PG8_STAGE(bufoff, gbase, voff) do { _Pragma("unroll") for (int _i = 0; _i < 2; ++_i) \
        __builtin_amdgcn_global_load_lds((const unsigned*)((const char*)(gbase) + (voff)[_i]), (PG8_LAS unsigned*)(lds + (bufoff) + ldsw + _i * 8192), 16, 0, 0); } while (0)
#define PG8_LDA(dst, b, h) do { _Pragma("unroll") for (int m = 0; m < 4; ++m) _Pragma("unroll") for (int k = 0; k < 2; ++k) dst[m][k] = *(const PG8_LAS bf16x8*)(lds + PG8_SA(b, h) + aoff + m * 2048 + k * 1024); } while (0)
#define PG8_LDB(dst, b, h) do { _Pragma("unroll") for (int n = 0; n < 2; ++n) _Pragma("unroll") for (int k = 0; k < 2; ++k) dst[n][k] = *(const PG8_LAS bf16x8*)(lds + PG8_SB(b, h) + boff + n * 2048 + k * 1024); } while (0)
#define PG8_MMA(ai, bj, At, Bt) do { __builtin_amdgcn_s_setprio(1); _Pragma("unroll") for (int m = 0; m < 4; ++m) _Pragma("unroll") for (int n = 0; n < 2; ++n) _Pragma("unroll") for (int k = 0; k < 2; ++k) \
        acc[ai][bj][m][n] = __builtin_amdgcn_mfma_f32_16x16x32_bf16(Bt[n][k], At[m][k], acc[ai][bj][m][n], 0, 0, 0); __builtin_amdgcn_s_setprio(0); } while (0)
#define PG8_WAIT_V(n) asm volatile("s_waitcnt vmcnt(" #n ")" ::: "memory")
#define PG8_WAIT_L(n) asm volatile("s_waitcnt lgkmcnt(" #n ")" ::: "memory")
#define PG8_BAR __builtin_amdgcn_s_barrier()
#define PG8_SCHED __builtin_amdgcn_sched_barrier(0)
    Unit cur, nxt; int ui = 0;
    if (!S.next(0, cur)) return;
    f32x4 acc[2][2][4][2];
#pragma unroll
    for (int a = 0; a < 2; ++a)
#pragma unroll
        for (int b = 0; b < 2; ++b)
#pragma unroll
            for (int m = 0; m < 4; ++m)
#pragma unroll
                for (int n = 0; n < 2; ++n) acc[a][b][m][n] = (f32x4){0.f, 0.f, 0.f, 0.f};
    bf16x8 At[4][2], B0[2][2], B1[2][2];
    const char* cA = (const char*)g.A + (size_t)cur.pm * tstep; const char* cB = (const char*)g.Bt + (size_t)cur.pn * tstep;
    S.a_ready(cur);
    if constexpr (SP2) {
        PG8_STAGE(PG8_SB(0, 0), cB, voffB); PG8_STAGE(PG8_SB(0, 1), cB + hstep, voffB); PG8_STAGE(PG8_SA(0, 0), cA, voffA); PG8_STAGE(PG8_SA(0, 1), cA + hstep, voffA);
        if (wr == 1) PG8_BAR;
        PG8_WAIT_V(2); PG8_BAR;
        PG8_STAGE(PG8_SB(1, 0), cB + kstep, voffB); PG8_STAGE(PG8_SA(1, 0), cA + kstep, voffA); PG8_STAGE(PG8_SB(1, 1), cB + hstep + kstep, voffB);
        PG8_WAIT_V(6); PG8_BAR;
    } else {
        PG8_STAGE(PG8_SB(0, 0), cB, voffB); PG8_STAGE(PG8_SA(0, 0), cA, voffA); PG8_STAGE(PG8_SB(0, 1), cB + hstep, voffB); PG8_STAGE(PG8_SA(0, 1), cA + hstep, voffA);
        if (wr == 1) PG8_BAR;
        PG8_WAIT_V(4); PG8_BAR;
        PG8_STAGE(PG8_SB(1, 0), cB + kstep, voffB); PG8_STAGE(PG8_SA(1, 0), cA + kstep, voffA); PG8_STAGE(PG8_SB(1, 1), cB + hstep + kstep, voffB);
        PG8_WAIT_V(6); PG8_BAR;
    }
    for (;;) {
        const bool has_next = S.next(ui + 1, nxt);
        const char* nA = has_next ? (const char*)g.A + (size_t)nxt.pm * tstep : cA; const char* nB = has_next ? (const char*)g.Bt + (size_t)nxt.pn * tstep : cB;
        for (int t = 0; t < nt; t += 2) {
            const bool last = (t == nt - 2);
            const char* a1 = cA + (size_t)(t + 1) * kstep;
            const char* a2 = last ? nA : cA + (size_t)(t + 2) * kstep; const char* b2 = last ? nB : cB + (size_t)(t + 2) * kstep;
            const char* a3 = a2 + kstep; const char* b3 = b2 + kstep;
            if (last && has_next) S.a_ready(nxt);
            if constexpr (SP2) {
            PG8_LDB(B0, 0, 0); PG8_LDB(B1, 0, 1); PG8_SCHED; PG8_LDA(At, 0, 0); PG8_STAGE(PG8_SA(1, 1), a1 + hstep, voffA);
            PG8_WAIT_V(8); PG8_WAIT_L(0); PG8_BAR; PG8_MMA(0, 0, At, B0); PG8_MMA(0, 1, At, B1); PG8_BAR; PG8_SCHED;
            PG8_LDA(At, 0, 1); PG8_STAGE(PG8_SB(0, 0), b2, voffB); PG8_STAGE(PG8_SB(0, 1), b2 + hstep, voffB); PG8_STAGE(PG8_SA(0, 0), a2, voffA);
            PG8_WAIT_V(8); PG8_WAIT_L(0); PG8_BAR; PG8_MMA(1, 0, At, B0); PG8_MMA(1, 1, At, B1); PG8_BAR; PG8_SCHED;
            PG8_LDB(B0, 1, 0); PG8_LDB(B1, 1, 1); PG8_SCHED; PG8_LDA(At, 1, 0); PG8_STAGE(PG8_SA(0, 1), a2 + hstep, voffA);
            PG8_WAIT_V(8); PG8_WAIT_L(0); PG8_BAR; PG8_MMA(0, 0, At, B0); PG8_MMA(0, 1, At, B1); PG8_BAR; PG8_SCHED;
            PG8_LDA(At, 1, 1); PG8_STAGE(PG8_SB(1, 0), b3, voffB); PG8_STAGE(PG8_SB(1, 1), b3 + hstep, voffB); PG8_STAGE(PG8_SA(1, 0), a3, voffA);
            PG8_WAIT_V(8); PG8_WAIT_L(0); PG8_BAR; PG8_MMA(1, 0, At, B0); PG8_MMA(1, 1, At, B1); PG8_BAR; PG8_SCHED;
            } else {
            PG8_LDB(B0, 0, 0); PG8_SCHED; PG8_LDA(At, 0, 0); PG8_STAGE(PG8_SA(1, 1), a1 + hstep, voffA);
            PG8_WAIT_L(8); PG8_BAR; PG8_WAIT_L(0); PG8_MMA(0, 0, At, B0); PG8_BAR; PG8_SCHED;
            PG8_LDB(B1, 0, 1); PG8_STAGE(PG8_SB(0, 0), b2, voffB);
            PG8_BAR; PG8_WAIT_L(0); PG8_MMA(0, 1, At, B1); PG8_BAR;
            PG8_LDA(At, 0, 1); PG8_STAGE(PG8_SA(0, 0), a2, voffA);
            PG8_BAR; PG8_WAIT_L(0); PG8_MMA(1, 0, At, B0); PG8_BAR; PG8_SCHED;
            PG8_STAGE(PG8_SB(0, 1), b2 + hstep, voffB);
            PG8_WAIT_V(6); PG8_BAR; PG8_MMA(1, 1, At, B1); PG8_BAR;
            PG8_LDB(B0, 1, 0); PG8_SCHED; PG8_LDA(At, 1, 0); PG8_STAGE(PG8_SA(0, 1), a2 + hstep, voffA);
            PG8_WAIT_L(8); PG8_BAR; PG8_WAIT_L(0); PG8_MMA(0, 0, At, B0); PG8_BAR; PG8_SCHED;
            PG8_LDB(B1, 1, 1); PG8_STAGE(PG8_SB(1, 0), b3, voffB);
            PG8_BAR; PG8_WAIT_L(0); PG8_MMA(0, 1, At, B1); PG8_BAR;
            PG8_LDA(At, 1, 1); PG8_STAGE(PG8_SA(1, 0), a3, voffA);
            PG8_BAR; PG8_WAIT_L(0); PG8_MMA(1, 0, At, B0); PG8_BAR; PG8_SCHED;
            PG8_STAGE(PG8_SB(1, 1), b3 + hstep, voffB);
            PG8_WAIT_V(6); PG8_BAR; PG8_MMA(1, 1, At, B1); PG8_BAR;
            }
        }
        if constexpr (ALIGN_EPI) { if (wr == 0) PG8_BAR; }
        if constexpr (!Epi::AFTER_DRAIN) { E(acc, cur, wr, wc, fr, fq); S.done(cur); }
        if (!has_next) break;
#pragma unroll
        for (int a = 0; a < 2; ++a)
#pragma unroll
            for (int b = 0; b < 2; ++b)
#pragma unroll
                for (int m = 0; m < 4; ++m)
#pragma unroll
                    for (int n = 0; n < 2; ++n) acc[a][b][m][n] = (f32x4){0.f, 0.f, 0.f, 0.f};
        cur = nxt; cA = nA; cB = nB; ++ui;
        if constexpr (ALIGN_EPI) { if (wr == 1) PG8_BAR; }
    }
    PG8_WAIT_V(0);
    if constexpr (!ALIGN_EPI) { if (wr == 0) PG8_BAR; }
    PG8_BAR;
    if constexpr (Epi::AFTER_DRAIN) { E.fused(acc, cur, wr, wc, fr, fq, lds, wid, lane); S.done(cur); }
#undef PG8_SA
#undef PG8_SB
#undef PG8_STAGE
#undef PG8_LDA
#undef PG8_LDB
#undef PG8_MMA
#undef PG8_WAIT_V
#undef PG8_WAIT_L
#undef PG8_BAR
#undef PG8_SCHED
}
}
#define GAS __attribute__((address_space(1)))
#define LAS __attribute__((address_space(3)))
typedef unsigned short bf16;
typedef unsigned v4u __attribute__((ext_vector_type(4)));
typedef float f32x4 __attribute__((ext_vector_type(4)));
typedef short bf16x8 __attribute__((ext_vector_type(8)));
typedef GAS unsigned gu32;
typedef GAS unsigned long long gu64;
#define RLX_AGENT __ATOMIC_RELAXED, __HIP_MEMORY_SCOPE_AGENT
#define LDS_WAIT() asm volatile("s_waitcnt lgkmcnt(0)" ::: "memory")
#define VM_WAIT() asm volatile("s_waitcnt vmcnt(0)" ::: "memory")
__device__ __forceinline__ unsigned long long rt() { return __builtin_amdgcn_s_memrealtime(); }
__device__ __forceinline__ unsigned f2bf(float f) { unsigned u = __builtin_bit_cast(unsigned, f); return (u + 0x7fffu + ((u >> 16) & 1u)) >> 16; }

#define XB_TMO      128
#define XB_XCNT(j)  (256  + 64 * (j))
#define XB_XSUB(j)  (1280 + 64 * (j))
#define XB_XGEN(j)  (2304 + 64 * (j))
#define XB_TOP      3328
#define XB_TOPGEN   3392
#define XCD_BAR_WORDS 3456
#define XB_SPIN_CAP (1u << 22)

__device__ __forceinline__ unsigned xb_ld(unsigned* p)              { return __hip_atomic_load(p, __ATOMIC_RELAXED, __HIP_MEMORY_SCOPE_AGENT); }
__device__ __forceinline__ unsigned xb_add(unsigned* p, unsigned v) { return __hip_atomic_fetch_add(p, v, __ATOMIC_RELAXED, __HIP_MEMORY_SCOPE_AGENT); }
__device__ __forceinline__ unsigned xb_xcc_id() { return (unsigned)__builtin_amdgcn_s_getreg((3 << 11) | 20) & 0xFu; }
#define XB_SPIN(cond, bar) do { unsigned _sp = 0; while (cond) { __builtin_amdgcn_s_sleep(1); \
    if ((++_sp & 255u) == 0u) { if (xb_ld(&(bar)[XB_TMO])) break; if (_sp > XB_SPIN_CAP) { atomicAdd(&(bar)[XB_TMO], 1u); break; } } } } while (0)

struct XcdBarrier {
    unsigned* bar; unsigned x;
    volatile LAS unsigned* st;
};

__device__ __forceinline__ XcdBarrier xcd_barrier_post(unsigned* bar, volatile LAS unsigned* st) {
    XcdBarrier b; b.bar = bar; b.x = xb_xcc_id(); b.st = st;
    if (threadIdx.x == 0) (void)xb_add(&bar[XB_XCNT(b.x)], 1u);
    return b;
}
__device__ __forceinline__ void xcd_barrier_complete(unsigned* bar, unsigned x, unsigned& nloc, unsigned& nx) {
    const unsigned G = gridDim.x * gridDim.y * gridDim.z;
    unsigned sum, cnt, mine, sp = 0u;
    for (;;) {
        sum = 0u; cnt = 0u; mine = 0u;
#pragma unroll
        for (unsigned j = 0; j < 16; ++j) { const unsigned c = xb_ld(&bar[XB_XCNT(j)]); sum += c; cnt += (c > 0u) ? 1u : 0u; mine = (j == x) ? c : mine; }
        if (sum == G) break;
        __builtin_amdgcn_s_sleep(1);
        if ((++sp & 255u) == 0u) { if (xb_ld(&bar[XB_TMO])) break; if (sp > XB_SPIN_CAP) { atomicAdd(&bar[XB_TMO], 1u); break; } }
    }
    nloc = mine > 0u ? mine : 1u; nx = cnt > 0u ? cnt : 1u;
}

__device__ __forceinline__ void xcd_barrier(const XcdBarrier& b) {
    asm volatile("s_waitcnt vmcnt(0)" ::: "memory");
    __syncthreads();
    if (threadIdx.x == 0) {
        unsigned* bar = b.bar;
        __builtin_amdgcn_s_waitcnt(0);
        unsigned nloc = b.st[0], nx = b.st[1];
        if (nloc == 0u) { xcd_barrier_complete(bar, b.x, nloc, nx); b.st[0] = nloc; b.st[1] = nx; }
        const unsigned old = xb_add(&bar[XB_XSUB(b.x)], 1u);
        const unsigned gen = old / nloc;
        if (old + 1u == (gen + 1u) * nloc) {
            __builtin_amdgcn_fence(__ATOMIC_RELEASE, "agent");
            asm volatile("s_waitcnt vmcnt(0)" ::: "memory");
            const unsigned og = xb_add(&bar[XB_TOP], 1u);
            const unsigned tg = og / nx;
            if (og + 1u == (tg + 1u) * nx) xb_add(&bar[XB_TOPGEN], 1u);
            else XB_SPIN(xb_ld(&bar[XB_TOPGEN]) == tg, bar);
            __builtin_amdgcn_fence(__ATOMIC_ACQUIRE, "agent");
            xb_add(&bar[XB_XGEN(b.x)], 1u);
            asm volatile("s_waitcnt vmcnt(0)" ::: "memory");
        } else {
            XB_SPIN(xb_ld(&bar[XB_XGEN(b.x)]) == gen, bar);
            __builtin_amdgcn_fence(__ATOMIC_ACQUIRE, "agent");
            asm volatile("s_waitcnt vmcnt(0)" ::: "memory");
        }
    }
    __syncthreads();
}
#ifndef DBG_PROBE
#define DBG_PROBE 0
#endif
#ifndef DBG_NOINTER
#define DBG_NOINTER 0
#endif
#ifndef DBG_LAYER
#define DBG_LAYER -1
#endif
#ifndef NAIVE_RET
#define NAIVE_RET 0
#endif
#ifndef NAIVE_LRU
#define NAIVE_LRU 0
#endif
constexpr int NB = 4, SEQ = 8192, DM = 1024, NCX = 256, NKEY = 8448, MLAT = 32768, MCTX = 1024, MALL = 33792, NIN = 3072, DFF = 2816;
constexpr float EPS = 1e-6f, LOG2E = 1.4426950408889634f;
constexpr int NWAVES = 8;
constexpr size_t MiB = 1u << 20, KiB = 1024;
constexpr size_t WS_CTL = 0, CTL_ZERO_BYTES = 1 * MiB;
constexpr size_t WS_WIN = 2 * MiB, WS_WOUT = 14 * MiB, WS_WF1 = 18 * MiB, WS_WF2 = 40 * MiB;
constexpr size_t SZ_WIN = 6 * MiB, SZ_WOUT = 2 * MiB, SZ_WF1 = 11 * MiB, SZ_WF2 = (size_t)1024 * 2816 * 2;
constexpr size_t WS_LRUW = 52 * MiB, SZ_LRUW = 128 * KiB;
constexpr size_t WS_MOD = 52 * MiB + 256 * KiB;
constexpr size_t WS_TAB = 52 * MiB + 512 * KiB;
constexpr size_t WS_LAM = 52 * MiB + 544 * KiB;
constexpr size_t WS_XC = 54 * MiB;
constexpr size_t WS_LSUM = 58 * MiB;
constexpr size_t WS_LCIN = 67 * MiB;
constexpr size_t WS_KVT = 72 * MiB;
constexpr size_t WS_SIN = 105 * MiB;
constexpr size_t WS_B = 122 * MiB;
constexpr size_t WS_A = 188 * MiB;
constexpr size_t WS_XRES = 386 * MiB;
constexpr size_t WS_END = 452 * MiB;
constexpr int CW_BAR = 4096, CW_Q = 8192;
constexpr int RING_BYTES = 131072, LDSCTL_OFF = RING_BYTES, MISC_OFF = LDSCTL_OFF + 320, LDS_BYTES = 147456;

typedef unsigned u32x2 __attribute__((ext_vector_type(2)));
typedef float f32x16 __attribute__((ext_vector_type(16)));
typedef short s16x4 __attribute__((ext_vector_type(4)));
typedef short v4i16_t __attribute__((ext_vector_type(4)));
typedef float f32x2_t __attribute__((ext_vector_type(2))); typedef __bf16 bf16x2_t __attribute__((ext_vector_type(2)));

__device__ __forceinline__ unsigned pk2(float lo, float hi) { f32x2_t v = {lo, hi}; bf16x2_t b = __builtin_convertvector(v, bf16x2_t); return __builtin_bit_cast(unsigned, b); }
__device__ __forceinline__ float bf2f(unsigned short u) { return __builtin_bit_cast(float, (unsigned)u << 16); }
__device__ __forceinline__ float bflo(unsigned w) { return __builtin_bit_cast(float, w << 16); }
__device__ __forceinline__ float bfhi(unsigned w) { return __builtin_bit_cast(float, w & 0xffff0000u); }
__device__ __forceinline__ float wave_sum(float v) {
#pragma unroll
    for (int o = 1; o < 64; o <<= 1) v += __shfl_xor(v, o);
    return v;
}
__device__ __forceinline__ float ex2(float x) { return __builtin_amdgcn_exp2f(x); }
__device__ __forceinline__ float rcp(float x) { return __builtin_amdgcn_rcpf(x); }
__device__ __forceinline__ float sigmoidf_(float x) { return rcp(1.0f + ex2(-x * LOG2E)); }
__device__ __forceinline__ float gelu_tanh(float x) { const float z = 0.7978845608028654f * (x + 0.044715f * x * x * x); const float e = ex2(2.0f * LOG2E * z); const float th = 1.0f - 2.0f * rcp(1.0f + e); return 0.5f * x * (1.0f + th); }
__device__ __forceinline__ float max3f(float a, float b, float c) { float r; asm("v_max3_f32 %0, %1, %2, %3" : "=v"(r) : "v"(a), "v"(b), "v"(c)); return r; }
__device__ __forceinline__ float max2f(float a, float b) { float r; asm("v_max_f32_e32 %0, %1, %2" : "=v"(r) : "v"(a), "v"(b)); return r; }
__device__ __forceinline__ void swap32(float v, float& lo, float& hi) { float a = v, b = v; asm volatile("s_nop 1\n\tv_permlane32_swap_b32 %0, %1" : "+v"(a), "+v"(b)); lo = a; hi = b; }
__device__ __forceinline__ float swap_max(float v) { float lo, hi; swap32(v, lo, hi); return max2f(lo, hi); }
__device__ __forceinline__ float swap_add(float v) { float lo, hi; swap32(v, lo, hi); return lo + hi; }
__device__ __forceinline__ int crow(int r, int hi) { return (r & 3) + 8 * (r >> 2) + 4 * hi; }
__device__ __forceinline__ s16x4 vtr(const LAS unsigned char* p) { return __builtin_bit_cast(s16x4, __builtin_amdgcn_ds_read_tr16_b64_v4i16((LAS v4i16_t*)p)); }
__device__ __forceinline__ bf16x8 mk8(s16x4 lo, s16x4 hi) { return (bf16x8){lo[0], lo[1], lo[2], lo[3], hi[0], hi[1], hi[2], hi[3]}; }
__device__ __forceinline__ bf16x8 pack8(float a0, float a1, float a2, float a3, float a4, float a5, float a6, float a7) {
    v4u w; w.x = pk2(a0, a1); w.y = pk2(a2, a3); w.z = pk2(a4, a5); w.w = pk2(a6, a7); return __builtin_bit_cast(bf16x8, w); }
#define MFMA32(a, b, c) __builtin_amdgcn_mfma_f32_32x32x16_bf16((a), (b), (c), 0, 0, 0)
#define MFMA16(a, b, c) __builtin_amdgcn_mfma_f32_16x16x32_bf16((a), (b), (c), 0, 0, 0)

struct Frame {
    LAS unsigned char* lds;
    int tid, lane, wave, vcu, G;
    const float* const __attribute__((address_space(4)))* kin; float* out; unsigned char* ws;
};
#define LAUNDER_IDS int tid_ = F.tid; asm volatile("" : "+v"(tid_)); int wid_ = F.wave; asm volatile("" : "+s"(wid_)); const int tid = tid_, lane = tid_ & 63, wid = wid_; (void)tid; (void)lane; (void)wid; const float* const __attribute__((address_space(4)))* kin_ = F.kin; asm volatile("" : "+s"(kin_));
#define FIN(i) (kin_[i])
#define IN_X 0
#define IN_C 1
#define IN_CTX 2
#define IN_CCTX 3
#define IN_WMOD 4
#define IN_BMOD 5
#define IN_GPREMIX 6
#define IN_GPOSTMIX 7
#define IN_GPREFFN 8
#define IN_GPOSTFFN 9
#define IN_WIN 10
#define IN_RPB 11
#define IN_CONVW 12
#define IN_CONVB 13
#define IN_GATEW 14
#define IN_GATEB 15
#define IN_LRULAM 16
#define IN_RETDECAY 17
#define IN_DIFFLAM 18
#define IN_SUBLN 19
#define IN_WOUT 20
#define IN_WF1 21
#define IN_WF2 22

__device__ __forceinline__ int perm_in(int n) {
    const int sec = n >> 8, p = n & 255, hh = p >> 6, ph = p & 63;
    if (sec == 5 || sec == 6) { const int G = ph >> 3, j = ph & 7; return sec * 256 + hh * 64 + ((j < 4) ? 4 * G + j : 32 + 4 * G + (j - 4)); }
    if (sec == 9 || sec == 10) { const int mp = ph >> 5, pm = ph & 31, G = pm >> 3, j = pm & 7; return sec * 256 + hh * 64 + mp * 32 + ((j < 4) ? 4 * G + j : 16 + 4 * G + (j - 4)); }
    return n;
}
__device__ __forceinline__ int perm_f1(int n) { const int pn = n >> 8, half = (n >> 7) & 1, i = n & 127; return half * 2816 + pn * 128 + i; }
template <int MAP> __device__ __forceinline__ void p0_transpose_item(const float* W, int K, int N, bf16* WT, LAS float* scr, int item, int lane) {
    const int nblk = N / 32, kb = item / nblk, nb = item % nblk, k0 = 64 * kb, n0 = 32 * nb;
    const int nphys = n0 + (lane & 31);
    const int nsrc = (MAP == 1) ? perm_in(nphys) : ((MAP == 2) ? perm_f1(nphys) : nphys);
    float wv[32];
#pragma unroll
    for (int i = 0; i < 32; ++i) wv[i] = W[(size_t)(k0 + 2 * i + (lane >> 5)) * N + nsrc];
#pragma unroll
    for (int i = 0; i < 32; ++i) scr[(2 * i + (lane >> 5)) * 33 + (lane & 31)] = wv[i];
    LDS_WAIT(); asm volatile("" ::: "memory");
    const int c = lane & 7;
#pragma unroll
    for (int j = 0; j < 4; ++j) { const int n = (lane >> 3) + 8 * j; const LAS float* s = scr + (8 * c) * 33 + n;
        v4u o; o.x = pk2(s[0 * 33], s[1 * 33]); o.y = pk2(s[2 * 33], s[3 * 33]); o.z = pk2(s[4 * 33], s[5 * 33]); o.w = pk2(s[6 * 33], s[7 * 33]);
        *(GAS v4u*)(WT + (size_t)(n0 + n) * K + k0 + 8 * c) = o; }
    LDS_WAIT(); asm volatile("" ::: "memory");
}
__device__ __forceinline__ void p0a(Frame& F) {
    LAUNDER_IDS
    if ((int)blockIdx.x < 192) {
        LAS float* sc = (LAS float*)F.lds; LAS float* red = (LAS float*)(F.lds + 20480);
        for (int i = tid; i < 5120; i += 512) { const float v = (i < 4096) ? FIN(IN_C)[i] : FIN(IN_CCTX)[i - 4096]; sc[i] = v * sigmoidf_(v); }
        __syncthreads();
        for (int item = blockIdx.x; item < 192; item += F.G) {
            const int l = item / 96, cg = item % 96, cl = tid & 63, ks = tid >> 6;
            const float* wm = FIN(IN_WMOD) + (size_t)l * 1024 * 6144 + cg * 64 + cl;
            float a0 = 0.f, a1 = 0.f, a2 = 0.f, a3 = 0.f, a4 = 0.f;
            for (int kb = ks * 128; kb < ks * 128 + 128; kb += 32) { float wv[32];
#pragma unroll
                for (int i = 0; i < 32; ++i) wv[i] = wm[(size_t)(kb + i) * 6144];
#pragma unroll
                for (int i = 0; i < 32; ++i) { const int k = kb + i; const float w = wv[i]; a0 += sc[k] * w; a1 += sc[1024 + k] * w; a2 += sc[2048 + k] * w; a3 += sc[3072 + k] * w; a4 += sc[4096 + k] * w; } }
            red[(ks * 5 + 0) * 64 + cl] = a0; red[(ks * 5 + 1) * 64 + cl] = a1; red[(ks * 5 + 2) * 64 + cl] = a2; red[(ks * 5 + 3) * 64 + cl] = a3; red[(ks * 5 + 4) * 64 + cl] = a4;
            __syncthreads();
            if (tid < 320) { const int s = tid >> 6; float sum = 0.f;
#pragma unroll
                for (int k2 = 0; k2 < 8; ++k2) sum += red[(k2 * 5 + s) * 64 + cl];
                ((float*)(F.ws + WS_MOD))[(size_t)(l * 5 + s) * 6144 + cg * 64 + cl] = sum + FIN(IN_BMOD)[l * 6144 + cg * 64 + cl]; }
            __syncthreads();
        }
    }
    if ((int)blockIdx.x == F.G - 1) {
        if (tid < 16) {
            double th = 1.0; for (int i = 0; i < tid; ++i) th *= 0.5623413251903491;
            const double t2 = th * th; double s = 1.0, c = 1.0;
            for (int n = 14; n >= 1; --n) { s = 1.0 - s * t2 / (double)((2 * n) * (2 * n + 1)); c = 1.0 - c * t2 / (double)((2 * n - 1) * (2 * n)); }
            s *= th;
            float* Rc = (float*)(F.ws + WS_TAB); float* Rs = Rc + 2048; float* Dc = Rs + 2048; float* Ds = Dc + 1024;
            double cp = 1.0, sp = 0.0;
            for (int p = 0; p < 128; ++p) { Rc[p * 16 + tid] = (float)cp; Rs[p * 16 + tid] = (float)sp;
                if ((tid & 1) == 0) { Dc[p * 8 + (tid >> 1)] = (float)cp; Ds[p * 8 + (tid >> 1)] = (float)sp; }
                const double cn = cp * c - sp * s, sn = sp * c + cp * s; cp = cn; sp = sn; }
        }
        if (tid >= 64 && tid < 66) { const int l = tid - 64; const float* dl = FIN(IN_DIFFLAM) + l * 128; float d1 = 0.f, d2 = 0.f;
            for (int i = 0; i < 32; ++i) { d1 += dl[i] * dl[32 + i]; d2 += dl[64 + i] * dl[96 + i]; }
            const float lam_init = (l == 0) ? 0.2f : 0.35550906759f;
            ((float*)(F.ws + WS_LAM))[l] = expf(d1) - expf(d2) + lam_init; }
    }
    for (int idx = F.vcu * 512 + tid; idx < 1024; idx += F.G * 512) ((float*)(F.ws + WS_LAM + 4096))[idx] = log1pf(expf(-FIN(IN_LRULAM)[idx])) * (-8.0f * LOG2E);
    for (int idx = F.vcu * 512 + tid; idx < 131072; idx += F.G * 512) { const int c = idx & 63, d = (idx >> 6) & 63, rest = idx >> 12;
        ((bf16*)(F.ws + WS_LRUW))[idx] = (bf16)f2bf(FIN(IN_GATEW)[(size_t)rest * 4096 + c * 64 + d]); }
    __syncthreads();
    LAS float* scr = (LAS float*)(F.lds + wid * 16384);
    const int gw = F.vcu * NWAVES + wid, NGW = F.G * NWAVES;
    constexpr int I_IN = 16 * 96, I_OUT = 16 * 32, I_F1 = 16 * 176, I_F2 = 44 * 32, I_L = I_IN + I_OUT + I_F1 + I_F2;
    for (int it = gw; it < 2 * I_L; it += NGW) {
        const int l = it / I_L; int r = it % I_L;
        if (r < I_IN) { p0_transpose_item<1>(FIN(IN_WIN) + (size_t)l * 1024 * 3072, 1024, 3072, (bf16*)(F.ws + WS_WIN + l * SZ_WIN), scr, r, lane); continue; } r -= I_IN;
        if (r < I_OUT) { p0_transpose_item<0>(FIN(IN_WOUT) + (size_t)l * 1024 * 1024, 1024, 1024, (bf16*)(F.ws + WS_WOUT + l * SZ_WOUT), scr, r, lane); continue; } r -= I_OUT;
        if (r < I_F1) { p0_transpose_item<2>(FIN(IN_WF1) + (size_t)l * 1024 * 5632, 1024, 5632, (bf16*)(F.ws + WS_WF1 + l * SZ_WF1), scr, r, lane); continue; } r -= I_F1;
        p0_transpose_item<0>(FIN(IN_WF2) + (size_t)l * 2816 * 1024, 2816, 1024, (bf16*)(F.ws + WS_WF2 + l * SZ_WF2), scr, r, lane);
    }
}

__device__ __forceinline__ void ld_row_f32(const float* row, int lane, f32x4 (&v)[4]) {
#pragma unroll
    for (int j = 0; j < 4; ++j) v[j] = *(const f32x4*)(row + 4 * lane + 256 * j);
}
__device__ __forceinline__ void ld_row_bf16(const bf16* row, int lane, f32x4 (&v)[4]) {
#pragma unroll
    for (int j = 0; j < 4; ++j) { const u32x2 w = *(const u32x2*)(row + 4 * lane + 256 * j); v[j] = (f32x4){bflo(w.x), bfhi(w.x), bflo(w.y), bfhi(w.y)}; }
}
__device__ __forceinline__ float row_rstd(const f32x4 (&v)[4]) {
    float s = 0.f;
#pragma unroll
    for (int j = 0; j < 4; ++j) s += (v[j].x * v[j].x + v[j].y * v[j].y) + (v[j].z * v[j].z + v[j].w * v[j].w);
    return 1.0f / sqrtf(wave_sum(s) * (1.0f / 1024.0f) + EPS);
}
__device__ __forceinline__ void st_modulated(bf16* orow, int lane, const f32x4 (&v)[4], float rstd, const float* g, const float* shift, const float* scale) {
#pragma unroll
    for (int j = 0; j < 4; ++j) { const int c = 4 * lane + 256 * j; const f32x4 gg = *(const f32x4*)(g + c), sh = *(const f32x4*)(shift + c), scl = *(const f32x4*)(scale + c);
        const f32x4 o = v[j] * rstd * gg * (scl + 1.0f) + sh;
        u32x2 w; w.x = pk2(o.x, o.y); w.y = pk2(o.z, o.w); *(u32x2*)(orow + c) = w; }
}
__device__ __forceinline__ const float* mod_ptr(Frame& F, int l, int m) { const int slot = (m < MLAT) ? (m >> 13) : 4; return (const float*)(F.ws + WS_MOD) + (size_t)(l * 5 + slot) * 6144; }
#define ROWCOL(j) (4 * lane + 256 * (j))
__device__ __forceinline__ float rstd_of(const f32x4 (&v)[4]) { return row_rstd(v); }
#define ROW_PIPE3(ma, mb, LD, BODY) do { const int n_ = (mb) - (ma); if (n_ > 0) { const int last_ = (mb) - 1; LD((ma), 0); LD(min((ma) + 1, last_), 1); const int T_ = n_ / 3; int r_ = (ma); \
        for (int t_ = 0; t_ < T_; ++t_, r_ += 3) { LD(min(r_ + 2, last_), 2); BODY(r_, 0); LD(min(r_ + 3, last_), 0); BODY(r_ + 1, 1); LD(min(r_ + 4, last_), 1); BODY(r_ + 2, 2); } \
        const int rem_ = n_ - 3 * T_; if (rem_ >= 1) { BODY(r_, 0); if (rem_ == 2) BODY(r_ + 1, 1); } } } while (0)
#define ROW_SEG_END(a, mhi_) (((a) < MLAT) ? min((mhi_), min(MLAT, (((a) >> 13) + 1) << 13)) : (mhi_))
__device__ __forceinline__ void p0b(Frame& F) {
    LAUNDER_IDS
    const int gw = F.vcu * NWAVES + wid, NGW = F.G * NWAVES, R = (MALL + NGW - 1) / NGW, m0 = gw * R, m1 = min(MALL, m0 + R);
    bf16* H = (bf16*)(F.ws + WS_B);
    f32x4 G[4], Sh[4], Sc[4], xb[3][4];
#pragma unroll
    for (int j = 0; j < 4; ++j) G[j] = *(const f32x4*)(FIN(IN_GPREMIX) + ROWCOL(j));
#define P0B_SRC(m) (((m) < MLAT) ? FIN(IN_X) + (size_t)(m) * DM : FIN(IN_CTX) + (size_t)((m) - MLAT) * DM)
#define P0B_LD(m, B) do { const float* s_ = P0B_SRC(m); _Pragma("unroll") for (int j_ = 0; j_ < 4; ++j_) xb[B][j_] = *(const f32x4*)(s_ + ROWCOL(j_)); } while (0)
#define P0B_BODY(m, B) do { const float rstd_ = row_rstd(xb[B]); \
        _Pragma("unroll") for (int j_ = 0; j_ < 4; ++j_) { const f32x4 o_ = xb[B][j_] * rstd_ * G[j_] * Sc[j_] + Sh[j_]; u32x2 w_; w_.x = pk2(o_.x, o_.y); w_.y = pk2(o_.z, o_.w); *(u32x2*)(H + (size_t)(m) * DM + ROWCOL(j_)) = w_; } } while (0)
    for (int a = m0; a < m1; ) { const int e = ROW_SEG_END(a, m1), slot = (a < MLAT) ? (a >> 13) : 4; const float* mp = (const float*)(F.ws + WS_MOD) + (size_t)slot * 6144;
#pragma unroll
        for (int j = 0; j < 4; ++j) { Sh[j] = *(const f32x4*)(mp + ROWCOL(j)); Sc[j] = *(const f32x4*)(mp + 1024 + ROWCOL(j)) + 1.0f; }
        ROW_PIPE3(a, e, P0B_LD, P0B_BODY); a = e; }
#undef P0B_SRC
#undef P0B_LD
#undef P0B_BODY
}
__device__ __forceinline__ f32x4 bf4(u32x2 w) { return (f32x4){bflo(w.x), bfhi(w.x), bflo(w.y), bfhi(w.y)}; }
template <bool F32SRC>
__device__ __forceinline__ void e2_rows(Frame& F, int l, int mlo, int mhi, int wg_rank, int wg_count) {
    LAUNDER_IDS
    const int gw = wg_rank * NWAVES + wid, NGW = wg_count * NWAVES, R = (mhi - mlo + NGW - 1) / NGW, m0 = mlo + gw * R, m1 = min(mhi, m0 + R);
    const bf16* Y = (const bf16*)(F.ws + WS_A); bf16* H2 = (bf16*)(F.ws + WS_B); bf16* XR = (bf16*)(F.ws + WS_XRES);
    f32x4 Gp[4], Gf[4], Gate[4], Sh[4], Sc[4], xf[3][4]; u32x2 xh[3][4], yb[3][4];
#pragma unroll
    for (int j = 0; j < 4; ++j) { Gp[j] = *(const f32x4*)(FIN(IN_GPOSTMIX) + l * 1024 + ROWCOL(j)); Gf[j] = *(const f32x4*)(FIN(IN_GPREFFN) + l * 1024 + ROWCOL(j)); }
#define E2_SRC(m) (((m) < MLAT) ? FIN(IN_X) + (size_t)(m) * DM : FIN(IN_CTX) + (size_t)((m) - MLAT) * DM)
#define E2_LD(m, B) do { if (F32SRC) { const float* s_ = E2_SRC(m); _Pragma("unroll") for (int j_ = 0; j_ < 4; ++j_) xf[B][j_] = *(const f32x4*)(s_ + ROWCOL(j_)); } \
        else { _Pragma("unroll") for (int j_ = 0; j_ < 4; ++j_) xh[B][j_] = *(const u32x2*)(XR + (size_t)(m) * DM + ROWCOL(j_)); } \
        _Pragma("unroll") for (int j_ = 0; j_ < 4; ++j_) yb[B][j_] = *(const u32x2*)(Y + (size_t)(m) * DM + ROWCOL(j_)); } while (0)
#define E2_BODY(m, B) do { f32x4 y_[4], x_[4]; \
        _Pragma("unroll") for (int j_ = 0; j_ < 4; ++j_) { y_[j_] = bf4(yb[B][j_]); x_[j_] = F32SRC ? xf[B][j_] : bf4(xh[B][j_]); } \
        const float rstd_ = row_rstd(y_); \
        _Pragma("unroll") for (int j_ = 0; j_ < 4; ++j_) { x_[j_] = x_[j_] + Gate[j_] * (y_[j_] * rstd_ * Gp[j_]); u32x2 w_; w_.x = pk2(x_[j_].x, x_[j_].y); w_.y = pk2(x_[j_].z, x_[j_].w); *(u32x2*)(XR + (size_t)(m) * DM + ROWCOL(j_)) = w_; } \
        const float rstd2_ = row_rstd(x_); \
        _Pragma("unroll") for (int j_ = 0; j_ < 4; ++j_) { const f32x4 o_ = x_[j_] * rstd2_ * Gf[j_] * Sc[j_] + Sh[j_]; u32x2 w_; w_.x = pk2(o_.x, o_.y); w_.y = pk2(o_.z, o_.w); *(u32x2*)(H2 + (size_t)(m) * DM + ROWCOL(j_)) = w_; } } while (0)
    for (int a = m0; a < m1; ) { const int e = ROW_SEG_END(a, m1), slot = (a < MLAT) ? (a >> 13) : 4; const float* mp = (const float*)(F.ws + WS_MOD) + (size_t)(l * 5 + slot) * 6144;
#pragma unroll
        for (int j = 0; j < 4; ++j) { Gate[j] = *(const f32x4*)(mp + 2048 + ROWCOL(j)); Sh[j] = *(const f32x4*)(mp + 3072 + ROWCOL(j)); Sc[j] = *(const f32x4*)(mp + 4096 + ROWCOL(j)) + 1.0f; }
        ROW_PIPE3(a, e, E2_LD, E2_BODY); a = e; }
#undef E2_SRC
#undef E2_LD
#undef E2_BODY
}
__device__ __forceinline__ void e2_phase(Frame& F, int l, int mlo, int mhi, int wg_rank, int wg_count) { if (l == 0) e2_rows<true>(F, l, mlo, mhi, wg_rank, wg_count); else e2_rows<false>(F, l, mlo, mhi, wg_rank, wg_count); }
template <bool LAST, bool PART2 = false>
__device__ __forceinline__ void e3_rows(Frame& F, int l, int mlo, int mhi, int wg_rank, int wg_count, const bf16* Y2 = nullptr) {
    LAUNDER_IDS
    const int gw = wg_rank * NWAVES + wid, NGW = wg_count * NWAVES, R = (mhi - mlo + NGW - 1) / NGW, m0 = mlo + gw * R, m1 = min(mhi, m0 + R);
    bf16* YB = (bf16*)(F.ws + WS_B); bf16* XR = (bf16*)(F.ws + WS_XRES);
    f32x4 Gp[4], Gn[4], Gate[4], Sh[4], Sc[4]; u32x2 xb[3][4], yb[3][4], y2[3][4];
#pragma unroll
    for (int j = 0; j < 4; ++j) { Gp[j] = *(const f32x4*)(FIN(IN_GPOSTFFN) + l * 1024 + ROWCOL(j)); Gn[j] = *(const f32x4*)(FIN(IN_GPREMIX) + 1024 + ROWCOL(j)); }
#define E3_LD(m, B) do { _Pragma("unroll") for (int j_ = 0; j_ < 4; ++j_) { xb[B][j_] = *(const u32x2*)(XR + (size_t)(m) * DM + ROWCOL(j_)); yb[B][j_] = *(const u32x2*)(YB + (size_t)(m) * DM + ROWCOL(j_)); \
        if (PART2) y2[B][j_] = *(const u32x2*)(Y2 + (size_t)(m) * DM + ROWCOL(j_)); } } while (0)
#define E3_BODY(m, B) do { f32x4 y_[4], x_[4]; \
        _Pragma("unroll") for (int j_ = 0; j_ < 4; ++j_) { y_[j_] = bf4(yb[B][j_]); if (PART2) y_[j_] = y_[j_] + bf4(y2[B][j_]); x_[j_] = bf4(xb[B][j_]); } \
        const float rstd_ = row_rstd(y_); \
        _Pragma("unroll") for (int j_ = 0; j_ < 4; ++j_) x_[j_] = x_[j_] + Gate[j_] * (y_[j_] * rstd_ * Gp[j_]); \
        if (!LAST) { \
            _Pragma("unroll") for (int j_ = 0; j_ < 4; ++j_) { u32x2 w_; w_.x = pk2(x_[j_].x, x_[j_].y); w_.y = pk2(x_[j_].z, x_[j_].w); *(u32x2*)(XR + (size_t)(m) * DM + ROWCOL(j_)) = w_; } \
            const float rstd2_ = row_rstd(x_); \
            _Pragma("unroll") for (int j_ = 0; j_ < 4; ++j_) { const f32x4 o_ = x_[j_] * rstd2_ * Gn[j_] * Sc[j_] + Sh[j_]; u32x2 w_; w_.x = pk2(o_.x, o_.y); w_.y = pk2(o_.z, o_.w); *(u32x2*)(YB + (size_t)(m) * DM + ROWCOL(j_)) = w_; } \
        } else { \
            _Pragma("unroll") for (int j_ = 0; j_ < 4; ++j_) *(f32x4*)(F.out + (size_t)(m) * DM + ROWCOL(j_)) = x_[j_]; \
        } } while (0)
    for (int a = m0; a < m1; ) { const int e = ROW_SEG_END(a, m1), slot = (a < MLAT) ? (a >> 13) : 4;
        const float* mp = (const float*)(F.ws + WS_MOD) + (size_t)(l * 5 + slot) * 6144; const float* mp1 = (const float*)(F.ws + WS_MOD) + (size_t)(5 + slot) * 6144;
#pragma unroll
        for (int j = 0; j < 4; ++j) { Gate[j] = *(const f32x4*)(mp + 5120 + ROWCOL(j)); if (!LAST) { Sh[j] = *(const f32x4*)(mp1 + ROWCOL(j)); Sc[j] = *(const f32x4*)(mp1 + 1024 + ROWCOL(j)) + 1.0f; } }
        ROW_PIPE3(a, e, E3_LD, E3_BODY); a = e; }
#undef E3_LD
#undef E3_BODY
}
__device__ __forceinline__ void e3_phase(Frame& F, int l, int mlo, int mhi, int wg_rank, int wg_count) { if (l == 0) e3_rows<false>(F, l, mlo, mhi, wg_rank, wg_count); else e3_rows<true>(F, l, mlo, mhi, wg_rank, wg_count); }
constexpr int ATT_KB = 0, ATT_VB = 16384, ATT_BIAS = 32768;
template <int MODE> __device__ __forceinline__ void attn_unit(Frame& F, int l, int b, int h, int blk) {
    constexpr bool DIFF = (MODE == 0 || MODE == 2), LAT = (MODE < 2);
    constexpr int SQ = DIFF ? 9 : 0, SK = DIFF ? 10 : 1, SV = DIFF ? 11 : 2, NMAP = DIFF ? 2 : 1, NDS = DIFF ? 2 : 4;
    LAUNDER_IDS
    const int r32 = lane & 31, hi = lane >> 5;
    const bf16* P = (const bf16*)(F.ws + WS_A); bf16* Y = (bf16*)(F.ws + WS_B);
    LAS unsigned char* lds = F.lds;
    const int qtok = (LAT ? blk * 256 : 0) + wid * 32 + r32;
    const size_t qprow = (size_t)b * NKEY + (LAT ? 256 : 0) + qtok;
    const size_t ygrow = LAT ? (size_t)b * SEQ + qtok : (size_t)MLAT + b * 256 + qtok;
    int nt, nwin = 0, kr0 = 0;
    if (MODE == 0) nt = 132;
    else if (MODE == 1) { const int R = blk * 4; kr0 = min(max(R - 4, 0), 120); const int krl = min(max(R + 3 - 4, 0), 120) + 7; nwin = krl - kr0 + 1; nt = nwin + 4; }
    else nt = 4;
    const int qrow = blk * 4 + (wid >> 1), qcol = 32 * (wid & 1) + r32;
    const int r0q = min(max(qrow - 4, 0), 120), csq = min(max(qcol - 8, 0), 48);
    const int srow = tid >> 3, sch = tid & 7;
    const int koff = srow * 128 + ((sch ^ ((srow >> 1) & 7)) << 4);
    const int voff = (sch >> 2) * 4096 + (srow >> 3) * 512 + (srow & 7) * 64 + (sch & 3) * 16;
    const bf16* kvbase = P + (size_t)srow * NIN + h * 64 + sch * 8;
#define TILE_PROW(j) ((size_t)b * NKEY + ((MODE == 1) ? (((j) < nwin) ? 256 + (kr0 + (j)) * 64 : 64 * ((j) - nwin)) : 64 * (j)))
    bf16x8 qr[4];
#pragma unroll
    for (int d0 = 0; d0 < 4; ++d0) qr[d0] = *(const bf16x8*)(P + qprow * NIN + SQ * 256 + h * 64 + d0 * 16 + hi * 8);
    if (MODE == 1) { LAS float* bl = (LAS float*)(lds + ATT_BIAS); const float* rp = FIN(IN_RPB) + (size_t)(l * 4 + h) * 465;
        for (int i = tid; i < 480; i += 512) { const int dr = i >> 5, dc = i & 31; bl[i] = (dc < 31) ? rp[dr * 31 + dc] * LOG2E : 0.f; } }
    f32x16 o[NMAP][2]; float mrun[NMAP], lrun[NMAP];
#pragma unroll
    for (int mp = 0; mp < NMAP; ++mp) { mrun[mp] = -1e30f; lrun[mp] = 0.f;
#pragma unroll
        for (int d0 = 0; d0 < 2; ++d0)
#pragma unroll
            for (int r = 0; r < 16; ++r) o[mp][d0][r] = 0.f; }
    { const bf16* src = kvbase + TILE_PROW(0) * NIN; const v4u kk = *(const v4u*)(src + SK * 256), vv = *(const v4u*)(src + SV * 256);
      *(LAS v4u*)(lds + ATT_KB + koff) = kk; *(LAS v4u*)(lds + ATT_VB + voff) = vv; }
    __syncthreads();
    const int kfo = r32 * 128, ksw = (r32 >> 1) & 7;
    const int vb = ((lane >> 4) & 1) * 32 + (lane & 3) * 8 + (4 * hi + ((lane & 15) >> 2)) * 64;
    for (int j = 0; j < nt; ++j) {
        const int cur = j & 1;
        v4u kn, vn;
        if (j + 1 < nt) { const bf16* src = kvbase + TILE_PROW(j + 1) * NIN; kn = *(const v4u*)(src + SK * 256); vn = *(const v4u*)(src + SV * 256); }
        bool act = true;
        if (MODE == 1) { if (j < nwin) { const int d = kr0 + j - r0q; act = (d >= 0 && d < 8); } }
        if (act) {
            const LAS unsigned char* kb = lds + ATT_KB + cur * 8192; const LAS unsigned char* vbp = lds + ATT_VB + cur * 8192 + vb;
            bf16x8 vf[4][2];
#pragma unroll
            for (int ks = 0; ks < 4; ++ks)
#pragma unroll
                for (int d0 = 0; d0 < 2; ++d0) vf[ks][d0] = mk8(vtr(vbp + d0 * 4096 + ks * 1024), vtr(vbp + d0 * 4096 + ks * 1024 + 512));
#pragma unroll
            for (int mp = 0; mp < NMAP; ++mp) {
                f32x16 c0, c1;
#pragma unroll
                for (int r = 0; r < 16; ++r) { c0[r] = 0.f; c1[r] = 0.f; }
#pragma unroll
                for (int ds = 0; ds < NDS; ++ds) { const int dstep = mp * 2 + ds; const int chunk = 2 * dstep + hi;
                    const LAS unsigned char* kp = kb + kfo + ((chunk ^ ksw) << 4);
                    const bf16x8 k0 = *(const LAS bf16x8*)kp, k1 = *(const LAS bf16x8*)(kp + 4096);
                    c0 = MFMA32(k0, qr[dstep], c0); c1 = MFMA32(k1, qr[dstep], c1); }
                if (MODE == 1) { if (j < nwin) { const LAS float* bl = (const LAS float*)(lds + ATT_BIAS) + (kr0 + j - qrow + 7) * 32;
#pragma unroll
                    for (int r = 0; r < 16; ++r) { const int kc0 = (r & 3) + 8 * (r >> 2) + 4 * hi, kc1 = kc0 + 32;
                        const float b0 = bl[(kc0 - qcol + 15) & 31], b1 = bl[(kc1 - qcol + 15) & 31];
                        c0[r] = ((unsigned)(kc0 - csq) < 16u) ? c0[r] + b0 : -1e30f; c1[r] = ((unsigned)(kc1 - csq) < 16u) ? c1[r] + b1 : -1e30f; } } }
                float rm = max3f(c0[0], c0[1], c1[0]), rm2 = max3f(c0[2], c0[3], c1[1]); rm = max3f(rm, c1[2], c1[3]);
#pragma unroll
                for (int r = 4; r < 16; r += 4) { rm = max3f(rm, c0[r], c0[r + 1]); rm2 = max3f(rm2, c0[r + 2], c0[r + 3]); rm = max3f(rm, c1[r], c1[r + 1]); rm2 = max3f(rm2, c1[r + 2], c1[r + 3]); }
                rm = swap_max(max2f(rm, rm2));
                if (__any(rm > mrun[mp] + 6.0f)) { const float mn = max2f(mrun[mp], rm), f = ex2(mrun[mp] - mn); mrun[mp] = mn; lrun[mp] *= f;
#pragma unroll
                    for (int r = 0; r < 16; ++r) { o[mp][0][r] *= f; o[mp][1][r] *= f; } }
                const float mm = mrun[mp]; float ps = 0.f;
#pragma unroll
                for (int r = 0; r < 16; ++r) { c0[r] = ex2(c0[r] - mm); c1[r] = ex2(c1[r] - mm); ps += c0[r] + c1[r]; }
                lrun[mp] += ps;
                const bf16x8 p0 = pack8(c0[0], c0[1], c0[2], c0[3], c0[4], c0[5], c0[6], c0[7]), p1 = pack8(c0[8], c0[9], c0[10], c0[11], c0[12], c0[13], c0[14], c0[15]);
                const bf16x8 p2 = pack8(c1[0], c1[1], c1[2], c1[3], c1[4], c1[5], c1[6], c1[7]), p3 = pack8(c1[8], c1[9], c1[10], c1[11], c1[12], c1[13], c1[14], c1[15]);
#pragma unroll
                for (int d0 = 0; d0 < 2; ++d0) { o[mp][d0] = MFMA32(vf[0][d0], p0, o[mp][d0]); o[mp][d0] = MFMA32(vf[1][d0], p1, o[mp][d0]); o[mp][d0] = MFMA32(vf[2][d0], p2, o[mp][d0]); o[mp][d0] = MFMA32(vf[3][d0], p3, o[mp][d0]); }
            }
        }
        if (j + 1 < nt) { *(LAS v4u*)(lds + ATT_KB + (cur ^ 1) * 8192 + koff) = kn; *(LAS v4u*)(lds + ATT_VB + (cur ^ 1) * 8192 + voff) = vn; }
        __syncthreads();
    }
#undef TILE_PROW
    if (DIFF) {
        const float lam = ((const float*)(F.ws + WS_LAM))[l]; const float omli = (l == 0) ? 0.8f : 0.64449093241f;
        const float i1 = 1.0f / swap_add(lrun[0]), i2 = lam / swap_add(lrun[NMAP - 1]);
        float ss = 0.f;
#pragma unroll
        for (int d0 = 0; d0 < 2; ++d0)
#pragma unroll
            for (int r = 0; r < 16; ++r) { const float y = o[0][d0][r] * i1 - o[NMAP - 1][d0][r] * i2; o[0][d0][r] = y; ss += y * y; }
        ss = swap_add(ss);
        const float rs = omli / sqrtf(ss * (1.0f / 64.0f) + EPS); const float* sg = FIN(IN_SUBLN) + l * 64;
#pragma unroll
        for (int d0 = 0; d0 < 2; ++d0)
#pragma unroll
            for (int rg = 0; rg < 4; ++rg) { const int dv = 32 * d0 + 8 * rg + 4 * hi; const f32x4 g4 = *(const f32x4*)(sg + dv);
                u32x2 w; w.x = pk2(o[0][d0][4 * rg] * rs * g4.x, o[0][d0][4 * rg + 1] * rs * g4.y); w.y = pk2(o[0][d0][4 * rg + 2] * rs * g4.z, o[0][d0][4 * rg + 3] * rs * g4.w);
                *(u32x2*)(Y + ygrow * DM + 768 + h * 64 + dv) = w; }
    } else {
        const float i1 = 1.0f / swap_add(lrun[0]);
#pragma unroll
        for (int d0 = 0; d0 < 2; ++d0)
#pragma unroll
            for (int rg = 0; rg < 4; ++rg) { const int dv = 32 * d0 + 8 * rg + 4 * hi;
                u32x2 w; w.x = pk2(o[0][d0][4 * rg] * i1, o[0][d0][4 * rg + 1] * i1); w.y = pk2(o[0][d0][4 * rg + 2] * i1, o[0][d0][4 * rg + 3] * i1);
                *(u32x2*)(Y + ygrow * DM + h * 64 + dv) = w; }
    }
}
#define SB() __builtin_amdgcn_sched_barrier(0)
constexpr int DF_KB = 0, DF_VB = 16384, DF_QB = 40960;
#define PSUM8(Y, B) (((f32x2_t){Y[B], Y[B + 1]} + (f32x2_t){Y[B + 2], Y[B + 3]}) + ((f32x2_t){Y[B + 4], Y[B + 5]} + (f32x2_t){Y[B + 6], Y[B + 7]}))
#ifndef DIFF_VAR
#define DIFF_VAR 0
#endif
template <int MP, bool HASPREV, int VAR>
__device__ __forceinline__ void diff_step(f32x16& X0, f32x16& X1, const f32x16& Y0, const f32x16& Y1, f32x16 (&o)[2][2], float (&mrun)[2], float (&lrun)[2], bool (&trk)[2], bool first, const LAS unsigned char* qp,
                                          const LAS unsigned char* kp, int ksw, int hi, const LAS unsigned char* vp) {
    constexpr int OM = 1 - MP;
    const int ch0 = ((4 * MP + hi) ^ ksw) << 4, ch1 = ((4 * MP + 2 + hi) ^ ksw) << 4;
    const bf16x8 k00 = *(const LAS bf16x8*)(kp + ch0), k01 = *(const LAS bf16x8*)(kp + ch0 + 4096), k10 = *(const LAS bf16x8*)(kp + ch1), k11 = *(const LAS bf16x8*)(kp + ch1 + 4096);
    f32x16 z;
#pragma unroll
    for (int r = 0; r < 16; ++r) z[r] = 0.f;
    const bf16x8 q0 = *(const LAS bf16x8*)(qp + (2 * MP) * 1024), q1 = *(const LAS bf16x8*)(qp + (2 * MP + 1) * 1024);
    bf16x8 pw0, pw1, pw2, pw3; f32x2_t ps2 = {0.f, 0.f};
    if (VAR == 1) { pw0 = q0; pw1 = q1; pw2 = q0; pw3 = q1; }
    if (VAR != 2) X0 = MFMA32(k00, q0, z); else { asm volatile("" :: "v"(k00), "v"(k01), "v"(k10), "v"(k11), "v"(q0), "v"(q1));
#pragma unroll
        for (int r = 0; r < 16; ++r) { X0[r] = 0.5f; X1[r] = 0.5f; } asm volatile("" : "+v"(X0), "+v"(X1)); }
    if (HASPREV && VAR != 1) { ps2 += PSUM8(Y0, 0); pw0 = pack8(Y0[0], Y0[1], Y0[2], Y0[3], Y0[4], Y0[5], Y0[6], Y0[7]); }
    SB();
    if (VAR != 2) X1 = MFMA32(k01, q0, z);
    if (HASPREV && VAR != 1) { ps2 += PSUM8(Y0, 8); pw1 = pack8(Y0[8], Y0[9], Y0[10], Y0[11], Y0[12], Y0[13], Y0[14], Y0[15]); }
    SB();
    if (VAR != 2) X0 = MFMA32(k10, q1, X0);
    if (HASPREV && VAR != 1) { ps2 += PSUM8(Y1, 0); pw2 = pack8(Y1[0], Y1[1], Y1[2], Y1[3], Y1[4], Y1[5], Y1[6], Y1[7]); }
    SB();
    if (VAR != 2) X1 = MFMA32(k11, q1, X1);
    if (VAR == 1) asm volatile("" :: "v"(X0), "v"(X1));
    if (HASPREV && VAR != 1) { ps2 += PSUM8(Y1, 8); pw3 = pack8(Y1[8], Y1[9], Y1[10], Y1[11], Y1[12], Y1[13], Y1[14], Y1[15]); lrun[OM] += ps2.x + ps2.y; }
    SB();
    if (!HASPREV) asm volatile("s_nop 15\n\ts_nop 7" : "+v"(X0), "+v"(X1));
    bf16x8 va0, va1, vb0, vb1;
    if (HASPREV) { va0 = mk8(vtr(vp), vtr(vp + 512)); va1 = mk8(vtr(vp + 4096), vtr(vp + 4096 + 512)); vb0 = mk8(vtr(vp + 1024), vtr(vp + 1024 + 512)); vb1 = mk8(vtr(vp + 4096 + 1024), vtr(vp + 4096 + 1024 + 512)); }
    float ra = 0.f, rb = 0.f;
    if (HASPREV) { if (VAR != 2) o[OM][0] = MFMA32(va0, pw0, o[OM][0]); else asm volatile("" :: "v"(va0)); }
    if (VAR != 1) { ra = max3f(X0[0], X0[1], X0[2]); rb = max3f(X0[3], X0[4], X0[5]); ra = max3f(ra, X0[6], X0[7]); rb = max3f(rb, X0[8], X0[9]); ra = max3f(ra, X0[10], X0[11]); }
    SB();
    if (HASPREV) { { if (VAR != 2) o[OM][1] = MFMA32(va1, pw0, o[OM][1]); else asm volatile("" :: "v"(va1)); } va0 = mk8(vtr(vp + 2048), vtr(vp + 2048 + 512)); va1 = mk8(vtr(vp + 4096 + 2048), vtr(vp + 4096 + 2048 + 512)); }
    if (VAR != 1) { rb = max3f(rb, X0[12], X0[13]); ra = max3f(ra, X0[14], X0[15]); rb = max3f(rb, X1[0], X1[1]); ra = max3f(ra, X1[2], X1[3]); rb = max3f(rb, X1[4], X1[5]); }
    SB();
    if (HASPREV) { if (VAR != 2) o[OM][0] = MFMA32(vb0, pw1, o[OM][0]); else asm volatile("" :: "v"(vb0)); }
    if (VAR != 1) { ra = max3f(ra, X1[6], X1[7]); rb = max3f(rb, X1[8], X1[9]); ra = max3f(ra, X1[10], X1[11]); rb = max3f(rb, X1[12], X1[13]); ra = max3f(ra, X1[14], X1[15]); }
    float rm = (VAR != 1) ? swap_max(max2f(ra, rb)) : 0.f;
    SB();
    if (HASPREV) { { if (VAR != 2) o[OM][1] = MFMA32(vb1, pw1, o[OM][1]); else asm volatile("" :: "v"(vb1)); } vb0 = mk8(vtr(vp + 3072), vtr(vp + 3072 + 512)); vb1 = mk8(vtr(vp + 4096 + 3072), vtr(vp + 4096 + 3072 + 512)); }
    { bool resc; if (!trk[MP]) resc = __any(rm > 30.0f) || (first && __any(rm < -30.0f)); else resc = __any(rm > mrun[MP] + 6.0f);
      if (resc) { const float mn = first ? rm : max2f(mrun[MP], rm), f = ex2(mrun[MP] - mn); mrun[MP] = mn; lrun[MP] *= f; trk[MP] = true;
#pragma unroll
          for (int r = 0; r < 16; ++r) { o[MP][0][r] *= f; o[MP][1][r] *= f; } } }
    if (trk[MP]) { const float mm = mrun[MP];
#pragma unroll
        for (int r = 0; r < 16; ++r) { X0[r] -= mm; X1[r] -= mm; } }
    SB();
    if (HASPREV) { if (VAR != 2) o[OM][0] = MFMA32(va0, pw2, o[OM][0]); else asm volatile("" :: "v"(va0)); }
#pragma unroll
    for (int r = 0; r < 8; ++r) { if (VAR != 1) X0[r] = ex2(X0[r]); }
    SB();
    if (HASPREV) { if (VAR != 2) o[OM][1] = MFMA32(va1, pw2, o[OM][1]); else asm volatile("" :: "v"(va1)); }
#pragma unroll
    for (int r = 8; r < 16; ++r) { if (VAR != 1) X0[r] = ex2(X0[r]); }
    SB();
    if (HASPREV) { if (VAR != 2) o[OM][0] = MFMA32(vb0, pw3, o[OM][0]); else asm volatile("" :: "v"(vb0)); }
#pragma unroll
    for (int r = 0; r < 8; ++r) { if (VAR != 1) X1[r] = ex2(X1[r]); }
    SB();
    if (HASPREV) { if (VAR != 2) o[OM][1] = MFMA32(vb1, pw3, o[OM][1]); else asm volatile("" :: "v"(vb1)); }
#pragma unroll
    for (int r = 8; r < 16; ++r) { if (VAR != 1) X1[r] = ex2(X1[r]); }
    SB();
}
template <int VAR> __device__ __forceinline__ void diff_unit(Frame& F, int l, int b, int h, int blk) {
    LAUNDER_IDS
    const int r32 = lane & 31, hi = lane >> 5;
    const bf16* P = (const bf16*)(F.ws + WS_A); bf16* Y = (bf16*)(F.ws + (VAR ? 390 * MiB : WS_B));
    LAS unsigned char* lds = F.lds;
    const int qtok = blk * 256 + wid * 32 + r32;
    const size_t qprow = (size_t)b * NKEY + 256 + qtok, ygrow = (size_t)b * SEQ + qtok;
    const int srow = tid >> 3, sch = tid & 7;
    const int koff = srow * 128 + ((sch ^ ((srow >> 1) & 7)) << 4);
    const int voff = (sch >> 2) * 4096 + (srow >> 3) * 512 + (srow & 7) * 64 + (sch & 3) * 16;
    const bf16* kvbase = P + ((size_t)b * NKEY + srow) * NIN + h * 64 + sch * 8;
    LAS unsigned char* qp = lds + DF_QB + wid * 4096 + lane * 16;
#pragma unroll
    for (int d0 = 0; d0 < 4; ++d0) *(LAS bf16x8*)(qp + d0 * 1024) = *(const bf16x8*)(P + qprow * NIN + 9 * 256 + h * 64 + d0 * 16 + hi * 8);
    f32x16 o[2][2]; float mrun[2] = {0.f, 0.f}, lrun[2] = {0.f, 0.f}; bool trk[2] = {false, false};
#pragma unroll
    for (int mp = 0; mp < 2; ++mp)
#pragma unroll
        for (int d0 = 0; d0 < 2; ++d0)
#pragma unroll
            for (int r = 0; r < 16; ++r) o[mp][d0][r] = 0.f;
    { const v4u kk = *(const v4u*)(kvbase + 10 * 256), vv = *(const v4u*)(kvbase + 11 * 256);
      *(LAS v4u*)(lds + DF_KB + koff) = kk; *(LAS v4u*)(lds + DF_VB + voff) = vv; }
    __syncthreads();
    const int ksw = (r32 >> 1) & 7;
    const int vb = ((lane >> 4) & 1) * 32 + (lane & 3) * 8 + (4 * hi + ((lane & 15) >> 2)) * 64;
    const LAS unsigned char* kp0 = lds + DF_KB + r32 * 128; const LAS unsigned char* vp0 = lds + DF_VB + vb;
    f32x16 A0, A1, B0, B1;
    int vs_prev = 0, vs_cur = 0, vs_next = 8192;
    diff_step<0, false, VAR>(A0, A1, A0, A1, o, mrun, lrun, trk, true, qp, kp0, ksw, hi, vp0);
    for (int j = 0; j < 132; ++j) {
        v4u kn, vn;
        if (j + 1 < 132) { const bf16* src = kvbase + (size_t)(64 * (j + 1)) * NIN; kn = *(const v4u*)(src + 10 * 256); vn = *(const v4u*)(src + 11 * 256); }
        const LAS unsigned char* kp = kp0 + (j & 1) * 8192;
        if (j > 0) diff_step<0, true, VAR>(A0, A1, B0, B1, o, mrun, lrun, trk, false, qp, kp, ksw, hi, vp0 + vs_prev);
        diff_step<1, true, VAR>(B0, B1, A0, A1, o, mrun, lrun, trk, j == 0, qp, kp, ksw, hi, vp0 + vs_cur);
        if (j + 1 < 132) { *(LAS v4u*)(lds + DF_KB + ((j + 1) & 1) * 8192 + koff) = kn; *(LAS v4u*)(lds + DF_VB + vs_next + voff) = vn; }
        __syncthreads();
        vs_prev = vs_cur; vs_cur = vs_next; vs_next = (vs_next == 16384) ? 0 : vs_next + 8192;
    }
    { const LAS unsigned char* vp = vp0 + vs_prev;
      float ps = 0.f;
#pragma unroll
      for (int r = 0; r < 16; ++r) ps += B0[r] + B1[r];
      lrun[1] += ps;
      const bf16x8 p0 = pack8(B0[0], B0[1], B0[2], B0[3], B0[4], B0[5], B0[6], B0[7]), p1 = pack8(B0[8], B0[9], B0[10], B0[11], B0[12], B0[13], B0[14], B0[15]);
      const bf16x8 p2 = pack8(B1[0], B1[1], B1[2], B1[3], B1[4], B1[5], B1[6], B1[7]), p3 = pack8(B1[8], B1[9], B1[10], B1[11], B1[12], B1[13], B1[14], B1[15]);
#pragma unroll
      for (int d0 = 0; d0 < 2; ++d0) {
          o[1][d0] = MFMA32(mk8(vtr(vp + d0 * 4096), vtr(vp + d0 * 4096 + 512)), p0, o[1][d0]);
          o[1][d0] = MFMA32(mk8(vtr(vp + d0 * 4096 + 1024), vtr(vp + d0 * 4096 + 1024 + 512)), p1, o[1][d0]);
          o[1][d0] = MFMA32(mk8(vtr(vp + d0 * 4096 + 2048), vtr(vp + d0 * 4096 + 2048 + 512)), p2, o[1][d0]);
          o[1][d0] = MFMA32(mk8(vtr(vp + d0 * 4096 + 3072), vtr(vp + d0 * 4096 + 3072 + 512)), p3, o[1][d0]); } }
    __syncthreads();
    { const float lam = ((const float*)(F.ws + WS_LAM))[l]; const float omli = (l == 0) ? 0.8f : 0.64449093241f;
      const float i1 = 1.0f / swap_add(lrun[0]), i2 = lam / swap_add(lrun[1]);
      float ss = 0.f;
#pragma unroll
      for (int d0 = 0; d0 < 2; ++d0)
#pragma unroll
          for (int r = 0; r < 16; ++r) { const float y = o[0][d0][r] * i1 - o[1][d0][r] * i2; o[0][d0][r] = y; ss += y * y; }
      ss = swap_add(ss);
      const float rs = omli / sqrtf(ss * (1.0f / 64.0f) + EPS); const float* sg = FIN(IN_SUBLN) + l * 64;
#pragma unroll
      for (int d0 = 0; d0 < 2; ++d0)
#pragma unroll
          for (int rg = 0; rg < 4; ++rg) { const int dv = 32 * d0 + 8 * rg + 4 * hi; const f32x4 g4 = *(const f32x4*)(sg + dv);
              u32x2 w; w.x = pk2(o[0][d0][4 * rg] * rs * g4.x, o[0][d0][4 * rg + 1] * rs * g4.y); w.y = pk2(o[0][d0][4 * rg + 2] * rs * g4.z, o[0][d0][4 * rg + 3] * rs * g4.w);
              *(u32x2*)(Y + ygrow * DM + 768 + h * 64 + dv) = w; } }
}
template <int MP, bool HASPREV>
__device__ __forceinline__ void diff3_step(f32x16 (&o)[2][2], float (&mrun)[2], float (&lrun)[2], bool (&trk)[2], bool first, const LAS unsigned char* qp, bf16x8 (&qf)[2], bf16x8 (&kf)[4], bf16x8 (&pw)[4],
                                           const LAS unsigned char* vp  , const LAS unsigned char* knext  , int kc0, int kc1  ) {
    constexpr int OM = 1 - MP;
    f32x16 z;
#pragma unroll
    for (int r = 0; r < 16; ++r) z[r] = 0.f;
    f32x16 X0, X1;
    bf16x8 va0, va1, vb0, vb1;
    X0 = MFMA32(kf[0], qf[0], z);
    if (HASPREV) { va0 = mk8(vtr(vp), vtr(vp + 512)); va1 = mk8(vtr(vp + 4096), vtr(vp + 4096 + 512)); }
    SB();
    X1 = MFMA32(kf[1], qf[0], z);
    if (HASPREV) { vb0 = mk8(vtr(vp + 1024), vtr(vp + 1024 + 512)); vb1 = mk8(vtr(vp + 4096 + 1024), vtr(vp + 4096 + 1024 + 512)); }
    SB();
    X0 = MFMA32(kf[2], qf[1], X0);
    SB();
    X1 = MFMA32(kf[3], qf[1], X1);
    SB();
    if (!HASPREV) asm volatile("s_nop 15\n\ts_nop 7" : "+v"(X0), "+v"(X1));
    qf[0] = *(const LAS bf16x8*)(qp + (2 * OM) * 1024); qf[1] = *(const LAS bf16x8*)(qp + (2 * OM + 1) * 1024);
    if (knext) { kf[0] = *(const LAS bf16x8*)(knext + kc0); kf[1] = *(const LAS bf16x8*)(knext + kc0 + 4096); kf[2] = *(const LAS bf16x8*)(knext + kc1); kf[3] = *(const LAS bf16x8*)(knext + kc1 + 4096); }
    float ra, rb;
    if (HASPREV) o[OM][0] = MFMA32(va0, pw[0], o[OM][0]);
    ra = max3f(X0[0], X0[1], X0[2]); rb = max3f(X0[3], X0[4], X0[5]); ra = max3f(ra, X0[6], X0[7]); rb = max3f(rb, X0[8], X0[9]); ra = max3f(ra, X0[10], X0[11]);
    SB();
    if (HASPREV) { o[OM][1] = MFMA32(va1, pw[0], o[OM][1]); va0 = mk8(vtr(vp + 2048), vtr(vp + 2048 + 512)); va1 = mk8(vtr(vp + 4096 + 2048), vtr(vp + 4096 + 2048 + 512)); }
    rb = max3f(rb, X0[12], X0[13]); ra = max3f(ra, X0[14], X0[15]); rb = max3f(rb, X1[0], X1[1]); ra = max3f(ra, X1[2], X1[3]); rb = max3f(rb, X1[4], X1[5]);
    SB();
    if (HASPREV) o[OM][0] = MFMA32(vb0, pw[1], o[OM][0]);
    ra = max3f(ra, X1[6], X1[7]); rb = max3f(rb, X1[8], X1[9]); ra = max3f(ra, X1[10], X1[11]); rb = max3f(rb, X1[12], X1[13]); ra = max3f(ra, X1[14], X1[15]);
    const float rm = swap_max(max2f(ra, rb));
    SB();
    if (HASPREV) { o[OM][1] = MFMA32(vb1, pw[1], o[OM][1]); vb0 = mk8(vtr(vp + 3072), vtr(vp + 3072 + 512)); vb1 = mk8(vtr(vp + 4096 + 3072), vtr(vp + 4096 + 3072 + 512)); }
    { bool resc; if (!trk[MP]) resc = __any(rm > 30.0f) || (first && __any(rm < -30.0f)); else resc = __any(rm > mrun[MP] + 6.0f);
      if (resc) { const float mn = first ? rm : max2f(mrun[MP], rm), f = ex2(mrun[MP] - mn); mrun[MP] = mn; lrun[MP] *= f; trk[MP] = true;
#pragma unroll
          for (int r = 0; r < 16; ++r) { o[MP][0][r] *= f; o[MP][1][r] *= f; } } }
    if (trk[MP]) { const float mm = mrun[MP];
#pragma unroll
        for (int r = 0; r < 16; ++r) { X0[r] -= mm; X1[r] -= mm; } }
    f32x2_t ps2 = {0.f, 0.f}; bf16x8 n0, n1, n2, n3;
    SB();
    if (HASPREV) o[OM][0] = MFMA32(va0, pw[2], o[OM][0]);
#pragma unroll
    for (int r = 0; r < 8; ++r) X0[r] = ex2(X0[r]);
    ps2 += PSUM8(X0, 0); n0 = pack8(X0[0], X0[1], X0[2], X0[3], X0[4], X0[5], X0[6], X0[7]);
    SB();
    if (HASPREV) o[OM][1] = MFMA32(va1, pw[2], o[OM][1]);
#pragma unroll
    for (int r = 8; r < 16; ++r) X0[r] = ex2(X0[r]);
    ps2 += PSUM8(X0, 8); n1 = pack8(X0[8], X0[9], X0[10], X0[11], X0[12], X0[13], X0[14], X0[15]);
    SB();
    if (HASPREV) o[OM][0] = MFMA32(vb0, pw[3], o[OM][0]);
#pragma unroll
    for (int r = 0; r < 8; ++r) X1[r] = ex2(X1[r]);
    ps2 += PSUM8(X1, 0); n2 = pack8(X1[0], X1[1], X1[2], X1[3], X1[4], X1[5], X1[6], X1[7]);
    SB();
    if (HASPREV) o[OM][1] = MFMA32(vb1, pw[3], o[OM][1]);
#pragma unroll
    for (int r = 8; r < 16; ++r) X1[r] = ex2(X1[r]);
    ps2 += PSUM8(X1, 8); n3 = pack8(X1[8], X1[9], X1[10], X1[11], X1[12], X1[13], X1[14], X1[15]);
    lrun[MP] += ps2.x + ps2.y;
    SB();
    pw[0] = n0; pw[1] = n1; pw[2] = n2; pw[3] = n3;
}
__device__ __forceinline__ void diff3_unit(Frame& F, int l, int b, int h, int blk) {
    LAUNDER_IDS
    const int r32 = lane & 31, hi = lane >> 5;
    const bf16* P = (const bf16*)(F.ws + WS_A); bf16* Y = (bf16*)(F.ws + WS_B);
    LAS unsigned char* lds = F.lds;
    const int qtok = blk * 256 + wid * 32 + r32;
    const size_t qprow = (size_t)b * NKEY + 256 + qtok;
    const int krow = tid >> 3, kch = (tid & 7) ^ ((krow >> 1) & 7);
    const int vrow = 8 * ((tid & 255) >> 5) + (((tid & 255) >> 2) & 7), vch = 4 * (tid >> 8) + (tid & 3);
    const unsigned kofs = (unsigned)((krow * NIN + 10 * 256 + h * 64 + kch * 8) * 2), vofs = (unsigned)((vrow * NIN + 11 * 256 + h * 64 + vch * 8) * 2);
    const char* pbase = (const char*)(P + (size_t)b * NKEY * NIN);
    const int dmaw = wid * 1024;
#define DF_DMA(tile, kbuf_off, vslot_off) do { \
        const char* tb_ = pbase + (size_t)(tile) * (64 * NIN * 2); \
        __builtin_amdgcn_global_load_lds((const unsigned*)(tb_ + kofs), (LAS unsigned*)(lds + DF_KB + (kbuf_off) + dmaw), 16, 0, 0); \
        __builtin_amdgcn_global_load_lds((const unsigned*)(tb_ + vofs), (LAS unsigned*)(lds + DF_VB + (vslot_off) + dmaw), 16, 0, 0); } while (0)
    LAS unsigned char* qp = lds + DF_QB + wid * 4096 + lane * 16;
#pragma unroll
    for (int d0 = 0; d0 < 4; ++d0) *(LAS bf16x8*)(qp + d0 * 1024) = *(const bf16x8*)(P + qprow * NIN + 9 * 256 + h * 64 + d0 * 16 + hi * 8);
    f32x16 o[2][2]; float mrun[2] = {0.f, 0.f}, lrun[2] = {0.f, 0.f}; bool trk[2] = {false, false};
#pragma unroll
    for (int mp = 0; mp < 2; ++mp)
#pragma unroll
        for (int d0 = 0; d0 < 2; ++d0)
#pragma unroll
            for (int r = 0; r < 16; ++r) o[mp][d0][r] = 0.f;
    DF_DMA(0, 0, 0);
    __syncthreads();
    DF_DMA(1, 8192, 8192);
    const int ksw = (r32 >> 1) & 7;
    const int kcA0 = (hi ^ ksw) << 4;
#define kcA1 (kcA0 ^ 32)
#define kcB0 (kcA0 ^ 64)
#define kcB1 (kcA0 ^ 96)
    const int vb = ((lane >> 4) & 1) * 32 + (lane & 3) * 8 + (4 * hi + ((lane & 15) >> 2)) * 64;
    const LAS unsigned char* kp0 = lds + DF_KB + r32 * 128; const LAS unsigned char* vp0 = lds + DF_VB + vb;
    bf16x8 kf[4], pw[4], qf[2];
    qf[0] = *(const LAS bf16x8*)(qp); qf[1] = *(const LAS bf16x8*)(qp + 1024);
    kf[0] = *(const LAS bf16x8*)(kp0 + kcA0); kf[1] = *(const LAS bf16x8*)(kp0 + kcA0 + 4096); kf[2] = *(const LAS bf16x8*)(kp0 + kcA1); kf[3] = *(const LAS bf16x8*)(kp0 + kcA1 + 4096);
#pragma unroll
    for (int i = 0; i < 4; ++i) pw[i] = kf[0];
    int vs_prev = 16384, vs_cur = 0, vs_next = 8192;
    for (int j = 0; j < 132; ++j) {
        const LAS unsigned char* kp = kp0 + (j & 1) * 8192;
        if (j > 0) diff3_step<0, true>(o, mrun, lrun, trk, false, qp, qf, kf, pw, vp0 + vs_prev, kp, kcB0, kcB1);
        else diff3_step<0, false>(o, mrun, lrun, trk, true, qp, qf, kf, pw, vp0, kp, kcB0, kcB1);
        __syncthreads();
        if (j + 2 < 132) DF_DMA(j + 2, (j & 1) * 8192, vs_prev);
        diff3_step<1, true>(o, mrun, lrun, trk, j == 0, qp, qf, kf, pw, vp0 + vs_cur, (j + 1 < 132) ? kp0 + ((j + 1) & 1) * 8192 : (const LAS unsigned char*)nullptr, kcA0, kcA1);
        vs_prev = vs_cur; vs_cur = vs_next; vs_next = (vs_next == 16384) ? 0 : vs_next + 8192;
    }
    { const LAS unsigned char* vp = vp0 + vs_prev;
#pragma unroll
      for (int d0 = 0; d0 < 2; ++d0) {
          o[1][d0] = MFMA32(mk8(vtr(vp + d0 * 4096), vtr(vp + d0 * 4096 + 512)), pw[0], o[1][d0]);
          o[1][d0] = MFMA32(mk8(vtr(vp + d0 * 4096 + 1024), vtr(vp + d0 * 4096 + 1024 + 512)), pw[1], o[1][d0]);
          o[1][d0] = MFMA32(mk8(vtr(vp + d0 * 4096 + 2048), vtr(vp + d0 * 4096 + 2048 + 512)), pw[2], o[1][d0]);
          o[1][d0] = MFMA32(mk8(vtr(vp + d0 * 4096 + 3072), vtr(vp + d0 * 4096 + 3072 + 512)), pw[3], o[1][d0]); } }
    __syncthreads();
#undef DF_DMA
#undef kcA1
#undef kcB0
#undef kcB1
    { int tid2 = F.tid; asm volatile("" : "+v"(tid2)); const size_t ygrow = (size_t)b * SEQ + blk * 256 + (tid2 >> 6) * 32 + (tid2 & 31);
      const float lam = ((const float*)(F.ws + WS_LAM))[l]; const float omli = (l == 0) ? 0.8f : 0.64449093241f;
      const float i1 = 1.0f / swap_add(lrun[0]), i2 = lam / swap_add(lrun[1]);
      float ss = 0.f;
#pragma unroll
      for (int d0 = 0; d0 < 2; ++d0)
#pragma unroll
          for (int r = 0; r < 16; ++r) { const float y = o[0][d0][r] * i1 - o[1][d0][r] * i2; o[0][d0][r] = y; ss += y * y; }
      ss = swap_add(ss);
      const float rs = omli / sqrtf(ss * (1.0f / 64.0f) + EPS); const float* sg = FIN(IN_SUBLN) + l * 64;
#pragma unroll
      for (int d0 = 0; d0 < 2; ++d0)
#pragma unroll
          for (int rg = 0; rg < 4; ++rg) { const int dv = 32 * d0 + 8 * rg + 4 * hi; const f32x4 g4 = *(const f32x4*)(sg + dv);
              u32x2 w; w.x = pk2(o[0][d0][4 * rg] * rs * g4.x, o[0][d0][4 * rg + 1] * rs * g4.y); w.y = pk2(o[0][d0][4 * rg + 2] * rs * g4.z, o[0][d0][4 * rg + 3] * rs * g4.w);
              *(u32x2*)(Y + ygrow * DM + 768 + h * 64 + dv) = w; } }
}
#ifndef D5_PROF
#define D5_PROF 0
#endif
#ifndef D5_PROF_WAVE
#define D5_PROF_WAVE 0
#endif
#ifndef D5_PROF_SEL
#define D5_PROF_SEL 0
#endif
constexpr int D5_KB = 0, D5_VB = 32768, D5_EX = 0;
__device__ __forceinline__ void diff5_unit(Frame& F, int l, int b, int h, int blk) {
    LAUNDER_IDS
    const int r32 = lane & 31, hi = lane >> 5, mp = wid & 1, qg = wid >> 1;
    const bf16* P = (const bf16*)(F.ws + WS_A); bf16* Y = (bf16*)(F.ws + WS_B);
    LAS unsigned char* lds = F.lds;
    const int qtok0 = blk * 256 + qg * 64 + r32;
    const int krow = tid >> 3, kch = (tid & 7) ^ ((krow >> 1) & 7);
    const int vrow = 8 * ((tid & 255) >> 5) + (((tid & 255) >> 2) & 7), vch = 4 * (tid >> 8) + (tid & 3);
    const unsigned kofs = (unsigned)((krow * NIN + 10 * 256 + h * 64 + kch * 8) * 2), vofs = (unsigned)((vrow * NIN + 11 * 256 + h * 64 + vch * 8) * 2);
    const char* pbase = (const char*)(P + (size_t)b * NKEY * NIN);
    const int dmaw = wid * 1024;
#define D5_DMA(tile) do { const int sl_ = ((tile) & 3) * 8192; const char* tb_ = pbase + (size_t)(tile) * (64 * NIN * 2); \
        __builtin_amdgcn_global_load_lds((const unsigned*)(tb_ + kofs), (LAS unsigned*)(lds + D5_KB + sl_ + dmaw), 16, 0, 0); \
        __builtin_amdgcn_global_load_lds((const unsigned*)(tb_ + vofs), (LAS unsigned*)(lds + D5_VB + sl_ + dmaw), 16, 0, 0); } while (0)
#define D5_DMA2(tile, slot) do { const char* tb_ = pbase + (size_t)(tile) * (64 * NIN * 2); \
        __builtin_amdgcn_global_load_lds((const unsigned*)(tb_ + kofs), (LAS unsigned*)(lds + D5_KB + (slot) * 8192 + dmaw), 16, 0, 0); \
        __builtin_amdgcn_global_load_lds((const unsigned*)(tb_ + vofs), (LAS unsigned*)(lds + D5_VB + (slot) * 8192 + dmaw), 16, 0, 0); } while (0)
#define D5_BAR(N) do { asm volatile("s_waitcnt vmcnt(" #N ")" ::: "memory"); asm volatile("s_waitcnt lgkmcnt(0)" ::: "memory"); __builtin_amdgcn_s_barrier(); asm volatile("" ::: "memory"); } while (0)
    bf16x8 q[2][2];
#pragma unroll
    for (int s = 0; s < 2; ++s)
#pragma unroll
        for (int d = 0; d < 2; ++d) q[s][d] = *(const bf16x8*)(P + ((size_t)b * NKEY + 256 + qtok0 + 32 * s) * NIN + 9 * 256 + h * 64 + (2 * mp + d) * 16 + hi * 8);
    f32x16 o[2][2]; float mrun[2] = {0.f, 0.f}, lrun[2] = {0.f, 0.f}; bool trk[2] = {false, false};
#pragma unroll
    for (int s = 0; s < 2; ++s)
#pragma unroll
        for (int d0 = 0; d0 < 2; ++d0)
#pragma unroll
            for (int r = 0; r < 16; ++r) o[s][d0][r] = 0.f;
    D5_DMA(0); D5_DMA(1); D5_DMA(2);
    D5_BAR(4);
    const int ksw = (r32 >> 1) & 7;
    const int kc0 = ((4 * mp + hi) ^ ksw) << 4, kc1 = ((4 * mp + 2 + hi) ^ ksw) << 4;
    const int vb = ((lane >> 4) & 1) * 32 + (lane & 3) * 8 + (4 * hi + ((lane & 15) >> 2)) * 64;
    f32x16 z;
#pragma unroll
    for (int r = 0; r < 16; ++r) z[r] = 0.f;
#if D5_PROF
    unsigned long long tacc = 0; unsigned long long t0_ = __builtin_amdgcn_s_memtime();
#define tA 0
#define tB 1
#define tC 2
#define tD 3
#define D5_STAMP(seg) do { const unsigned long long tn_ = __builtin_amdgcn_s_memtime(); if ((seg) == D5_PROF_SEL || D5_PROF_SEL == 4) tacc += tn_ - t0_; t0_ = tn_; } while (0)
#else
#define D5_STAMP(acc) do {} while (0)
#endif
    for (int j4 = 0; j4 < 132; j4 += 4) {
#pragma unroll
        for (int jj = 0; jj < 4; ++jj) {
        const int j = j4 + jj; constexpr int dummy_ = 0; (void)dummy_; const int cur = jj;
        if (j + 3 < 132) D5_DMA2(j + 3, (jj + 3) & 3);
        const LAS unsigned char* kp = lds + D5_KB + cur * 8192 + r32 * 128; const LAS unsigned char* vp = lds + D5_VB + cur * 8192 + vb;
        const bf16x8 kf0 = *(const LAS bf16x8*)(kp + kc0), kf1 = *(const LAS bf16x8*)(kp + kc0 + 4096), kf2 = *(const LAS bf16x8*)(kp + kc1), kf3 = *(const LAS bf16x8*)(kp + kc1 + 4096);
        f32x16 X[2][2];
        asm volatile("s_setprio 1");
#pragma unroll
        for (int s = 0; s < 2; ++s) { X[s][0] = MFMA32(kf0, q[s][0], z); X[s][1] = MFMA32(kf1, q[s][0], z); }
#pragma unroll
        for (int s = 0; s < 2; ++s) { X[s][0] = MFMA32(kf2, q[s][1], X[s][0]); X[s][1] = MFMA32(kf3, q[s][1], X[s][1]); }
        asm volatile("s_setprio 0\n\ts_nop 15\n\ts_nop 7" : "+v"(X[0][0]), "+v"(X[0][1]), "+v"(X[1][0]), "+v"(X[1][1]));
        D5_STAMP(tA);
        bf16x8 pw[2][4];
#pragma unroll
        for (int s = 0; s < 2; ++s) {
            f32x16& X0 = X[s][0]; f32x16& X1 = X[s][1];
            float ra = max3f(X0[0], X0[1], X0[2]), rb = max3f(X0[3], X0[4], X0[5]);
            ra = max3f(ra, X0[6], X0[7]); rb = max3f(rb, X0[8], X0[9]); ra = max3f(ra, X0[10], X0[11]); rb = max3f(rb, X0[12], X0[13]); ra = max3f(ra, X0[14], X0[15]);
            rb = max3f(rb, X1[0], X1[1]); ra = max3f(ra, X1[2], X1[3]); rb = max3f(rb, X1[4], X1[5]); ra = max3f(ra, X1[6], X1[7]); rb = max3f(rb, X1[8], X1[9]);
            ra = max3f(ra, X1[10], X1[11]); rb = max3f(rb, X1[12], X1[13]); ra = max3f(ra, X1[14], X1[15]);
            const float rm = swap_max(max2f(ra, rb));
            { bool resc; if (!trk[s]) resc = __any(rm > 30.0f) || (j == 0 && __any(rm < -30.0f)); else resc = __any(rm > mrun[s] + 6.0f);
              if (resc) { const float mn = (j == 0) ? rm : max2f(mrun[s], rm), f = ex2(mrun[s] - mn); mrun[s] = mn; lrun[s] *= f; trk[s] = true;
#pragma unroll
                  for (int r = 0; r < 16; ++r) { o[s][0][r] *= f; o[s][1][r] *= f; } } }
            if (trk[s]) { const float mm = mrun[s];
#pragma unroll
                for (int r = 0; r < 16; ++r) { X0[r] -= mm; X1[r] -= mm; } }
#pragma unroll
            for (int r = 0; r < 16; ++r) { X0[r] = ex2(X0[r]); X1[r] = ex2(X1[r]); }
            f32x2_t ps2 = (PSUM8(X0, 0) + PSUM8(X0, 8)) + (PSUM8(X1, 0) + PSUM8(X1, 8));
            lrun[s] += ps2.x + ps2.y;
            pw[s][0] = pack8(X0[0], X0[1], X0[2], X0[3], X0[4], X0[5], X0[6], X0[7]); pw[s][1] = pack8(X0[8], X0[9], X0[10], X0[11], X0[12], X0[13], X0[14], X0[15]);
            pw[s][2] = pack8(X1[0], X1[1], X1[2], X1[3], X1[4], X1[5], X1[6], X1[7]); pw[s][3] = pack8(X1[8], X1[9], X1[10], X1[11], X1[12], X1[13], X1[14], X1[15]);
        }
        asm volatile("" :: "v"(pw[0][0]), "v"(pw[0][3]), "v"(pw[1][0]), "v"(pw[1][3])); D5_STAMP(tB);
        { const unsigned va = (unsigned)(__UINTPTR_TYPE__)(lds + vb);
#define D5_TR(dst, OFF) asm volatile("ds_read_b64_tr_b16 %0, %1 offset:%c2" : "=&v"(dst) : "v"(va), "i"(OFF) : "memory")
#define D5_VO(ks, d0) (D5_VB + cur * 8192 + (d0) * 4096 + (ks) * 1024)
          s16x4 a00l, a00h, a01l, a01h, a10l, a10h, a11l, a11h, b00l, b00h, b01l, b01h, b10l, b10h, b11l, b11h;
          D5_TR(a00l, D5_VO(0, 0)); D5_TR(a00h, D5_VO(0, 0) + 512); D5_TR(a01l, D5_VO(0, 1)); D5_TR(a01h, D5_VO(0, 1) + 512);
          D5_TR(a10l, D5_VO(1, 0)); D5_TR(a10h, D5_VO(1, 0) + 512); D5_TR(a11l, D5_VO(1, 1)); D5_TR(a11h, D5_VO(1, 1) + 512);
          asm volatile("s_waitcnt lgkmcnt(0)" ::: "memory"); SB();
          D5_TR(b00l, D5_VO(2, 0)); D5_TR(b00h, D5_VO(2, 0) + 512); D5_TR(b01l, D5_VO(2, 1)); D5_TR(b01h, D5_VO(2, 1) + 512);
          D5_TR(b10l, D5_VO(3, 0)); D5_TR(b10h, D5_VO(3, 0) + 512); D5_TR(b11l, D5_VO(3, 1)); D5_TR(b11h, D5_VO(3, 1) + 512);
          SB();
          __builtin_amdgcn_s_setprio(1);
          { const bf16x8 v00 = mk8(a00l, a00h), v01 = mk8(a01l, a01h), v10 = mk8(a10l, a10h), v11 = mk8(a11l, a11h);
            o[0][0] = MFMA32(v00, pw[0][0], o[0][0]); o[1][0] = MFMA32(v00, pw[1][0], o[1][0]); o[0][1] = MFMA32(v01, pw[0][0], o[0][1]); o[1][1] = MFMA32(v01, pw[1][0], o[1][1]);
            o[0][0] = MFMA32(v10, pw[0][1], o[0][0]); o[1][0] = MFMA32(v10, pw[1][1], o[1][0]); o[0][1] = MFMA32(v11, pw[0][1], o[0][1]); o[1][1] = MFMA32(v11, pw[1][1], o[1][1]); }
          SB();
          asm volatile("s_waitcnt lgkmcnt(0)" ::: "memory"); SB();
          { const bf16x8 v20 = mk8(b00l, b00h), v21 = mk8(b01l, b01h), v30 = mk8(b10l, b10h), v31 = mk8(b11l, b11h);
            o[0][0] = MFMA32(v20, pw[0][2], o[0][0]); o[1][0] = MFMA32(v20, pw[1][2], o[1][0]); o[0][1] = MFMA32(v21, pw[0][2], o[0][1]); o[1][1] = MFMA32(v21, pw[1][2], o[1][1]);
            o[0][0] = MFMA32(v30, pw[0][3], o[0][0]); o[1][0] = MFMA32(v30, pw[1][3], o[1][0]); o[0][1] = MFMA32(v31, pw[0][3], o[0][1]); o[1][1] = MFMA32(v31, pw[1][3], o[1][1]); }
          __builtin_amdgcn_s_setprio(0);
#undef D5_TR
#undef D5_VO
        }
        asm volatile("s_nop 15\n\ts_nop 7" : "+v"(o[0][0]), "+v"(o[0][1]), "+v"(o[1][0]), "+v"(o[1][1])); D5_STAMP(tC);
        if (j + 3 < 132) D5_BAR(4); else D5_BAR(0);
        D5_STAMP(tD);
        }
    }
#if D5_PROF
    if (blockIdx.x == 0 && wid == D5_PROF_WAVE && lane == 0) { unsigned long long* pr = (unsigned long long*)(F.ws + WS_CTL) + 8192; if (pr[7] == 0) { pr[0] = tacc; pr[7] = 1; } }
#endif
#undef D5_DMA
#undef D5_DMA2
#undef D5_BAR
    const float lam = ((const float*)(F.ws + WS_LAM))[l]; const float omli = (l == 0) ? 0.8f : 0.64449093241f;
    const float il0 = 1.0f / swap_add(lrun[0]), il1 = 1.0f / swap_add(lrun[1]);
    LAS float* ex = (LAS float*)(lds + D5_EX) + (qg * 2 + mp) * 2048 + lane;
    { const int sg = 1 - mp; const float sc = (mp == 0) ? il1 : lam * il0;
#pragma unroll
      for (int d0 = 0; d0 < 2; ++d0)
#pragma unroll
          for (int r = 0; r < 16; ++r) ex[(d0 * 16 + r) * 64] = ((sg == 0) ? o[0][d0][r] : o[1][d0][r]) * sc; }
    __syncthreads();
    { const LAS float* exr = (const LAS float*)(lds + D5_EX) + (qg * 2 + (1 - mp)) * 2048 + lane;
      const int sk = mp;
      const float own = (mp == 0) ? il0 : lam * il1;
      float y[2][16]; float ss = 0.f;
#pragma unroll
      for (int d0 = 0; d0 < 2; ++d0)
#pragma unroll
          for (int r = 0; r < 16; ++r) { const float a = ((sk == 0) ? o[0][d0][r] : o[1][d0][r]) * own, pv = exr[(d0 * 16 + r) * 64];
              const float v = (mp == 0) ? a - pv : pv - a; y[d0][r] = v; ss += v * v; }
      ss = swap_add(ss);
      const float rs = omli / sqrtf(ss * (1.0f / 64.0f) + EPS); const float* sg = FIN(IN_SUBLN) + l * 64;
      const size_t ygrow = (size_t)b * SEQ + qtok0 + 32 * sk;
#pragma unroll
      for (int d0 = 0; d0 < 2; ++d0)
#pragma unroll
          for (int rg = 0; rg < 4; ++rg) { const int dv = 32 * d0 + 8 * rg + 4 * hi; const f32x4 g4 = *(const f32x4*)(sg + dv);
              u32x2 w; w.x = pk2(y[d0][4 * rg] * rs * g4.x, y[d0][4 * rg + 1] * rs * g4.y); w.y = pk2(y[d0][4 * rg + 2] * rs * g4.z, y[d0][4 * rg + 3] * rs * g4.w);
              *(u32x2*)(Y + ygrow * DM + 768 + h * 64 + dv) = w; } }
    __syncthreads();
}
constexpr int D6_KB = 0, D6_VB = 32768, D6_EX = 0;
__device__ __forceinline__ void diff6_unit(Frame& F, int l, int b, int h, int blk) {
    LAUNDER_IDS
    const int r32 = lane & 31, hi = lane >> 5, mp = wid & 1, qg = wid >> 1;
    const bool late = wid >= 4;
    const bf16* P = (const bf16*)(F.ws + WS_A); bf16* Y = (bf16*)(F.ws + WS_B);
    LAS unsigned char* lds = F.lds;
    const int qtok0 = blk * 256 + qg * 64 + r32;
    const int krow = tid >> 3, kch = (tid & 7) ^ ((krow >> 1) & 7);
    const int vrow = 8 * ((tid & 255) >> 5) + (((tid & 255) >> 2) & 7), vch = 4 * (tid >> 8) + (tid & 3);
    const unsigned kofs = (unsigned)((krow * NIN + 10 * 256 + h * 64 + kch * 8) * 2), vofs = (unsigned)((vrow * NIN + 11 * 256 + h * 64 + vch * 8) * 2);
    const char* pbase = (const char*)(P + (size_t)b * NKEY * NIN);
    const int dmaw = wid * 1024;
#define D6_DMA2(tile, slot) do { const char* tb_ = pbase + (size_t)(tile) * (64 * NIN * 2); \
        __builtin_amdgcn_global_load_lds((const unsigned*)(tb_ + kofs), (LAS unsigned*)(lds + D6_KB + (slot) * 8192 + dmaw), 16, 0, 0); \
        __builtin_amdgcn_global_load_lds((const unsigned*)(tb_ + vofs), (LAS unsigned*)(lds + D6_VB + (slot) * 8192 + dmaw), 16, 0, 0); } while (0)
#define D6_BAR(N) do { asm volatile("s_waitcnt vmcnt(" #N ")" ::: "memory"); asm volatile("s_waitcnt lgkmcnt(0)" ::: "memory"); __builtin_amdgcn_s_barrier(); asm volatile("" ::: "memory"); } while (0)
#define D6_BAR0() do { asm volatile("" ::: "memory"); __builtin_amdgcn_s_barrier(); asm volatile("" ::: "memory"); } while (0)
    bf16x8 q[2][2];
#pragma unroll
    for (int s = 0; s < 2; ++s)
#pragma unroll
        for (int d = 0; d < 2; ++d) q[s][d] = *(const bf16x8*)(P + ((size_t)b * NKEY + 256 + qtok0 + 32 * s) * NIN + 9 * 256 + h * 64 + (2 * mp + d) * 16 + hi * 8);
    f32x16 o[2][2]; float mrun[2] = {0.f, 0.f}, lrun[2] = {0.f, 0.f}; bool trk[2] = {false, false};
#pragma unroll
    for (int s = 0; s < 2; ++s)
#pragma unroll
        for (int d0 = 0; d0 < 2; ++d0)
#pragma unroll
            for (int r = 0; r < 16; ++r) o[s][d0][r] = 0.f;
    D6_DMA2(0, 0); D6_DMA2(1, 1); D6_DMA2(2, 2);
    D6_BAR(2);
    const int ksw = (r32 >> 1) & 7;
    const int kc0 = ((4 * mp + hi) ^ ksw) << 4, kc1 = ((4 * mp + 2 + hi) ^ ksw) << 4;
    const int vb = ((lane >> 4) & 1) * 32 + (lane & 3) * 8 + (4 * hi + ((lane & 15) >> 2)) * 64;
    f32x16 z;
#pragma unroll
    for (int r = 0; r < 16; ++r) z[r] = 0.f;
    f32x16 X[2][2];
#define D6_QK(slot) do { const LAS unsigned char* kp = lds + D6_KB + (slot) * 8192 + r32 * 128; \
        const bf16x8 kf0 = *(const LAS bf16x8*)(kp + kc0), kf1 = *(const LAS bf16x8*)(kp + kc0 + 4096), kf2 = *(const LAS bf16x8*)(kp + kc1), kf3 = *(const LAS bf16x8*)(kp + kc1 + 4096); \
        _Pragma("unroll") for (int s = 0; s < 2; ++s) { X[s][0] = MFMA32(kf0, q[s][0], z); X[s][1] = MFMA32(kf1, q[s][0], z); } \
        _Pragma("unroll") for (int s = 0; s < 2; ++s) { X[s][0] = MFMA32(kf2, q[s][1], X[s][0]); X[s][1] = MFMA32(kf3, q[s][1], X[s][1]); } \
        asm volatile("s_nop 15\n\ts_nop 7" : "+v"(X[0][0]), "+v"(X[0][1]), "+v"(X[1][0]), "+v"(X[1][1])); } while (0)
    D6_QK(0);
    if (late) D6_BAR0();
#if D5_PROF
    const unsigned long long t6_0 = __builtin_amdgcn_s_memtime(); unsigned long long t6a = 0, t6acc = 0;
#define D6_T0(seg) do { if (D5_PROF_SEL == (seg)) t6a = __builtin_amdgcn_s_memtime(); } while (0)
#define D6_T1(seg) do { if (D5_PROF_SEL == (seg)) t6acc += __builtin_amdgcn_s_memtime() - t6a; } while (0)
#else
#define D6_T0(seg) do {} while (0)
#define D6_T1(seg) do {} while (0)
#endif
    for (int j4 = 0; j4 < 132; j4 += 4) {
#pragma unroll
        for (int jj = 0; jj < 4; ++jj) {
        const int j = j4 + jj; const int cur = jj;
        D6_T0(0);
        bf16x8 pw[2][4];
#pragma unroll
        for (int s = 0; s < 2; ++s) {
            f32x16& X0 = X[s][0]; f32x16& X1 = X[s][1];
            float ra = max3f(X0[0], X0[1], X0[2]), rb = max3f(X0[3], X0[4], X0[5]);
            ra = max3f(ra, X0[6], X0[7]); rb = max3f(rb, X0[8], X0[9]); ra = max3f(ra, X0[10], X0[11]); rb = max3f(rb, X0[12], X0[13]); ra = max3f(ra, X0[14], X0[15]);
            rb = max3f(rb, X1[0], X1[1]); ra = max3f(ra, X1[2], X1[3]); rb = max3f(rb, X1[4], X1[5]); ra = max3f(ra, X1[6], X1[7]); rb = max3f(rb, X1[8], X1[9]);
            ra = max3f(ra, X1[10], X1[11]); rb = max3f(rb, X1[12], X1[13]); ra = max3f(ra, X1[14], X1[15]);
            const float rm = swap_max(max2f(ra, rb));
            { bool resc; if (!trk[s]) resc = __any(rm > 30.0f) || (j == 0 && __any(rm < -30.0f)); else resc = __any(rm > mrun[s] + 6.0f);
              if (resc) { const float mn = (j == 0) ? rm : max2f(mrun[s], rm), f = ex2(mrun[s] - mn); mrun[s] = mn; lrun[s] *= f; trk[s] = true;
#pragma unroll
                  for (int r = 0; r < 16; ++r) { o[s][0][r] *= f; o[s][1][r] *= f; } } }
            if (trk[s]) { const float mm = mrun[s];
#pragma unroll
                for (int r = 0; r < 16; ++r) { X0[r] -= mm; X1[r] -= mm; } }
#pragma unroll
            for (int r = 0; r < 16; ++r) { X0[r] = ex2(X0[r]); X1[r] = ex2(X1[r]); }
            f32x2_t ps2 = (PSUM8(X0, 0) + PSUM8(X0, 8)) + (PSUM8(X1, 0) + PSUM8(X1, 8));
            lrun[s] += ps2.x + ps2.y;
            pw[s][0] = pack8(X0[0], X0[1], X0[2], X0[3], X0[4], X0[5], X0[6], X0[7]); pw[s][1] = pack8(X0[8], X0[9], X0[10], X0[11], X0[12], X0[13], X0[14], X0[15]);
            pw[s][2] = pack8(X1[0], X1[1], X1[2], X1[3], X1[4], X1[5], X1[6], X1[7]); pw[s][3] = pack8(X1[8], X1[9], X1[10], X1[11], X1[12], X1[13], X1[14], X1[15]);
        }
        asm volatile("" : "+v"(pw[0][0]), "+v"(pw[0][1]), "+v"(pw[0][2]), "+v"(pw[0][3]), "+v"(pw[1][0]), "+v"(pw[1][1]), "+v"(pw[1][2]), "+v"(pw[1][3]));
        D6_T1(0); D6_T0(1);
        SB(); D6_BAR0(); SB();
        D6_T1(1); D6_T0(2);
        if (j + 3 < 132) D6_DMA2(j + 3, (jj + 3) & 3);
        { const unsigned va = (unsigned)(__UINTPTR_TYPE__)(lds + vb);
#define D6_TR(dst, OFF) asm volatile("ds_read_b64_tr_b16 %0, %1 offset:%c2" : "=&v"(dst) : "v"(va), "i"(OFF) : "memory")
#define D6_VO(ks, d0) (D6_VB + cur * 8192 + (d0) * 4096 + (ks) * 1024)
          s16x4 a00l, a00h, a01l, a01h, a10l, a10h, a11l, a11h, b00l, b00h, b01l, b01h, b10l, b10h, b11l, b11h;
          D6_TR(a00l, D6_VO(0, 0)); D6_TR(a00h, D6_VO(0, 0) + 512); D6_TR(a01l, D6_VO(0, 1)); D6_TR(a01h, D6_VO(0, 1) + 512);
          D6_TR(a10l, D6_VO(1, 0)); D6_TR(a10h, D6_VO(1, 0) + 512); D6_TR(a11l, D6_VO(1, 1)); D6_TR(a11h, D6_VO(1, 1) + 512);
          asm volatile("s_waitcnt lgkmcnt(0)" ::: "memory"); SB();
          D6_TR(b00l, D6_VO(2, 0)); D6_TR(b00h, D6_VO(2, 0) + 512); D6_TR(b01l, D6_VO(2, 1)); D6_TR(b01h, D6_VO(2, 1) + 512);
          D6_TR(b10l, D6_VO(3, 0)); D6_TR(b10h, D6_VO(3, 0) + 512); D6_TR(b11l, D6_VO(3, 1)); D6_TR(b11h, D6_VO(3, 1) + 512);
          SB();
          { const bf16x8 v00 = mk8(a00l, a00h), v01 = mk8(a01l, a01h), v10 = mk8(a10l, a10h), v11 = mk8(a11l, a11h);
            o[0][0] = MFMA32(v00, pw[0][0], o[0][0]); o[1][0] = MFMA32(v00, pw[1][0], o[1][0]); o[0][1] = MFMA32(v01, pw[0][0], o[0][1]); o[1][1] = MFMA32(v01, pw[1][0], o[1][1]);
            o[0][0] = MFMA32(v10, pw[0][1], o[0][0]); o[1][0] = MFMA32(v10, pw[1][1], o[1][0]); o[0][1] = MFMA32(v11, pw[0][1], o[0][1]); o[1][1] = MFMA32(v11, pw[1][1], o[1][1]); }
          SB();
          asm volatile("s_waitcnt lgkmcnt(0)" ::: "memory"); SB();
          { const bf16x8 v20 = mk8(b00l, b00h), v21 = mk8(b01l, b01h), v30 = mk8(b10l, b10h), v31 = mk8(b11l, b11h);
            o[0][0] = MFMA32(v20, pw[0][2], o[0][0]); o[1][0] = MFMA32(v20, pw[1][2], o[1][0]); o[0][1] = MFMA32(v21, pw[0][2], o[0][1]); o[1][1] = MFMA32(v21, pw[1][2], o[1][1]);
            o[0][0] = MFMA32(v30, pw[0][3], o[0][0]); o[1][0] = MFMA32(v30, pw[1][3], o[1][0]); o[0][1] = MFMA32(v31, pw[0][3], o[0][1]); o[1][1] = MFMA32(v31, pw[1][3], o[1][1]); }
#undef D6_TR
#undef D6_VO
        }
        SB();
        D6_QK((jj + 1) & 3);
        asm volatile("" : "+v"(o[0][0]), "+v"(o[0][1]), "+v"(o[1][0]), "+v"(o[1][1]));
        SB();
        D6_T1(2); D6_T0(3);
        if (j + 3 < 132) D6_BAR(2); else D6_BAR(0);
        D6_T1(3);
        }
    }
    if (!late) D6_BAR0();
#if D5_PROF
    if (blockIdx.x == 0 && wid == D5_PROF_WAVE && lane == 0) { unsigned long long* pr = (unsigned long long*)(F.ws + WS_CTL) + 8192; if (pr[7] == 0) { pr[0] = (D5_PROF_SEL == 4) ? __builtin_amdgcn_s_memtime() - t6_0 : t6acc; pr[7] = 1; } }
#endif
#undef D6_DMA2
#undef D6_BAR
#undef D6_BAR0
#undef D6_QK
    const float lam = ((const float*)(F.ws + WS_LAM))[l]; const float omli = (l == 0) ? 0.8f : 0.64449093241f;
    const float il0 = 1.0f / swap_add(lrun[0]), il1 = 1.0f / swap_add(lrun[1]);
    LAS float* ex = (LAS float*)(lds + D6_EX) + (qg * 2 + mp) * 2048 + lane;
    { const int sg = 1 - mp; const float sc = (mp == 0) ? il1 : lam * il0;
#pragma unroll
      for (int d0 = 0; d0 < 2; ++d0)
#pragma unroll
          for (int r = 0; r < 16; ++r) ex[(d0 * 16 + r) * 64] = ((sg == 0) ? o[0][d0][r] : o[1][d0][r]) * sc; }
    __syncthreads();
    { const LAS float* exr = (const LAS float*)(lds + D6_EX) + (qg * 2 + (1 - mp)) * 2048 + lane;
      const int sk = mp;
      const float own = (mp == 0) ? il0 : lam * il1;
      float y[2][16]; float ss = 0.f;
#pragma unroll
      for (int d0 = 0; d0 < 2; ++d0)
#pragma unroll
          for (int r = 0; r < 16; ++r) { const float a = ((sk == 0) ? o[0][d0][r] : o[1][d0][r]) * own, pv = exr[(d0 * 16 + r) * 64];
              const float v = (mp == 0) ? a - pv : pv - a; y[d0][r] = v; ss += v * v; }
      ss = swap_add(ss);
      const float rs = omli / sqrtf(ss * (1.0f / 64.0f) + EPS); const float* sg = FIN(IN_SUBLN) + l * 64;
      const size_t ygrow = (size_t)b * SEQ + qtok0 + 32 * sk;
#pragma unroll
      for (int d0 = 0; d0 < 2; ++d0)
#pragma unroll
          for (int rg = 0; rg < 4; ++rg) { const int dv = 32 * d0 + 8 * rg + 4 * hi; const f32x4 g4 = *(const f32x4*)(sg + dv);
              u32x2 w; w.x = pk2(y[d0][4 * rg] * rs * g4.x, y[d0][4 * rg + 1] * rs * g4.y); w.y = pk2(y[d0][4 * rg + 2] * rs * g4.z, y[d0][4 * rg + 3] * rs * g4.w);
              *(u32x2*)(Y + ygrow * DM + 768 + h * 64 + dv) = w; } }
    __syncthreads();
}
#ifndef D7_VAR
#define D7_VAR 0
#endif
#ifndef D7_SPRIO
#define D7_SPRIO 1
#endif
#ifndef D7_YPRIO
#define D7_YPRIO 0
#endif
#ifndef D7_PRIO
#define D7_PRIO 0
#endif
constexpr int D7_KB = 0, D7_VB = 49152, D7_EX = 0;
constexpr int D7_FLAG = 98304;
template <bool FAST>
__device__ __forceinline__ bool diff7_unit(Frame& F, int l, int b, int h, int blk) {
    LAUNDER_IDS
    const int r32 = lane & 31, hi = lane >> 5, mp = wid & 1, qg = wid >> 1;
#ifndef D7_LATE_OLD
#define D7_LATE_OLD 0
#endif
    const bool late = D7_LATE_OLD ? (wid < 4) : (wid >= 4);
    const bf16* P = (const bf16*)(F.ws + WS_A); bf16* Y = (bf16*)(F.ws + WS_B);
    LAS unsigned char* lds = F.lds;
    const int qtok0 = blk * 256 + qg * 64 + r32;
    const int krow = tid >> 3, kch = (tid & 7) ^ ((krow >> 1) & 7);
    const int vrow = 8 * ((tid & 255) >> 5) + (((tid & 255) >> 2) & 7), vch = 4 * (tid >> 8) + (tid & 3);
    const unsigned kofs = (unsigned)((krow * NIN + 10 * 256 + h * 64 + kch * 8) * 2), vofs = (unsigned)((vrow * NIN + 11 * 256 + h * 64 + vch * 8) * 2);
    const char* pbase = (const char*)(P + (size_t)b * NKEY * NIN);
    const int dmaw = wid * 1024;
#define D7_DMA(tile, slot) do { const char* tb_ = pbase + (size_t)(tile) * (64 * NIN * 2); \
        __builtin_amdgcn_global_load_lds((const unsigned*)(tb_ + kofs), (LAS unsigned*)(lds + D7_KB + (slot) * 8192 + dmaw), 16, 0, 0); \
        __builtin_amdgcn_global_load_lds((const unsigned*)(tb_ + vofs), (LAS unsigned*)(lds + D7_VB + (slot) * 8192 + dmaw), 16, 0, 0); } while (0)
#define D7_TILE_BAR(bi, slot_m2) do { if ((bi) + 3 < 132) asm volatile("s_waitcnt vmcnt(4)" ::: "memory"); else asm volatile("s_waitcnt vmcnt(0)" ::: "memory"); \
        asm volatile("s_waitcnt lgkmcnt(0)" ::: "memory"); if (!(D7_VAR & 2)) __builtin_amdgcn_s_barrier(); asm volatile("" ::: "memory"); \
        if (!(D7_VAR & 1) && (bi) + 4 < 132) D7_DMA((bi) + 4, slot_m2); } while (0)
    bf16x8 q[2][2];
#pragma unroll
    for (int s = 0; s < 2; ++s)
#pragma unroll
        for (int d = 0; d < 2; ++d) q[s][d] = *(const bf16x8*)(P + ((size_t)b * NKEY + 256 + qtok0 + 32 * s) * NIN + 9 * 256 + h * 64 + (2 * mp + d) * 16 + hi * 8);
    f32x16 o[2][2]; float mrun[2] = {0.f, 0.f}, lrun[2] = {0.f, 0.f};
#pragma unroll
    for (int s = 0; s < 2; ++s)
#pragma unroll
        for (int d0 = 0; d0 < 2; ++d0)
#pragma unroll
            for (int r = 0; r < 16; ++r) o[s][d0][r] = 0.f;
    D7_DMA(0, 0); D7_DMA(1, 1); D7_DMA(2, 2); D7_DMA(3, 3);
    if (FAST && tid == 0) *(volatile LAS int*)(lds + D7_FLAG) = 0;
    asm volatile("s_waitcnt vmcnt(4) lgkmcnt(0)" ::: "memory"); __builtin_amdgcn_s_barrier(); asm volatile("" ::: "memory");
    D7_DMA(4, 4);
    const int ksw = (r32 >> 1) & 7;
    const unsigned lds0 = (unsigned)(__UINTPTR_TYPE__)lds;
    const unsigned ka0 = lds0 + D7_KB + r32 * 128 + (((4 * mp + hi) ^ ksw) << 4), ka1 = lds0 + D7_KB + r32 * 128 + (((4 * mp + 2 + hi) ^ ksw) << 4);
    const unsigned va0 = lds0 + D7_VB + ((lane >> 4) & 1) * 32 + (lane & 3) * 8 + (4 * hi + ((lane & 15) >> 2)) * 64;
    f32x16 z;
#pragma unroll
    for (int r = 0; r < 16; ++r) z[r] = 0.f;
    f32x16 X[2][2];
#define D7_R128(dst, addr, OFF) do { if (D7_VAR & 8) asm volatile("" : "=v"(dst)); else asm volatile("ds_read_b128 %0, %1 offset:%c2" : "=&v"(dst) : "v"(addr), "i"(OFF) : "memory"); } while (0)
#define D7_QK(slot) do { const unsigned k0_ = ka0 + (slot) * 8192, k1_ = ka1 + (slot) * 8192; bf16x8 kf0, kf1, kf2, kf3; \
        D7_R128(kf0, k0_, 0); D7_R128(kf1, k0_, 4096); D7_R128(kf2, k1_, 0); D7_R128(kf3, k1_, 4096); \
        asm volatile("s_waitcnt lgkmcnt(0)" ::: "memory"); SB(); \
        _Pragma("unroll") for (int s = 0; s < 2; ++s) { X[s][0] = MFMA32(kf0, q[s][0], z); X[s][1] = MFMA32(kf1, q[s][0], z); } \
        _Pragma("unroll") for (int s = 0; s < 2; ++s) { X[s][0] = MFMA32(kf2, q[s][1], X[s][0]); X[s][1] = MFMA32(kf3, q[s][1], X[s][1]); } \
        asm volatile("s_nop 15\n\ts_nop 7" : "+v"(X[0][0]), "+v"(X[0][1]), "+v"(X[1][0]), "+v"(X[1][1])); } while (0)
    D7_QK(0);
    int sj = 0;
#if D7_YPRIO == 2
    if (!late) asm volatile("s_setprio 1");
#elif D7_YPRIO
    if (late) asm volatile("s_setprio 1");
#endif
#if D5_PROF
    const unsigned long long t7_0 = __builtin_amdgcn_s_memtime(); unsigned long long t7a = 0, t7acc = 0;
#define D7_T0(seg) do { if (D5_PROF_SEL == (seg)) t7a = __builtin_amdgcn_s_memtime(); } while (0)
#define D7_T1(seg) do { if (D5_PROF_SEL == (seg)) t7acc += __builtin_amdgcn_s_memtime() - t7a; } while (0)
#else
#define D7_T0(seg) do {} while (0)
#define D7_T1(seg) do {} while (0)
#endif
#pragma unroll 1
    for (int j = 0; j < 132; ++j) {
        const int s1 = (sj == 5) ? 0 : sj + 1, sm1 = (sj == 0) ? 5 : sj - 1;
        bf16x8 pw[2][4];
#if D7_SPRIO
        asm volatile("s_setprio 1");
#endif
        if (j > 0) D7_T1(5);
        D7_T0(0);
#pragma unroll
        for (int s = 0; s < 2; ++s) {
            f32x16& X0 = X[s][0]; f32x16& X1 = X[s][1];
            if (!FAST) {
            float ra = max3f(X0[0], X0[1], X0[2]), rb = max3f(X0[3], X0[4], X0[5]);
            ra = max3f(ra, X0[6], X0[7]); rb = max3f(rb, X0[8], X0[9]); ra = max3f(ra, X0[10], X0[11]); rb = max3f(rb, X0[12], X0[13]); ra = max3f(ra, X0[14], X0[15]);
            rb = max3f(rb, X1[0], X1[1]); ra = max3f(ra, X1[2], X1[3]); rb = max3f(rb, X1[4], X1[5]); ra = max3f(ra, X1[6], X1[7]); rb = max3f(rb, X1[8], X1[9]);
            ra = max3f(ra, X1[10], X1[11]); rb = max3f(rb, X1[12], X1[13]); ra = max3f(ra, X1[14], X1[15]);
            const float rm = swap_max(max2f(ra, rb));
            if (j == 0) mrun[s] = rm;
            else if (__any(rm > mrun[s] + 6.0f)) { const float mn = max2f(mrun[s], rm), f = ex2(mrun[s] - mn); mrun[s] = mn; lrun[s] *= f;
#pragma unroll
                for (int r = 0; r < 16; ++r) { o[s][0][r] *= f; o[s][1][r] *= f; } }
            { const float mm = mrun[s];
#pragma unroll
              for (int r = 0; r < 16; ++r) { X0[r] -= mm; X1[r] -= mm; } }
            }
            f32x2_t ps2;
#pragma unroll
            for (int r = 0; r < 16; ++r) if (!(D7_VAR & 32)) X0[r] = ex2(X0[r]);
            if (D7_VAR & 4) ps2 = (f32x2_t){X0[0], X0[1]}; else ps2 = PSUM8(X0, 0) + PSUM8(X0, 8);
            pw[s][0] = pack8(X0[0], X0[1], X0[2], X0[3], X0[4], X0[5], X0[6], X0[7]); pw[s][1] = pack8(X0[8], X0[9], X0[10], X0[11], X0[12], X0[13], X0[14], X0[15]);
            asm volatile("" : "+v"(pw[s][0]), "+v"(pw[s][1]), "+v"(ps2)); SB();
#pragma unroll
            for (int r = 0; r < 16; ++r) if (!(D7_VAR & 32)) X1[r] = ex2(X1[r]);
            if (!(D7_VAR & 4)) ps2 += PSUM8(X1, 0) + PSUM8(X1, 8);
            lrun[s] += ps2.x + ps2.y;
            pw[s][2] = pack8(X1[0], X1[1], X1[2], X1[3], X1[4], X1[5], X1[6], X1[7]); pw[s][3] = pack8(X1[8], X1[9], X1[10], X1[11], X1[12], X1[13], X1[14], X1[15]);
            asm volatile("" : "+v"(pw[s][2]), "+v"(pw[s][3]), "+v"(lrun[s])); SB();
        }
        asm volatile("" : "+v"(pw[0][0]), "+v"(pw[0][1]), "+v"(pw[0][2]), "+v"(pw[0][3]), "+v"(pw[1][0]), "+v"(pw[1][1]), "+v"(pw[1][2]), "+v"(pw[1][3]));
#if D7_SPRIO
        asm volatile("s_setprio 0");
#endif
        SB();
        D7_T1(0); D7_T0(1);
        if (late) D7_TILE_BAR(j + 1, sm1);
        SB();
        D7_T1(1); D7_T0(2);
#if D7_PRIO
        asm volatile("s_setprio 1");
#endif
        { const unsigned va = va0 + sj * 8192;
#define D7_TR(dst, OFF) do { if (D7_VAR & 8) asm volatile("" : "=v"(dst)); else asm volatile("ds_read_b64_tr_b16 %0, %1 offset:%c2" : "=&v"(dst) : "v"(va), "i"(OFF) : "memory"); } while (0)
#define D7_VO(ks, d0) ((d0) * 4096 + (ks) * 1024)
          s16x4 a00l, a00h, a01l, a01h, a10l, a10h, a11l, a11h, b00l, b00h, b01l, b01h, b10l, b10h, b11l, b11h;
          D7_TR(a00l, D7_VO(0, 0)); D7_TR(a00h, D7_VO(0, 0) + 512); D7_TR(a01l, D7_VO(0, 1)); D7_TR(a01h, D7_VO(0, 1) + 512);
          D7_TR(a10l, D7_VO(1, 0)); D7_TR(a10h, D7_VO(1, 0) + 512); D7_TR(a11l, D7_VO(1, 1)); D7_TR(a11h, D7_VO(1, 1) + 512);
          asm volatile("s_waitcnt lgkmcnt(0)" ::: "memory"); SB();
          D7_TR(b00l, D7_VO(2, 0)); D7_TR(b00h, D7_VO(2, 0) + 512); D7_TR(b01l, D7_VO(2, 1)); D7_TR(b01h, D7_VO(2, 1) + 512);
          D7_TR(b10l, D7_VO(3, 0)); D7_TR(b10h, D7_VO(3, 0) + 512); D7_TR(b11l, D7_VO(3, 1)); D7_TR(b11h, D7_VO(3, 1) + 512);
          SB();
          { const bf16x8 v00 = mk8(a00l, a00h), v01 = mk8(a01l, a01h), v10 = mk8(a10l, a10h), v11 = mk8(a11l, a11h);
            o[0][0] = MFMA32(v00, pw[0][0], o[0][0]); o[1][0] = MFMA32(v00, pw[1][0], o[1][0]); o[0][1] = MFMA32(v01, pw[0][0], o[0][1]); o[1][1] = MFMA32(v01, pw[1][0], o[1][1]);
            o[0][0] = MFMA32(v10, pw[0][1], o[0][0]); o[1][0] = MFMA32(v10, pw[1][1], o[1][0]); o[0][1] = MFMA32(v11, pw[0][1], o[0][1]); o[1][1] = MFMA32(v11, pw[1][1], o[1][1]); }
          SB();
          asm volatile("s_waitcnt lgkmcnt(0)" ::: "memory"); SB();
          { const bf16x8 v20 = mk8(b00l, b00h), v21 = mk8(b01l, b01h), v30 = mk8(b10l, b10h), v31 = mk8(b11l, b11h);
            o[0][0] = MFMA32(v20, pw[0][2], o[0][0]); o[1][0] = MFMA32(v20, pw[1][2], o[1][0]); o[0][1] = MFMA32(v21, pw[0][2], o[0][1]); o[1][1] = MFMA32(v21, pw[1][2], o[1][1]);
            o[0][0] = MFMA32(v30, pw[0][3], o[0][0]); o[1][0] = MFMA32(v30, pw[1][3], o[1][0]); o[0][1] = MFMA32(v31, pw[0][3], o[0][1]); o[1][1] = MFMA32(v31, pw[1][3], o[1][1]); }
#undef D7_TR
#undef D7_VO
        }
        SB();
        D7_QK(s1);
        asm volatile("" : "+v"(o[0][0]), "+v"(o[0][1]), "+v"(o[1][0]), "+v"(o[1][1]));
#if D7_PRIO
        asm volatile("s_setprio 0");
#endif
        SB();
        D7_T1(2); D7_T0(3);
        if (!late) D7_TILE_BAR(j + 1, sm1);
        SB();
        D7_T1(3); D7_T0(5);
        sj = s1;
    }
#if D5_PROF
    if (FAST && blockIdx.x == 0 && wid == D5_PROF_WAVE && lane == 0) { unsigned long long* pr = (unsigned long long*)(F.ws + WS_CTL) + 8192; if (pr[7] == 0) { pr[0] = (D5_PROF_SEL == 4) ? __builtin_amdgcn_s_memtime() - t7_0 : t7acc; pr[7] = 1; } }
#endif
#if D7_YPRIO
    asm volatile("s_setprio 0");
#endif
    asm volatile("s_waitcnt vmcnt(0)" ::: "memory");
    __syncthreads();
#undef D7_DMA
#undef D7_TILE_BAR
#undef D7_QK
#undef D7_R128
    const float lam = ((const float*)(F.ws + WS_LAM))[l]; const float omli = (l == 0) ? 0.8f : 0.64449093241f;
    const float l0 = swap_add(lrun[0]), l1 = swap_add(lrun[1]);
    const float il0 = 1.0f / l0, il1 = 1.0f / l1;
    if (FAST) { bool bad = !(l0 > 7.9e-31f && l0 < 1.3e33f) || !(l1 > 7.9e-31f && l1 < 1.3e33f);
#ifdef D7_FORCE_REDO
        bad = bad || ((blk & 7) == 3 && wid == 5);
#endif
        if (__any(bad) && lane == 0) *(volatile LAS int*)(lds + D7_FLAG) = 1; }
    LAS float* ex = (LAS float*)(lds + D7_EX) + (qg * 2 + mp) * 2048 + lane;
    { const int sg = 1 - mp; const float sc = (mp == 0) ? il1 : lam * il0;
#pragma unroll
      for (int d0 = 0; d0 < 2; ++d0)
#pragma unroll
          for (int r = 0; r < 16; ++r) ex[(d0 * 16 + r) * 64] = ((sg == 0) ? o[0][d0][r] : o[1][d0][r]) * sc; }
    __syncthreads();
    const bool redo = FAST && (*(volatile LAS int*)(lds + D7_FLAG) != 0);
    { const LAS float* exr = (const LAS float*)(lds + D7_EX) + (qg * 2 + (1 - mp)) * 2048 + lane;
      const int sk = mp;
      const float own = (mp == 0) ? il0 : lam * il1;
      float y[2][16]; float ss = 0.f;
#pragma unroll
      for (int d0 = 0; d0 < 2; ++d0)
#pragma unroll
          for (int r = 0; r < 16; ++r) { const float a = ((sk == 0) ? o[0][d0][r] : o[1][d0][r]) * own, pv = exr[(d0 * 16 + r) * 64];
              const float v = (mp == 0) ? a - pv : pv - a; y[d0][r] = v; ss += v * v; }
      ss = swap_add(ss);
      const float rs = omli / sqrtf(ss * (1.0f / 64.0f) + EPS); const float* sg = FIN(IN_SUBLN) + l * 64;
      const size_t ygrow = (size_t)b * SEQ + qtok0 + 32 * sk;
#pragma unroll
      for (int d0 = 0; d0 < 2; ++d0)
#pragma unroll
          for (int rg = 0; rg < 4; ++rg) { const int dv = 32 * d0 + 8 * rg + 4 * hi; const f32x4 g4 = *(const f32x4*)(sg + dv);
              u32x2 w; w.x = pk2(y[d0][4 * rg] * rs * g4.x, y[d0][4 * rg + 1] * rs * g4.y); w.y = pk2(y[d0][4 * rg + 2] * rs * g4.z, y[d0][4 * rg + 3] * rs * g4.w);
              *(u32x2*)(Y + ygrow * DM + 768 + h * 64 + dv) = w; } }
    __syncthreads();
    return redo;
}
#define D8_VAR 0
#define D8_PRIO 0
constexpr int D8_KB = 0, D8_VB = 65536, D8_EX = 0;
constexpr int D8_FLAG = MISC_OFF + 128;
template <bool FAST>
__device__ __forceinline__ bool diff8_unit(Frame& F, int l, int b, int h, int blk) {
    LAUNDER_IDS
    const int r32 = lane & 31, hi = lane >> 5, mp = wid & 1, qg = wid >> 1;
    const bool late = wid >= 4;
    const bf16* P = (const bf16*)(F.ws + WS_A); bf16* Y = (bf16*)(F.ws + WS_B);
    LAS unsigned char* lds = F.lds;
    const int qtok0 = blk * 256 + qg * 64 + r32;
    const int krow = tid >> 3, kch = (tid & 7) ^ ((krow >> 1) & 7);
    const int vrow = 8 * ((tid & 255) >> 5) + (((tid & 255) >> 2) & 7), vch = 4 * (tid >> 8) + (tid & 3);
    const unsigned kofs = (unsigned)((krow * NIN + 10 * 256 + h * 64 + kch * 8) * 2), vofs = (unsigned)((vrow * NIN + 11 * 256 + h * 64 + vch * 8) * 2);
    const char* pbase = (const char*)(P + (size_t)b * NKEY * NIN);
    const int dmaw = wid * 1024;
#define D8_DMA(tile, slot) do { const char* tb_ = pbase + (size_t)(tile) * (64 * NIN * 2); \
        __builtin_amdgcn_global_load_lds((const unsigned*)(tb_ + kofs), (LAS unsigned*)(lds + D8_KB + (slot) * 8192 + dmaw), 16, 0, 0); \
        __builtin_amdgcn_global_load_lds((const unsigned*)(tb_ + vofs), (LAS unsigned*)(lds + D8_VB + (slot) * 8192 + dmaw), 16, 0, 0); } while (0)
#define D8_TILE_BAR(t0) do { asm volatile("s_waitcnt vmcnt(0) lgkmcnt(0)" ::: "memory"); __builtin_amdgcn_s_barrier(); asm volatile("" ::: "memory"); \
        if ((t0) < 132) D8_DMA((t0), (t0) & 7); if ((t0) + 1 < 132) D8_DMA((t0) + 1, ((t0) + 1) & 7); } while (0)
    bf16x8 q[2][2];
#pragma unroll
    for (int s = 0; s < 2; ++s)
#pragma unroll
        for (int d = 0; d < 2; ++d) q[s][d] = *(const bf16x8*)(P + ((size_t)b * NKEY + 256 + qtok0 + 32 * s) * NIN + 9 * 256 + h * 64 + (2 * mp + d) * 16 + hi * 8);
    f32x16 o[2][2]; float mrun[2] = {0.f, 0.f}, lrun[2] = {0.f, 0.f};
#pragma unroll
    for (int s = 0; s < 2; ++s)
#pragma unroll
        for (int d0 = 0; d0 < 2; ++d0)
#pragma unroll
            for (int r = 0; r < 16; ++r) o[s][d0][r] = 0.f;
    D8_DMA(0, 0); D8_DMA(1, 1); D8_DMA(2, 2);
    if (FAST && tid == 0) *(volatile LAS int*)(lds + D8_FLAG) = 0;
    asm volatile("s_waitcnt vmcnt(0) lgkmcnt(0)" ::: "memory"); __builtin_amdgcn_s_barrier(); asm volatile("" ::: "memory");
    D8_DMA(3, 3); D8_DMA(4, 4);
    const int ksw = (r32 >> 1) & 7;
    const unsigned lds0 = (unsigned)(__UINTPTR_TYPE__)lds;
    const unsigned ka0 = lds0 + D8_KB + r32 * 128 + (((4 * mp + hi) ^ ksw) << 4), ka1 = lds0 + D8_KB + r32 * 128 + (((4 * mp + 2 + hi) ^ ksw) << 4);
    const unsigned va0 = lds0 + D8_VB + ((lane >> 4) & 1) * 32 + (lane & 3) * 8 + (4 * hi + ((lane & 15) >> 2)) * 64;
    f32x16 z;
#pragma unroll
    for (int r = 0; r < 16; ++r) z[r] = 0.f;
    f32x16 X[2][2];
#define D8_R128(dst, addr, OFF) do { if (D8_VAR & 8) asm volatile("" : "=v"(dst)); else asm volatile("ds_read_b128 %0, %1 offset:%c2" : "=&v"(dst) : "v"(addr), "i"(OFF) : "memory"); } while (0)
#define D8_QK(slot) do { const unsigned k0_ = ka0 + (slot) * 8192, k1_ = ka1 + (slot) * 8192; bf16x8 kf0, kf1, kf2, kf3; \
        D8_R128(kf0, k0_, 0); D8_R128(kf1, k0_, 4096); D8_R128(kf2, k1_, 0); D8_R128(kf3, k1_, 4096); \
        asm volatile("s_waitcnt lgkmcnt(0)" ::: "memory"); SB(); \
        _Pragma("unroll") for (int s = 0; s < 2; ++s) { X[s][0] = MFMA32(kf0, q[s][0], z); X[s][1] = MFMA32(kf1, q[s][0], z); } \
        _Pragma("unroll") for (int s = 0; s < 2; ++s) { X[s][0] = MFMA32(kf2, q[s][1], X[s][0]); X[s][1] = MFMA32(kf3, q[s][1], X[s][1]); } \
        asm volatile("s_nop 15\n\ts_nop 7" : "+v"(X[0][0]), "+v"(X[0][1]), "+v"(X[1][0]), "+v"(X[1][1])); } while (0)
    D8_QK(0);
    int sj = 0;
#if D5_PROF
    const unsigned long long t7_0 = __builtin_amdgcn_s_memtime(); unsigned long long t7a = 0, t7acc = 0;
#define D8_T0(seg) do { if (D5_PROF_SEL == (seg)) t7a = __builtin_amdgcn_s_memtime(); } while (0)
#define D8_T1(seg) do { if (D5_PROF_SEL == (seg)) t7acc += __builtin_amdgcn_s_memtime() - t7a; } while (0)
#else
#define D8_T0(seg) do {} while (0)
#define D8_T1(seg) do {} while (0)
#endif
#pragma unroll 1
    for (int j = 0; j < 132; ++j) {
        const int s1 = (sj + 1) & 7;
        bf16x8 pw[2][4];
        if (j > 0) D8_T1(5);
        D8_T0(0);
#pragma unroll
        for (int s = 0; s < 2; ++s) {
            f32x16& X0 = X[s][0]; f32x16& X1 = X[s][1];
            if (!FAST) {
            float ra = max3f(X0[0], X0[1], X0[2]), rb = max3f(X0[3], X0[4], X0[5]);
            ra = max3f(ra, X0[6], X0[7]); rb = max3f(rb, X0[8], X0[9]); ra = max3f(ra, X0[10], X0[11]); rb = max3f(rb, X0[12], X0[13]); ra = max3f(ra, X0[14], X0[15]);
            rb = max3f(rb, X1[0], X1[1]); ra = max3f(ra, X1[2], X1[3]); rb = max3f(rb, X1[4], X1[5]); ra = max3f(ra, X1[6], X1[7]); rb = max3f(rb, X1[8], X1[9]);
            ra = max3f(ra, X1[10], X1[11]); rb = max3f(rb, X1[12], X1[13]); ra = max3f(ra, X1[14], X1[15]);
            const float rm = swap_max(max2f(ra, rb));
            if (j == 0) mrun[s] = rm;
            else if (__any(rm > mrun[s] + 6.0f)) { const float mn = max2f(mrun[s], rm), f = ex2(mrun[s] - mn); mrun[s] = mn; lrun[s] *= f;
#pragma unroll
                for (int r = 0; r < 16; ++r) { o[s][0][r] *= f; o[s][1][r] *= f; } }
            { const float mm = mrun[s];
#pragma unroll
              for (int r = 0; r < 16; ++r) { X0[r] -= mm; X1[r] -= mm; } }
            }
            f32x2_t ps2;
#pragma unroll
            for (int r = 0; r < 16; ++r) if (!(D8_VAR & 32)) X0[r] = ex2(X0[r]);
            if (D8_VAR & 4) ps2 = (f32x2_t){X0[0], X0[1]}; else ps2 = PSUM8(X0, 0) + PSUM8(X0, 8);
            pw[s][0] = pack8(X0[0], X0[1], X0[2], X0[3], X0[4], X0[5], X0[6], X0[7]); pw[s][1] = pack8(X0[8], X0[9], X0[10], X0[11], X0[12], X0[13], X0[14], X0[15]);
            asm volatile("" : "+v"(pw[s][0]), "+v"(pw[s][1]), "+v"(ps2)); SB();
#pragma unroll
            for (int r = 0; r < 16; ++r) if (!(D8_VAR & 32)) X1[r] = ex2(X1[r]);
            if (!(D8_VAR & 4)) ps2 += PSUM8(X1, 0) + PSUM8(X1, 8);
            lrun[s] += ps2.x + ps2.y;
            pw[s][2] = pack8(X1[0], X1[1], X1[2], X1[3], X1[4], X1[5], X1[6], X1[7]); pw[s][3] = pack8(X1[8], X1[9], X1[10], X1[11], X1[12], X1[13], X1[14], X1[15]);
            asm volatile("" : "+v"(pw[s][2]), "+v"(pw[s][3]), "+v"(lrun[s])); SB();
        }
        asm volatile("" : "+v"(pw[0][0]), "+v"(pw[0][1]), "+v"(pw[0][2]), "+v"(pw[0][3]), "+v"(pw[1][0]), "+v"(pw[1][1]), "+v"(pw[1][2]), "+v"(pw[1][3]));
        SB();
        D8_T1(0); D8_T0(1);
        if (late && !(j & 1)) D8_TILE_BAR(j + 5);
        SB();
        D8_T1(1); D8_T0(2);
#if D8_PRIO
        asm volatile("s_setprio 1");
#endif
        { const unsigned va = va0 + sj * 8192;
#define D8_TR(dst, OFF) do { if (D8_VAR & 8) asm volatile("" : "=v"(dst)); else asm volatile("ds_read_b64_tr_b16 %0, %1 offset:%c2" : "=&v"(dst) : "v"(va), "i"(OFF) : "memory"); } while (0)
#define D8_VO(ks, d0) ((d0) * 4096 + (ks) * 1024)
          s16x4 a00l, a00h, a01l, a01h, a10l, a10h, a11l, a11h, b00l, b00h, b01l, b01h, b10l, b10h, b11l, b11h;
          D8_TR(a00l, D8_VO(0, 0)); D8_TR(a00h, D8_VO(0, 0) + 512); D8_TR(a01l, D8_VO(0, 1)); D8_TR(a01h, D8_VO(0, 1) + 512);
          D8_TR(a10l, D8_VO(1, 0)); D8_TR(a10h, D8_VO(1, 0) + 512); D8_TR(a11l, D8_VO(1, 1)); D8_TR(a11h, D8_VO(1, 1) + 512);
          asm volatile("s_waitcnt lgkmcnt(0)" ::: "memory"); SB();
          D8_TR(b00l, D8_VO(2, 0)); D8_TR(b00h, D8_VO(2, 0) + 512); D8_TR(b01l, D8_VO(2, 1)); D8_TR(b01h, D8_VO(2, 1) + 512);
          D8_TR(b10l, D8_VO(3, 0)); D8_TR(b10h, D8_VO(3, 0) + 512); D8_TR(b11l, D8_VO(3, 1)); D8_TR(b11h, D8_VO(3, 1) + 512);
          SB();
          { const bf16x8 v00 = mk8(a00l, a00h), v01 = mk8(a01l, a01h), v10 = mk8(a10l, a10h), v11 = mk8(a11l, a11h);
            o[0][0] = MFMA32(v00, pw[0][0], o[0][0]); o[1][0] = MFMA32(v00, pw[1][0], o[1][0]); o[0][1] = MFMA32(v01, pw[0][0], o[0][1]); o[1][1] = MFMA32(v01, pw[1][0], o[1][1]);
            o[0][0] = MFMA32(v10, pw[0][1], o[0][0]); o[1][0] = MFMA32(v10, pw[1][1], o[1][0]); o[0][1] = MFMA32(v11, pw[0][1], o[0][1]); o[1][1] = MFMA32(v11, pw[1][1], o[1][1]); }
          SB();
          asm volatile("s_waitcnt lgkmcnt(0)" ::: "memory"); SB();
          { const bf16x8 v20 = mk8(b00l, b00h), v21 = mk8(b01l, b01h), v30 = mk8(b10l, b10h), v31 = mk8(b11l, b11h);
            o[0][0] = MFMA32(v20, pw[0][2], o[0][0]); o[1][0] = MFMA32(v20, pw[1][2], o[1][0]); o[0][1] = MFMA32(v21, pw[0][2], o[0][1]); o[1][1] = MFMA32(v21, pw[1][2], o[1][1]);
            o[0][0] = MFMA32(v30, pw[0][3], o[0][0]); o[1][0] = MFMA32(v30, pw[1][3], o[1][0]); o[0][1] = MFMA32(v31, pw[0][3], o[0][1]); o[1][1] = MFMA32(v31, pw[1][3], o[1][1]); }
#undef D8_TR
#undef D8_VO
        }
        SB();
        D8_QK(s1);
        asm volatile("" : "+v"(o[0][0]), "+v"(o[0][1]), "+v"(o[1][0]), "+v"(o[1][1]));
#if D8_PRIO
        asm volatile("s_setprio 0");
#endif
        SB();
        D8_T1(2); D8_T0(3);
        if (!late && (j & 1)) D8_TILE_BAR(j + 4);
        SB();
        D8_T1(3); D8_T0(5);
        sj = s1;
    }
#if D5_PROF
    if (FAST && blockIdx.x == 0 && wid == D5_PROF_WAVE && lane == 0) { unsigned long long* pr = (unsigned long long*)(F.ws + WS_CTL) + 8192; if (pr[7] == 0) { pr[0] = (D5_PROF_SEL == 4) ? __builtin_amdgcn_s_memtime() - t7_0 : t7acc; pr[7] = 1; } }
#endif
    asm volatile("s_waitcnt vmcnt(0)" ::: "memory");
    __syncthreads();
#undef D8_DMA
#undef D8_TILE_BAR
#undef D8_QK
#undef D8_R128
    const float lam = ((const float*)(F.ws + WS_LAM))[l]; const float omli = (l == 0) ? 0.8f : 0.64449093241f;
    const float l0 = swap_add(lrun[0]), l1 = swap_add(lrun[1]);
    const float il0 = 1.0f / l0, il1 = 1.0f / l1;
    if (FAST) { bool bad = !(l0 > 7.9e-31f && l0 < 1.3e33f) || !(l1 > 7.9e-31f && l1 < 1.3e33f);
#ifdef D8_FORCE_REDO
        bad = bad || ((blk & 7) == 3 && wid == 5);
#endif
        if (__any(bad) && lane == 0) *(volatile LAS int*)(lds + D8_FLAG) = 1; }
    LAS float* ex = (LAS float*)(lds + D8_EX) + (qg * 2 + mp) * 2048 + lane;
    { const int sg = 1 - mp; const float sc = (mp == 0) ? il1 : lam * il0;
#pragma unroll
      for (int d0 = 0; d0 < 2; ++d0)
#pragma unroll
          for (int r = 0; r < 16; ++r) ex[(d0 * 16 + r) * 64] = ((sg == 0) ? o[0][d0][r] : o[1][d0][r]) * sc; }
    __syncthreads();
    const bool redo = FAST && (*(volatile LAS int*)(lds + D8_FLAG) != 0);
    { const LAS float* exr = (const LAS float*)(lds + D8_EX) + (qg * 2 + (1 - mp)) * 2048 + lane;
      const int sk = mp;
      const float own = (mp == 0) ? il0 : lam * il1;
      float y[2][16]; float ss = 0.f;
#pragma unroll
      for (int d0 = 0; d0 < 2; ++d0)
#pragma unroll
          for (int r = 0; r < 16; ++r) { const float a = ((sk == 0) ? o[0][d0][r] : o[1][d0][r]) * own, pv = exr[(d0 * 16 + r) * 64];
              const float v = (mp == 0) ? a - pv : pv - a; y[d0][r] = v; ss += v * v; }
      ss = swap_add(ss);
      const float rs = omli / sqrtf(ss * (1.0f / 64.0f) + EPS); const float* sg = FIN(IN_SUBLN) + l * 64;
      const size_t ygrow = (size_t)b * SEQ + qtok0 + 32 * sk;
#pragma unroll
      for (int d0 = 0; d0 < 2; ++d0)
#pragma unroll
          for (int rg = 0; rg < 4; ++rg) { const int dv = 32 * d0 + 8 * rg + 4 * hi; const f32x4 g4 = *(const f32x4*)(sg + dv);
              u32x2 w; w.x = pk2(y[d0][4 * rg] * rs * g4.x, y[d0][4 * rg + 1] * rs * g4.y); w.y = pk2(y[d0][4 * rg + 2] * rs * g4.z, y[d0][4 * rg + 3] * rs * g4.w);
              *(u32x2*)(Y + ygrow * DM + 768 + h * 64 + dv) = w; } }
    __syncthreads();
    return redo;
}
#define D9_VAR 0
#define D9_PRIO 0
constexpr int D9_KB = 0, D9_VB = 49152, D9_EX = 0;
constexpr int D9_FLAG = 98304 + 64;
template <bool FAST>
__device__ __forceinline__ bool diff9_unit(Frame& F, int l, int b, int h, int blk) {
    LAUNDER_IDS
    const int r32 = lane & 31, hi = lane >> 5, mp = wid & 1, qg = wid >> 1;
    const bool late = wid >= 4;
    const bf16* P = (const bf16*)(F.ws + WS_A); bf16* Y = (bf16*)(F.ws + WS_B);
    LAS unsigned char* lds = F.lds;
    const int qtok0 = blk * 256 + qg * 64 + r32;
    const int krow = tid >> 3, kch = (tid & 7) ^ ((krow >> 1) & 7);
    const int vrow = 8 * ((tid & 255) >> 5) + (((tid & 255) >> 2) & 7), vch = 4 * (tid >> 8) + (tid & 3);
    const unsigned kofs = (unsigned)((krow * NIN + 10 * 256 + h * 64 + kch * 8) * 2), vofs = (unsigned)((vrow * NIN + 11 * 256 + h * 64 + vch * 8) * 2);
    const char* pbase = (const char*)(P + (size_t)b * NKEY * NIN);
    const int dmaw = wid * 1024;
#define D9_DMA(tile, slot) do { const char* tb_ = pbase + (size_t)(tile) * (64 * NIN * 2); \
        __builtin_amdgcn_global_load_lds((const unsigned*)(tb_ + kofs), (LAS unsigned*)(lds + D9_KB + (slot) * 8192 + dmaw), 16, 0, 0); \
        __builtin_amdgcn_global_load_lds((const unsigned*)(tb_ + vofs), (LAS unsigned*)(lds + D9_VB + (slot) * 8192 + dmaw), 16, 0, 0); } while (0)
#define D9_TILE_BAR(bi, slot_m2) do { if ((bi) + 3 < 132) asm volatile("s_waitcnt vmcnt(4)" ::: "memory"); else asm volatile("s_waitcnt vmcnt(0)" ::: "memory"); \
        asm volatile("s_waitcnt lgkmcnt(0)" ::: "memory"); if (!(D9_VAR & 2)) __builtin_amdgcn_s_barrier(); asm volatile("" ::: "memory"); \
        if (!(D9_VAR & 1) && (bi) + 4 < 132) D9_DMA((bi) + 4, slot_m2); } while (0)
    bf16x8 q[2][2];
#pragma unroll
    for (int s = 0; s < 2; ++s)
#pragma unroll
        for (int d = 0; d < 2; ++d) q[s][d] = *(const bf16x8*)(P + ((size_t)b * NKEY + 256 + qtok0 + 32 * s) * NIN + 9 * 256 + h * 64 + (2 * mp + d) * 16 + hi * 8);
    f32x16 o[2][2]; float mrun[2] = {0.f, 0.f}, lrun[2] = {0.f, 0.f};
#pragma unroll
    for (int s = 0; s < 2; ++s)
#pragma unroll
        for (int d0 = 0; d0 < 2; ++d0)
#pragma unroll
            for (int r = 0; r < 16; ++r) o[s][d0][r] = 0.f;
    D9_DMA(0, 0); D9_DMA(1, 1); D9_DMA(2, 2); D9_DMA(3, 3);
    if (FAST && tid == 0) *(volatile LAS int*)(lds + D9_FLAG) = 0;
    asm volatile("s_waitcnt vmcnt(4) lgkmcnt(0)" ::: "memory"); __builtin_amdgcn_s_barrier(); asm volatile("" ::: "memory");
    D9_DMA(4, 4);
    const int ksw = (r32 >> 1) & 7;
    const unsigned lds0 = (unsigned)(__UINTPTR_TYPE__)lds;
    const unsigned ka0 = lds0 + D9_KB + r32 * 128 + (((4 * mp + hi) ^ ksw) << 4), ka1 = lds0 + D9_KB + r32 * 128 + (((4 * mp + 2 + hi) ^ ksw) << 4);
    const unsigned va0 = lds0 + D9_VB + ((lane >> 4) & 1) * 32 + (lane & 3) * 8 + (4 * hi + ((lane & 15) >> 2)) * 64;
    f32x16 z;
#pragma unroll
    for (int r = 0; r < 16; ++r) z[r] = 0.f;
    f32x16 X[2][2];
#define D9_R128(dst, addr, OFF) do { if (D9_VAR & 8) asm volatile("" : "=v"(dst)); else asm volatile("ds_read_b128 %0, %1 offset:%c2" : "=&v"(dst) : "v"(addr), "i"(OFF) : "memory"); } while (0)
#define D9_QK(slot) do { const unsigned k0_ = ka0 + (slot) * 8192, k1_ = ka1 + (slot) * 8192; bf16x8 kf0, kf1, kf2, kf3; \
        D9_R128(kf0, k0_, 0); D9_R128(kf1, k0_, 4096); D9_R128(kf2, k1_, 0); D9_R128(kf3, k1_, 4096); \
        asm volatile("s_waitcnt lgkmcnt(0)" ::: "memory"); SB(); \
        _Pragma("unroll") for (int s = 0; s < 2; ++s) { X[s][0] = MFMA32(kf0, q[s][0], z); X[s][1] = MFMA32(kf1, q[s][0], z); } \
        _Pragma("unroll") for (int s = 0; s < 2; ++s) { X[s][0] = MFMA32(kf2, q[s][1], X[s][0]); X[s][1] = MFMA32(kf3, q[s][1], X[s][1]); } \
        asm volatile("s_nop 15\n\ts_nop 7" : "+v"(X[0][0]), "+v"(X[0][1]), "+v"(X[1][0]), "+v"(X[1][1])); } while (0)
    D9_QK(0);
    int sj = 0;
#if D5_PROF
    const unsigned long long t7_0 = __builtin_amdgcn_s_memtime(); unsigned long long t7a = 0, t7acc = 0;
#define D9_T0(seg) do { if (D5_PROF_SEL == (seg)) t7a = __builtin_amdgcn_s_memtime(); } while (0)
#define D9_T1(seg) do { if (D5_PROF_SEL == (seg)) t7acc += __builtin_amdgcn_s_memtime() - t7a; } while (0)
#else
#define D9_T0(seg) do {} while (0)
#define D9_T1(seg) do {} while (0)
#endif
#define D9_SOFTMAX(s) do { f32x16& X0 = X[s][0]; f32x16& X1 = X[s][1]; \
        if (!FAST) { \
            float ra = max3f(X0[0], X0[1], X0[2]), rb = max3f(X0[3], X0[4], X0[5]); \
            ra = max3f(ra, X0[6], X0[7]); rb = max3f(rb, X0[8], X0[9]); ra = max3f(ra, X0[10], X0[11]); rb = max3f(rb, X0[12], X0[13]); ra = max3f(ra, X0[14], X0[15]); \
            rb = max3f(rb, X1[0], X1[1]); ra = max3f(ra, X1[2], X1[3]); rb = max3f(rb, X1[4], X1[5]); ra = max3f(ra, X1[6], X1[7]); rb = max3f(rb, X1[8], X1[9]); \
            ra = max3f(ra, X1[10], X1[11]); rb = max3f(rb, X1[12], X1[13]); ra = max3f(ra, X1[14], X1[15]); \
            const float rm = swap_max(max2f(ra, rb)); \
            if (j == 0) mrun[s] = rm; \
            else if (__any(rm > mrun[s] + 6.0f)) { const float mn = max2f(mrun[s], rm), f = ex2(mrun[s] - mn); mrun[s] = mn; lrun[s] *= f; \
                _Pragma("unroll") for (int r = 0; r < 16; ++r) { o[s][0][r] *= f; o[s][1][r] *= f; } } \
            { const float mm = mrun[s]; _Pragma("unroll") for (int r = 0; r < 16; ++r) { X0[r] -= mm; X1[r] -= mm; } } \
        } \
        f32x2_t ps2; \
        _Pragma("unroll") for (int r = 0; r < 16; ++r) X0[r] = ex2(X0[r]); \
        ps2 = PSUM8(X0, 0) + PSUM8(X0, 8); \
        pw[0] = pack8(X0[0], X0[1], X0[2], X0[3], X0[4], X0[5], X0[6], X0[7]); pw[1] = pack8(X0[8], X0[9], X0[10], X0[11], X0[12], X0[13], X0[14], X0[15]); \
        asm volatile("" : "+v"(pw[0]), "+v"(pw[1]), "+v"(ps2)); SB(); \
        _Pragma("unroll") for (int r = 0; r < 16; ++r) X1[r] = ex2(X1[r]); \
        ps2 += PSUM8(X1, 0) + PSUM8(X1, 8); \
        lrun[s] += ps2.x + ps2.y; \
        pw[2] = pack8(X1[0], X1[1], X1[2], X1[3], X1[4], X1[5], X1[6], X1[7]); pw[3] = pack8(X1[8], X1[9], X1[10], X1[11], X1[12], X1[13], X1[14], X1[15]); \
        asm volatile("" : "+v"(pw[2]), "+v"(pw[3]), "+v"(lrun[s])); SB(); } while (0)
#define D9_TR(dst, OFF) asm volatile("ds_read_b64_tr_b16 %0, %1 offset:%c2" : "=&v"(dst) : "v"(va), "i"(OFF) : "memory")
#define D9_VO(ks, d0) ((d0) * 4096 + (ks) * 1024)
#define D9_LOADS() do { const unsigned va = va0 + sj * 8192, k0_ = ka0 + s1 * 8192, k1_ = ka1 + s1 * 8192; \
        D9_TR(a00l, D9_VO(0, 0)); D9_TR(a00h, D9_VO(0, 0) + 512); D9_TR(a01l, D9_VO(0, 1)); D9_TR(a01h, D9_VO(0, 1) + 512); \
        D9_TR(a10l, D9_VO(1, 0)); D9_TR(a10h, D9_VO(1, 0) + 512); D9_TR(a11l, D9_VO(1, 1)); D9_TR(a11h, D9_VO(1, 1) + 512); \
        D9_R128(kf0, k0_, 0); D9_R128(kf1, k0_, 4096); D9_R128(kf2, k1_, 0); D9_R128(kf3, k1_, 4096); \
        D9_TR(b00l, D9_VO(2, 0)); D9_TR(b00h, D9_VO(2, 0) + 512); D9_TR(b01l, D9_VO(2, 1)); D9_TR(b01h, D9_VO(2, 1) + 512); \
        D9_TR(b10l, D9_VO(3, 0)); D9_TR(b10h, D9_VO(3, 0) + 512); D9_TR(b11l, D9_VO(3, 1)); D9_TR(b11h, D9_VO(3, 1) + 512); \
        asm volatile("s_waitcnt lgkmcnt(0)" : "+v"(a00l), "+v"(a00h), "+v"(a01l), "+v"(a01h), "+v"(a10l), "+v"(a10h), "+v"(a11l), "+v"(a11h) :: "memory"); \
        asm volatile("" : "+v"(b00l), "+v"(b00h), "+v"(b01l), "+v"(b01h), "+v"(b10l), "+v"(b10h), "+v"(b11l), "+v"(b11h)); \
        asm volatile("" : "+v"(kf0), "+v"(kf1), "+v"(kf2), "+v"(kf3)); SB(); } while (0)
#define D9_BLOCK(s) do { \
        { const bf16x8 v00 = mk8(a00l, a00h), v01 = mk8(a01l, a01h), v10 = mk8(a10l, a10h), v11 = mk8(a11l, a11h); \
          o[s][0] = MFMA32(v00, pw[0], o[s][0]); o[s][1] = MFMA32(v01, pw[0], o[s][1]); X[s][0] = MFMA32(kf0, q[s][0], z); X[s][1] = MFMA32(kf1, q[s][0], z); \
          o[s][0] = MFMA32(v10, pw[1], o[s][0]); o[s][1] = MFMA32(v11, pw[1], o[s][1]); X[s][0] = MFMA32(kf2, q[s][1], X[s][0]); X[s][1] = MFMA32(kf3, q[s][1], X[s][1]); } \
        { const bf16x8 v20 = mk8(b00l, b00h), v21 = mk8(b01l, b01h), v30 = mk8(b10l, b10h), v31 = mk8(b11l, b11h); \
          o[s][0] = MFMA32(v20, pw[2], o[s][0]); o[s][1] = MFMA32(v21, pw[2], o[s][1]); o[s][0] = MFMA32(v30, pw[3], o[s][0]); o[s][1] = MFMA32(v31, pw[3], o[s][1]); } \
        asm volatile("" : "+v"(o[s][0]), "+v"(o[s][1]), "+v"(X[s][0]), "+v"(X[s][1])); SB(); } while (0)
#pragma unroll 1
    for (int j = 0; j < 132; ++j) {
        const int s1 = (sj == 5) ? 0 : sj + 1, sm1 = (sj == 0) ? 5 : sj - 1;
        bf16x8 pw[4];
        s16x4 a00l, a00h, a01l, a01h, a10l, a10h, a11l, a11h, b00l, b00h, b01l, b01h, b10l, b10h, b11l, b11h; bf16x8 kf0, kf1, kf2, kf3;
        D9_SOFTMAX(0);
        SB(); D9_LOADS(); D9_BLOCK(0); SB();
        if (late) D9_TILE_BAR(j + 1, sm1);
        SB();
        D9_SOFTMAX(1);
        SB(); D9_BLOCK(1); SB();
        if (!late) D9_TILE_BAR(j + 1, sm1);
        SB();
        sj = s1;
    }
#undef D9_SOFTMAX
#undef D9_BLOCK
#undef D9_LOADS
#undef D9_TR
#undef D9_VO
    asm volatile("s_waitcnt vmcnt(0)" ::: "memory");
    __syncthreads();
#undef D9_DMA
#undef D9_TILE_BAR
#undef D9_QK
#undef D9_R128
    const float lam = ((const float*)(F.ws + WS_LAM))[l]; const float omli = (l == 0) ? 0.8f : 0.64449093241f;
    const float l0 = swap_add(lrun[0]), l1 = swap_add(lrun[1]);
    const float il0 = 1.0f / l0, il1 = 1.0f / l1;
    if (FAST) { bool bad = !(l0 > 7.9e-31f && l0 < 1.3e33f) || !(l1 > 7.9e-31f && l1 < 1.3e33f);
#ifdef D9_FORCE_REDO
        bad = bad || ((blk & 7) == 3 && wid == 5);
#endif
        if (__any(bad) && lane == 0) *(volatile LAS int*)(lds + D9_FLAG) = 1; }
    LAS float* ex = (LAS float*)(lds + D9_EX) + (qg * 2 + mp) * 2048 + lane;
    { const int sg = 1 - mp; const float sc = (mp == 0) ? il1 : lam * il0;
#pragma unroll
      for (int d0 = 0; d0 < 2; ++d0)
#pragma unroll
          for (int r = 0; r < 16; ++r) ex[(d0 * 16 + r) * 64] = ((sg == 0) ? o[0][d0][r] : o[1][d0][r]) * sc; }
    __syncthreads();
    const bool redo = FAST && (*(volatile LAS int*)(lds + D9_FLAG) != 0);
    { const LAS float* exr = (const LAS float*)(lds + D9_EX) + (qg * 2 + (1 - mp)) * 2048 + lane;
      const int sk = mp;
      const float own = (mp == 0) ? il0 : lam * il1;
      float y[2][16]; float ss = 0.f;
#pragma unroll
      for (int d0 = 0; d0 < 2; ++d0)
#pragma unroll
          for (int r = 0; r < 16; ++r) { const float a = ((sk == 0) ? o[0][d0][r] : o[1][d0][r]) * own, pv = exr[(d0 * 16 + r) * 64];
              const float v = (mp == 0) ? a - pv : pv - a; y[d0][r] = v; ss += v * v; }
      ss = swap_add(ss);
      const float rs = omli / sqrtf(ss * (1.0f / 64.0f) + EPS); const float* sg = FIN(IN_SUBLN) + l * 64;
      const size_t ygrow = (size_t)b * SEQ + qtok0 + 32 * sk;
#pragma unroll
      for (int d0 = 0; d0 < 2; ++d0)
#pragma unroll
          for (int rg = 0; rg < 4; ++rg) { const int dv = 32 * d0 + 8 * rg + 4 * hi; const f32x4 g4 = *(const f32x4*)(sg + dv);
              u32x2 w; w.x = pk2(y[d0][4 * rg] * rs * g4.x, y[d0][4 * rg + 1] * rs * g4.y); w.y = pk2(y[d0][4 * rg + 2] * rs * g4.z, y[d0][4 * rg + 3] * rs * g4.w);
              *(u32x2*)(Y + ygrow * DM + 768 + h * 64 + dv) = w; } }
    __syncthreads();
    return redo;
}
constexpr int LRU_XB = 0, LRU_XB_PITCH = 528, LRU_XF = 34816, LRU_CW = 34816 + 65536;
template <bool FINAL> __device__ __forceinline__ void lru_unit(Frame& F, int l, int unit) {
    LAUNDER_IDS
#ifdef LRUPROF
    const unsigned long long tl0 = __builtin_amdgcn_s_memtime(); unsigned long long tl1 = 0, tl2 = 0;
#endif
    const int b = unit / 132, g = unit % 132; const bool isctx = g < 4;
    const int seqlen = isctx ? 256 : 8192, t0 = isctx ? 64 * g : 64 * (g - 4);
    const size_t prow0 = (size_t)b * NKEY + (isctx ? 0 : 256);
    const int gc0 = isctx ? 4 * g : 16 + 4 * (g - 4);
    const bf16* P = (const bf16*)(F.ws + WS_A); bf16* Y = (bf16*)(F.ws + WS_B);
    LAS unsigned char* lds = F.lds;
    LAS float* cwl = (LAS float*)(lds + LRU_CW);
    const int ct = tid >> 5, cg = tid & 31;
    v4u xin[4][4];
#pragma unroll
    for (int ci = 0; ci < 4; ++ci)
#pragma unroll
        for (int j = 0; j < 4; ++j) { const int tt = t0 + 16 * ci + ct + j - 1;
            xin[ci][j] = (tt >= 0 && tt < seqlen) ? *(const v4u*)(P + (prow0 + tt) * NIN + 768 + cg * 8) : (v4u){0u, 0u, 0u, 0u}; }
    for (int i = tid; i < 1280; i += 512) cwl[i] = (i < 1024) ? FIN(IN_CONVW)[l * 1024 + i] : FIN(IN_CONVB)[l * 256 + (i - 1024)];
    const int kblk = wid >> 1, dp = wid & 1, d16 = lane & 15, tg = lane >> 4;
    const bf16* WG = (const bf16*)(F.ws + WS_LRUW) + (size_t)l * 65536;
    bf16x8 bw[2][2][2][2];
    float spv[2][2], brv[2][2], biv[2][2];
#pragma unroll
    for (int dir = 0; dir < 2; ++dir)
#pragma unroll
        for (int dtl = 0; dtl < 2; ++dtl) { const int dcol = 16 * (2 * dp + dtl) + d16, ch = kblk * 64 + dcol;
#pragma unroll
            for (int gt = 0; gt < 2; ++gt)
#pragma unroll
                for (int s2 = 0; s2 < 2; ++s2) bw[dir][gt][dtl][s2] = *(const bf16x8*)(WG + ((size_t)((dir * 2 + gt) * 4 + kblk) * 64 + dcol) * 64 + 32 * s2 + 8 * tg);
            spv[dir][dtl] = ((const float*)(F.ws + WS_LAM + 4096))[(l * 2 + dir) * 256 + ch];
            brv[dir][dtl] = FIN(IN_GATEB)[((size_t)((l * 2 + dir) * 2 + 0) * 4 + kblk) * 64 + dcol];
            biv[dir][dtl] = FIN(IN_GATEB)[((size_t)((l * 2 + dir) * 2 + 1) * 4 + kblk) * 64 + dcol]; }
    unsigned short gcur[2][4], gnxt[2][4];
#define LRU_GLD(dst, cix) do { _Pragma("unroll") for (int dtl_ = 0; dtl_ < 2; ++dtl_) _Pragma("unroll") for (int r_ = 0; r_ < 4; ++r_) \
        dst[dtl_][r_] = *(const unsigned short*)(P + (prow0 + t0 + 16 * (cix) + 4 * tg + r_) * NIN + 1024 + kblk * 64 + 16 * (2 * dp + dtl_) + d16); } while (0)
    if (FINAL) LRU_GLD(gcur, 0);
    __syncthreads();
#ifdef LRUPROF
    tl1 = __builtin_amdgcn_s_memtime();
#endif
#pragma unroll
    for (int ci = 0; ci < 4; ++ci) { float acc8[8];
#pragma unroll
        for (int e = 0; e < 8; ++e) acc8[e] = cwl[1024 + cg * 8 + e];
#pragma unroll
        for (int j = 0; j < 4; ++j) { const v4u w = xin[ci][j]; const LAS float* cw = cwl + j * 256 + cg * 8;
            acc8[0] += cw[0] * bflo(w.x); acc8[1] += cw[1] * bfhi(w.x); acc8[2] += cw[2] * bflo(w.y); acc8[3] += cw[3] * bfhi(w.y);
            acc8[4] += cw[4] * bflo(w.z); acc8[5] += cw[5] * bfhi(w.z); acc8[6] += cw[6] * bflo(w.w); acc8[7] += cw[7] * bfhi(w.w); }
        const int row = 16 * ci + ct;
        v4u o; o.x = pk2(acc8[0], acc8[1]); o.y = pk2(acc8[2], acc8[3]); o.z = pk2(acc8[4], acc8[5]); o.w = pk2(acc8[6], acc8[7]);
        *(LAS v4u*)(lds + LRU_XB + row * LRU_XB_PITCH + cg * 16) = o;
        LAS float* xf = (LAS float*)(lds + LRU_XF) + row * 256 + cg * 8;
        *(LAS f32x4*)xf = (f32x4){acc8[0], acc8[1], acc8[2], acc8[3]}; *(LAS f32x4*)(xf + 4) = (f32x4){acc8[4], acc8[5], acc8[6], acc8[7]}; }
    __syncthreads();
#ifdef LRUPROF
    tl2 = __builtin_amdgcn_s_memtime();
#endif
    for (int ci = 0; ci < 4; ++ci) {
        const int tc = t0 + 16 * ci;
        if (FINAL) LRU_GLD(gnxt, min(ci + 1, 3));
        bf16x8 af[2];
#pragma unroll
        for (int s = 0; s < 2; ++s) af[s] = *(const LAS bf16x8*)(lds + LRU_XB + (16 * ci + d16) * LRU_XB_PITCH + (kblk * 64 + 32 * s + 8 * tg) * 2);
        const int gc = gc0 + ci;
        float hsum[2][4];
#pragma unroll
        for (int dtl = 0; dtl < 2; ++dtl)
#pragma unroll
            for (int r = 0; r < 4; ++r) hsum[dtl][r] = 0.f;
#pragma unroll
        for (int dir = 0; dir < 2; ++dir)
#pragma unroll
            for (int dtl = 0; dtl < 2; ++dtl) {
                const int ch = kblk * 64 + 16 * (2 * dp + dtl) + d16;
                f32x4 gr = (f32x4){0.f, 0.f, 0.f, 0.f}, gi = (f32x4){0.f, 0.f, 0.f, 0.f};
#pragma unroll
                for (int s = 0; s < 2; ++s) { gr = MFMA16(af[s], bw[dir][0][dtl][s], gr); gi = MFMA16(af[s], bw[dir][1][dtl][s], gi); }
                float a[4], u[4];
#pragma unroll
                for (int r = 0; r < 4; ++r) { const float rr = sigmoidf_(gr[r] + brv[dir][dtl]), ii = sigmoidf_(gi[r] + biv[dir][dtl]);
                    a[r] = ex2(rr * spv[dir][dtl]);
                    const float xv = ((const LAS float*)(lds + LRU_XF))[(16 * ci + 4 * tg + r) * 256 + ch];
                    u[r] = __builtin_amdgcn_sqrtf(1.0f - a[r] * a[r]) * (ii * xv); }
                float hl[4], pp[4];
                if (dir == 0) { pp[0] = a[0]; hl[0] = u[0];
#pragma unroll
                    for (int r = 1; r < 4; ++r) { pp[r] = a[r] * pp[r - 1]; hl[r] = a[r] * hl[r - 1] + u[r]; } }
                else { pp[3] = a[3]; hl[3] = u[3];
#pragma unroll
                    for (int r = 2; r >= 0; --r) { pp[r] = a[r] * pp[r + 1]; hl[r] = a[r] * hl[r + 1] + u[r]; } }
                const float Ag = (dir == 0) ? pp[3] : pp[0], Ug = (dir == 0) ? hl[3] : hl[0];
                float Aq[4], Uq[4];
#pragma unroll
                for (int q = 0; q < 4; ++q) { Aq[q] = __shfl(Ag, d16 + 16 * q); Uq[q] = __shfl(Ug, d16 + 16 * q); }
                if (!FINAL) {
                    float At = 1.f, Ut = 0.f;
                    if (dir == 0) {
#pragma unroll
                        for (int q = 0; q < 4; ++q) { Ut = Aq[q] * Ut + Uq[q]; At *= Aq[q]; } }
                    else {
#pragma unroll
                        for (int q = 3; q >= 0; --q) { Ut = Aq[q] * Ut + Uq[q]; At *= Aq[q]; } }
                    if (tg == 0) { f32x2_t v = {At, Ut}; *(f32x2_t*)((float*)(F.ws + WS_LSUM) + ((size_t)((b * 528 + gc) * 2 + dir) * 256 + ch) * 2) = v; }
                    float c0 = 0.f, Pp = 1.f;
                    if (dir == 0) {
#pragma unroll
                        for (int q = 0; q < 3; ++q) { c0 = (q < tg) ? Aq[q] * c0 + Uq[q] : c0; Pp = (q < tg) ? Pp * Aq[q] : Pp; } }
                    else {
#pragma unroll
                        for (int q = 3; q >= 1; --q) { c0 = (q > tg) ? Aq[q] * c0 + Uq[q] : c0; Pp = (q > tg) ? Pp * Aq[q] : Pp; } }
                    v4u w4; w4.x = pk2(hl[0] + pp[0] * c0, hl[1] + pp[1] * c0); w4.y = pk2(hl[2] + pp[2] * c0, hl[3] + pp[3] * c0);
                    w4.z = pk2(pp[0] * Pp, pp[1] * Pp); w4.w = pk2(pp[2] * Pp, pp[3] * Pp);
                    ((v4u*)F.out)[((((size_t)(unit * 4 + ci) * 2 + dir) * 8 + wid) * 2 + dtl) * 64 + lane] = w4;
                } else {
                    float c = ((const float*)(F.ws + WS_LCIN))[(size_t)((b * 528 + gc) * 2 + dir) * 256 + ch];
                    if (dir == 0) {
#pragma unroll
                        for (int q = 0; q < 3; ++q) c = (q < tg) ? Aq[q] * c + Uq[q] : c; }
                    else {
#pragma unroll
                        for (int q = 3; q >= 1; --q) c = (q > tg) ? Aq[q] * c + Uq[q] : c; }
#pragma unroll
                    for (int r = 0; r < 4; ++r) hsum[dtl][r] += hl[r] + pp[r] * c;
                }
            }
        if (FINAL) {
#pragma unroll
            for (int dtl = 0; dtl < 2; ++dtl) { const int ch = kblk * 64 + 16 * (2 * dp + dtl) + d16;
#pragma unroll
                for (int r = 0; r < 4; ++r) { const int t = tc + 4 * tg + r;
                    const float gv = __uint_as_float((unsigned)gcur[dtl][r] << 16);
                    const size_t grow = isctx ? (size_t)MLAT + b * 256 + t : (size_t)b * SEQ + t;
                    Y[grow * DM + 256 + ch] = (bf16)f2bf(hsum[dtl][r] * gelu_tanh(gv)); } }
#pragma unroll
            for (int dtl = 0; dtl < 2; ++dtl)
#pragma unroll
                for (int r = 0; r < 4; ++r) gcur[dtl][r] = gnxt[dtl][r];
        }
    }
#ifdef LRUPROF
    if (FINAL && blockIdx.x == 0 && wid == 0 && lane == 0) { unsigned long long* pr = (unsigned long long*)(F.ws + WS_CTL) + 8192; if (pr[7] == 0) { const unsigned long long te = __builtin_amdgcn_s_memtime();
        pr[0] = (LRUPROF == 0) ? tl1 - tl0 : (LRUPROF == 1) ? tl2 - tl1 : (LRUPROF == 2) ? te - tl2 : te - tl0; pr[7] = 1; } }
#endif
    __syncthreads();
}

#ifndef DBG_NOINTER
#define DBG_NOINTER 0
#endif
__device__ __forceinline__ float ret_lg2(const float* rd, int l, int dir, int h) { const float x = rd[(l * 2 + dir) * 4 + h]; return -log1pf(expf(-x)) * LOG2E; }
__device__ __forceinline__ int tr_off(int token, int ch  ) { return (ch >> 2) * 8192 + (token >> 3) * 512 + (token & 7) * 64 + (ch & 3) * 16; }
__device__ __forceinline__ void ret_m1_unit(Frame& F, int l, int unit) {
    LAUNDER_IDS
    const int r32 = lane & 31, hi = lane >> 5;
    const int hp = unit & 1, cc = (unit >> 1) % 66, b = unit / 132;
    const bf16* P = (const bf16*)(F.ws + WS_A); LAS unsigned char* lds = F.lds;
    const size_t prow0 = (size_t)b * NKEY + 128 * cc;
    { const int hs = tid >> 8, tt = tid & 255, h = 2 * hp + hs;
      const float lgf = ret_lg2(FIN(IN_RETDECAY), l, 0, h), lgb = ret_lg2(FIN(IN_RETDECAY), l, 1, h);
      LAS unsigned char* base = lds + hs * 49152;
#pragma unroll
      for (int i = 0; i < 4; ++i) { const int idx = tt + 256 * i, row = idx >> 3, ch = idx & 7;
          const bf16* src = P + (prow0 + row) * NIN + h * 64 + ch * 8;
          const v4u kk = *(const v4u*)(src + 6 * 256), vv = *(const v4u*)(src + 7 * 256);
          const int off = tr_off(row, ch);
          *(LAS v4u*)(base + off) = vv;
          const float df = ex2((float)(127 - row) * lgf), db = ex2((float)row * lgb);
          v4u kf, kb2;
          kf.x = pk2(bflo(kk.x) * df, bfhi(kk.x) * df); kf.y = pk2(bflo(kk.y) * df, bfhi(kk.y) * df); kf.z = pk2(bflo(kk.z) * df, bfhi(kk.z) * df); kf.w = pk2(bflo(kk.w) * df, bfhi(kk.w) * df);
          kb2.x = pk2(bflo(kk.x) * db, bfhi(kk.x) * db); kb2.y = pk2(bflo(kk.y) * db, bfhi(kk.y) * db); kb2.z = pk2(bflo(kk.z) * db, bfhi(kk.z) * db); kb2.w = pk2(bflo(kk.w) * db, bfhi(kk.w) * db);
          *(LAS v4u*)(base + 16384 + off) = kf; *(LAS v4u*)(base + 32768 + off) = kb2; } }
    __syncthreads();
    { const int hs = wid >> 2, h = 2 * hp + hs, et = (wid >> 1) & 1, dt = wid & 1;
      const LAS unsigned char* base = lds + hs * 49152;
      const int vb = ((lane >> 4) & 1) * 32 + (lane & 3) * 8 + (4 * hi + ((lane & 15) >> 2)) * 64;
      f32x16 accf, accb;
#pragma unroll
      for (int r = 0; r < 16; ++r) { accf[r] = 0.f; accb[r] = 0.f; }
#pragma unroll
      for (int ks = 0; ks < 8; ++ks) {
          const bf16x8 va = mk8(vtr(base + et * 8192 + ks * 1024 + vb), vtr(base + et * 8192 + ks * 1024 + 512 + vb));
          const bf16x8 kf = mk8(vtr(base + 16384 + dt * 8192 + ks * 1024 + vb), vtr(base + 16384 + dt * 8192 + ks * 1024 + 512 + vb));
          const bf16x8 kb2 = mk8(vtr(base + 32768 + dt * 8192 + ks * 1024 + vb), vtr(base + 32768 + dt * 8192 + ks * 1024 + 512 + vb));
          accf = MFMA32(va, kf, accf); accb = MFMA32(va, kb2, accb); }
      float* KV = (float*)(F.ws + WS_KVT) + (size_t)(((b * 4 + h) * 66 + cc) * 2) * 4096;
#pragma unroll
      for (int r = 0; r < 16; ++r) { const int e = 32 * et + crow(r, hi), d = 32 * dt + r32; KV[e * 64 + d] = accf[r]; KV[4096 + e * 64 + d] = accb[r]; } }
    __syncthreads();
#undef LRU_GLD
}
__device__ __forceinline__ void lru_final_unit(Frame& F, int l, int unit) {
    LAUNDER_IDS
    const int b = unit / 132, g = unit % 132; const bool isctx = g < 4;
    const int t0 = isctx ? 64 * g : 64 * (g - 4);
    const size_t prow0 = (size_t)b * NKEY + (isctx ? 0 : 256);
    const int gc0 = isctx ? 4 * g : 16 + 4 * (g - 4);
    const bf16* P = (const bf16*)(F.ws + WS_A); bf16* Y = (bf16*)(F.ws + WS_B);
    const int kblk = wid >> 1, dp = wid & 1, d16 = lane & 15, tg = lane >> 4;
    const v4u* HP = (const v4u*)F.out; const float* CIN = (const float*)(F.ws + WS_LCIN);
    v4u wv[4][2][2]; float cv[4][2][2]; unsigned short gq[4][2][4];
#pragma unroll
    for (int ci = 0; ci < 4; ++ci) {
#pragma unroll
        for (int dir = 0; dir < 2; ++dir)
#pragma unroll
            for (int dtl = 0; dtl < 2; ++dtl) { const int ch = kblk * 64 + 16 * (2 * dp + dtl) + d16;
                wv[ci][dir][dtl] = HP[((((size_t)(unit * 4 + ci) * 2 + dir) * 8 + wid) * 2 + dtl) * 64 + lane];
                cv[ci][dir][dtl] = CIN[(size_t)((b * 528 + gc0 + ci) * 2 + dir) * 256 + ch]; }
#pragma unroll
        for (int dtl = 0; dtl < 2; ++dtl)
#pragma unroll
            for (int r = 0; r < 4; ++r) gq[ci][dtl][r] = *(const unsigned short*)(P + (prow0 + t0 + 16 * ci + 4 * tg + r) * NIN + 1024 + kblk * 64 + 16 * (2 * dp + dtl) + d16);
    }
#pragma unroll
    for (int ci = 0; ci < 4; ++ci) {
#pragma unroll
        for (int dtl = 0; dtl < 2; ++dtl) { const int ch = kblk * 64 + 16 * (2 * dp + dtl) + d16;
            const v4u w0 = wv[ci][0][dtl], w1 = wv[ci][1][dtl];
            const f32x4 hf = bf4((u32x2){w0.x, w0.y}), pf = bf4((u32x2){w0.z, w0.w}), hb = bf4((u32x2){w1.x, w1.y}), pb = bf4((u32x2){w1.z, w1.w});
            const f32x4 h4 = (hf + pf * cv[ci][0][dtl]) + (hb + pb * cv[ci][1][dtl]);
#pragma unroll
            for (int r = 0; r < 4; ++r) { const int t = t0 + 16 * ci + 4 * tg + r;
                const float gv = __uint_as_float((unsigned)gq[ci][dtl][r] << 16);
                const size_t grow = isctx ? (size_t)MLAT + b * 256 + t : (size_t)b * SEQ + t;
                Y[grow * DM + 256 + ch] = (bf16)f2bf(h4[r] * gelu_tanh(gv)); } }
    }
}
__device__ __forceinline__ void ret_m3_unit(Frame& F, int l, int b, int cc, int hp_lo, int hp_hi) {
    LAUNDER_IDS
    const int r32 = lane & 31, hi = lane >> 5;
    const bf16* P = (const bf16*)(F.ws + WS_A); bf16* Y = (bf16*)(F.ws + WS_B); LAS unsigned char* lds = F.lds;
    const size_t prow0 = (size_t)b * NKEY + 128 * cc;
    { const int hs = tid >> 8, tt = tid & 255;
#pragma unroll
      for (int hp = 0; hp < 2; ++hp) if (hp >= hp_lo && hp < hp_hi) { const int h = 2 * hp + hs; LAS unsigned char* base = lds + h * 32768;
#pragma unroll
        for (int i = 0; i < 4; ++i) { const int idx = tt + 256 * i, row = idx >> 3, ch = idx & 7;
          const bf16* src = P + (prow0 + row) * NIN + h * 64 + ch * 8;
          const v4u kk = *(const v4u*)(src + 6 * 256), vv = *(const v4u*)(src + 7 * 256);
          *(LAS v4u*)(base + row * 128 + ((ch ^ ((row >> 1) & 7)) << 4)) = kk; *(LAS v4u*)(base + 16384 + tr_off(row, ch)) = vv; } } }
    const int hs = wid >> 2, qt = wid & 3;
    const int qi = 32 * qt + r32;
    __syncthreads();
    const int vb = ((lane >> 4) & 1) * 32 + (lane & 3) * 8 + (4 * hi + ((lane & 15) >> 2)) * 64;
#pragma unroll
    for (int hp = 0; hp < 2; ++hp) if (hp >= hp_lo && hp < hp_hi) {
    const int h = 2 * hp + hs;
    bf16x8 qr[4];
#pragma unroll
    for (int d0 = 0; d0 < 4; ++d0) qr[d0] = *(const bf16x8*)(P + (prow0 + qi) * NIN + 5 * 256 + h * 64 + d0 * 16 + hi * 8);
    const float lgf = ret_lg2(FIN(IN_RETDECAY), l, 0, h), lgb = ret_lg2(FIN(IN_RETDECAY), l, 1, h);
    const LAS unsigned char* base = lds + h * 32768;
    f32x16 o[2];
#pragma unroll
    for (int r = 0; r < 16; ++r) { o[0][r] = 0.f; o[1][r] = 0.f; }
#pragma unroll
    for (int kt = 0; kt < 4; ++kt) {
        f32x16 c;
#pragma unroll
        for (int r = 0; r < 16; ++r) c[r] = 0.f;
#pragma unroll
        for (int ds = 0; ds < 4; ++ds) { const int key = 32 * kt + r32, chunk = 2 * ds + hi;
            const bf16x8 kf = *(const LAS bf16x8*)(base + key * 128 + ((chunk ^ ((key >> 1) & 7)) << 4));
            c = MFMA32(kf, qr[ds], c); }
#pragma unroll
        for (int r = 0; r < 16; ++r) { const int kj = 32 * kt + crow(r, hi); const int dd = qi - kj;
            const float e = (dd >= 0) ? (float)dd * lgf : (float)(-dd - 1) * lgb; c[r] *= ex2(e); }
        const bf16x8 p0 = pack8(c[0], c[1], c[2], c[3], c[4], c[5], c[6], c[7]), p1 = pack8(c[8], c[9], c[10], c[11], c[12], c[13], c[14], c[15]);
#pragma unroll
        for (int et = 0; et < 2; ++et) {
            const bf16x8 v0 = mk8(vtr(base + 16384 + et * 8192 + (2 * kt) * 1024 + vb), vtr(base + 16384 + et * 8192 + (2 * kt) * 1024 + 512 + vb));
            const bf16x8 v1 = mk8(vtr(base + 16384 + et * 8192 + (2 * kt + 1) * 1024 + vb), vtr(base + 16384 + et * 8192 + (2 * kt + 1) * 1024 + 512 + vb));
            o[et] = MFMA32(v0, p0, o[et]); o[et] = MFMA32(v1, p1, o[et]); }
    }
    { const bf16* SI = (const bf16*)(F.ws + WS_SIN) + (size_t)(((b * 4 + h) * 66 + cc) * 2) * 4096;
      const float df = ex2((float)(qi + 1) * lgf), db = ex2((float)(127 - qi) * lgb);
#pragma unroll
      for (int et = 0; et < 2; ++et) { f32x16 xf, xb;
#pragma unroll
          for (int r = 0; r < 16; ++r) { xf[r] = 0.f; xb[r] = 0.f; }
#pragma unroll
          for (int ds = 0; ds < 4; ++ds) { const bf16x8 sf = *(const bf16x8*)(SI + (32 * et + r32) * 64 + 16 * ds + 8 * hi), sb = *(const bf16x8*)(SI + 4096 + (32 * et + r32) * 64 + 16 * ds + 8 * hi);
              xf = MFMA32(sf, qr[ds], xf); xb = MFMA32(sb, qr[ds], xb); }
#pragma unroll
          for (int r = 0; r < 16; ++r) o[et][r] += DBG_NOINTER ? 0.f : df * xf[r] + db * xb[r]; } }
    float ss = 0.f;
#pragma unroll
    for (int et = 0; et < 2; ++et)
#pragma unroll
        for (int r = 0; r < 16; ++r) ss += o[et][r] * o[et][r];
    ss = swap_add(ss);
    const float rs = 1.0f / sqrtf(ss * (1.0f / 64.0f) + EPS);
    const size_t prow = prow0 + qi;
    const size_t grow = (cc < 2) ? (size_t)MLAT + b * 256 + 128 * cc + qi : (size_t)b * SEQ + 128 * (cc - 2) + qi;
#pragma unroll
    for (int et = 0; et < 2; ++et)
#pragma unroll
        for (int rg = 0; rg < 4; ++rg) { const int e = 32 * et + 8 * rg + 4 * hi;
            const u32x2 gw = *(const u32x2*)(P + prow * NIN + 8 * 256 + h * 64 + e);
            const float g0 = bflo(gw.x), g1 = bfhi(gw.x), g2 = bflo(gw.y), g3 = bfhi(gw.y);
            u32x2 w; w.x = pk2(o[et][4 * rg] * rs * (g0 * sigmoidf_(g0)), o[et][4 * rg + 1] * rs * (g1 * sigmoidf_(g1)));
            w.y = pk2(o[et][4 * rg + 2] * rs * (g2 * sigmoidf_(g2)), o[et][4 * rg + 3] * rs * (g3 * sigmoidf_(g3)));
            *(u32x2*)(Y + grow * DM + 512 + h * 64 + e) = w; }
    }
    __syncthreads();
}
__device__ __forceinline__ void m2_phase(Frame& F, int l) {
    LAUNDER_IDS
    for (int item = blockIdx.x; item < 64; item += F.G) {
        const int seg = tid >> 5, ci = tid & 31, chain = item * 32 + ci, b = chain >> 9, dir = (chain >> 8) & 1, ch = chain & 255;
        const float* SUM = (const float*)(F.ws + WS_LSUM); float* CIN = (float*)(F.ws + WS_LCIN);
        LAS float* sA = (LAS float*)F.lds; LAS float* sU = sA + 512;
        float A[33], U[33];
#pragma unroll
        for (int i = 0; i < 33; ++i) { const int pos = seg * 33 + i; const int gc = (dir == 0) ? pos : ((pos < 16) ? 15 - pos : 543 - pos);
            const f32x2_t v = *(const f32x2_t*)(SUM + ((size_t)((b * 528 + gc) * 2 + dir) * 256 + ch) * 2); A[i] = v.x; U[i] = v.y; }
        float As = 1.f, Us = 0.f;
#pragma unroll
        for (int i = 0; i < 33; ++i) { Us = A[i] * Us + U[i]; As *= A[i]; }
        sA[seg * 32 + ci] = As; sU[seg * 32 + ci] = Us;
        __syncthreads();
        float c = 0.f;
        for (int s = 0; s < 15; ++s) { const float a2 = sA[s * 32 + ci], u2 = sU[s * 32 + ci]; c = (s < seg) ? a2 * c + u2 : c; }
#pragma unroll
        for (int i = 0; i < 33; ++i) { const int pos = seg * 33 + i; const int gc = (dir == 0) ? pos : ((pos < 16) ? 15 - pos : 543 - pos);
            CIN[(size_t)((b * 528 + gc) * 2 + dir) * 256 + ch] = c; c = A[i] * c + U[i]; }
        __syncthreads();
    }
    for (int idx = F.vcu * 512 + tid; idx < 131072; idx += F.G * 512) {
        const int chain = idx >> 12, el = idx & 4095, bh = chain >> 1, dir = chain & 1, h = bh & 3;
        const float c128 = ex2(128.0f * ret_lg2(FIN(IN_RETDECAY), l, dir, h));
        const float* KV = (const float*)(F.ws + WS_KVT) + (size_t)bh * 66 * 2 * 4096 + dir * 4096 + el;
        bf16* SI = (bf16*)(F.ws + WS_SIN) + (size_t)bh * 66 * 2 * 4096 + dir * 4096 + el;
        float S = 0.f;
        for (int p0 = 0; p0 < 66; p0 += 33) { float kv[33];
#pragma unroll
            for (int i = 0; i < 33; ++i) { const int pos = p0 + i; const int cc = (dir == 0) ? pos : ((pos < 2) ? 1 - pos : 67 - pos); kv[i] = KV[(size_t)cc * 8192]; }
#pragma unroll
            for (int i = 0; i < 33; ++i) { const int pos = p0 + i; const int cc = (dir == 0) ? pos : ((pos < 2) ? 1 - pos : 67 - pos); SI[(size_t)cc * 8192] = (bf16)f2bf(S); S = c128 * S + kv[i]; } }
    }
}
constexpr size_t WS_DBG = 452 * MiB;
#ifndef DBG_PROBE
#define DBG_PROBE 0
#endif
#ifndef DBG_NOINTER
#define DBG_NOINTER 0
#endif
#ifndef DBG_LAYER
#define DBG_LAYER -1
#endif
constexpr int CW_DBG = 12288;
#ifndef NAIVE_RET
#define NAIVE_RET 0
#endif
#ifndef NAIVE_LRU
#define NAIVE_LRU 0
#endif
__device__ __forceinline__ void chain_tok(int b, int dir, int pos, size_t& prow, size_t& grow) {
    int isctx = pos < 256, t = isctx ? pos : pos - 256;
    if (dir == 1) t = isctx ? 255 - t : 8191 - t;
    prow = (size_t)b * NKEY + (isctx ? 0 : 256) + t; grow = isctx ? (size_t)MLAT + b * 256 + t : (size_t)b * SEQ + t;
}
__device__ __forceinline__ void naive_ret(Frame& F, int l) {
    LAUNDER_IDS
    const bf16* P = (const bf16*)(F.ws + WS_A); bf16* Y = (bf16*)(F.ws + WS_B); float* T = (float*)(F.ws + WS_DBG);
    LAS float* red = (LAS float*)F.lds;
    for (int item = blockIdx.x; item < 32; item += F.G) {
        const int dir = item & 1, h = (item >> 1) & 3, b = item >> 3, e = tid & 63, dg = tid >> 6;
        const float gam = ex2(ret_lg2(FIN(IN_RETDECAY), l, dir, h));
        float S[8];
#pragma unroll
        for (int i = 0; i < 8; ++i) S[i] = 0.f;
        for (int pos = 0; pos < 8448; ++pos) {
            size_t prow, grow; chain_tok(b, dir, pos, prow, grow);
#if DBG_PROBE == 1
            if ((pos & 127) == 0 && (DBG_LAYER < 0 || l == DBG_LAYER)) { const int cc = (dir == 0) ? (pos >> 7) : ((pos < 256) ? 1 - (pos >> 7) : 65 - ((pos - 256) >> 7));
                const bf16* SI = (const bf16*)(F.ws + WS_SIN) + (size_t)((((b * 4 + h) * 66 + cc) * 2) + dir) * 4096;
                float md = 0.f, ms = 0.f;
#pragma unroll
                for (int i = 0; i < 8; ++i) { const float sv = bf2f(SI[e * 64 + dg * 8 + i]); md = fmaxf(md, fabsf(sv - S[i])); ms = fmaxf(ms, fabsf(S[i])); }
                atomicMax((unsigned*)(F.ws + WS_CTL) + CW_DBG, __float_as_uint(md)); atomicMax((unsigned*)(F.ws + WS_CTL) + CW_DBG + 1, __float_as_uint(ms)); }
#endif
#if DBG_NOINTER
            if ((pos & 127) == 0) {
#pragma unroll
                for (int i = 0; i < 8; ++i) S[i] = 0.f; }
#endif
            const bf16* pr = P + prow * NIN + h * 64;
            const v4u qw = *(const v4u*)(pr + 5 * 256 + dg * 8), kw = *(const v4u*)(pr + 6 * 256 + dg * 8);
            const float v = bf2f(pr[7 * 256 + e]);
            const float q[8] = {bflo(qw.x), bfhi(qw.x), bflo(qw.y), bfhi(qw.y), bflo(qw.z), bfhi(qw.z), bflo(qw.w), bfhi(qw.w)};
            const float k[8] = {bflo(kw.x), bfhi(kw.x), bflo(kw.y), bfhi(kw.y), bflo(kw.z), bfhi(kw.z), bflo(kw.w), bfhi(kw.w)};
            float part = 0.f;
            if (dir == 0) {
#pragma unroll
                for (int i = 0; i < 8; ++i) { S[i] = gam * S[i] + k[i] * v; part += q[i] * S[i]; } }
            else {
#pragma unroll
                for (int i = 0; i < 8; ++i) { part += q[i] * S[i]; S[i] = gam * S[i] + k[i] * v; } }
            red[dg * 64 + e] = part;
            __syncthreads();
            if (dg == 0) { float o = 0.f;
#pragma unroll
                for (int i = 0; i < 8; ++i) o += red[i * 64 + e];
                T[((size_t)dir * MALL + grow) * 256 + h * 64 + e] = o; }
            __syncthreads();
        }
    }
}
__device__ __forceinline__ void naive_ret_combine(Frame& F, int l) {
    LAUNDER_IDS
    const bf16* P = (const bf16*)(F.ws + WS_A); bf16* Y = (bf16*)(F.ws + WS_B); const float* T = (const float*)(F.ws + WS_DBG);
    const int gw = F.vcu * NWAVES + wid, NGW = F.G * NWAVES;
    for (int it = gw; it < MALL * 4; it += NGW) {
        const int grow = it >> 2, h = it & 3;
        if (l == 1 && grow >= MLAT) continue;
        const size_t prow = (grow < MLAT) ? (size_t)(grow >> 13) * NKEY + 256 + (grow & 8191) : (size_t)((grow - MLAT) >> 8) * NKEY + ((grow - MLAT) & 255);
        const float o = T[(size_t)grow * 256 + h * 64 + lane] + T[((size_t)MALL + grow) * 256 + h * 64 + lane];
        const float ss = wave_sum(o * o); const float rs = 1.0f / sqrtf(ss * (1.0f / 64.0f) + EPS);
        const float g = bf2f(P[prow * NIN + 8 * 256 + h * 64 + lane]);
#if DBG_PROBE == 2
        if (DBG_LAYER < 0 || l == DBG_LAYER) { const float mine = bf2f(Y[(size_t)grow * DM + 512 + h * 64 + lane]), ref = o * rs * (g * sigmoidf_(g));
            atomicMax((unsigned*)(F.ws + WS_CTL) + CW_DBG, __float_as_uint(fabsf(mine - ref))); atomicMax((unsigned*)(F.ws + WS_CTL) + CW_DBG + 1, __float_as_uint(fabsf(ref))); }
#else
        Y[(size_t)grow * DM + 512 + h * 64 + lane] = (bf16)f2bf(o * rs * (g * sigmoidf_(g)));
#endif
    }
}
__device__ __forceinline__ void naive_lru(Frame& F, int l) {
    LAUNDER_IDS
    const bf16* P = (const bf16*)(F.ws + WS_A); float* T = (float*)(F.ws + WS_DBG);
    LAS float* xs = (LAS float*)F.lds;
    for (int item = blockIdx.x; item < 16; item += F.G) {
        const int b = item >> 2, k = item & 3, dir = (tid >> 6) & 1, d = tid & 63, ch = k * 64 + d; const bool on = tid < 128;
        const float* cw = FIN(IN_CONVW) + l * 1024; const float cb = FIN(IN_CONVB)[l * 256 + ch];
        const float* wr_ = FIN(IN_GATEW) + ((size_t)((l * 2 + dir) * 2 + 0) * 4 + k) * 4096;
        const float* wi_ = FIN(IN_GATEW) + ((size_t)((l * 2 + dir) * 2 + 1) * 4 + k) * 4096;
        const float br = FIN(IN_GATEB)[((size_t)((l * 2 + dir) * 2 + 0) * 4 + k) * 64 + d], bi = FIN(IN_GATEB)[((size_t)((l * 2 + dir) * 2 + 1) * 4 + k) * 64 + d];
        const float sp = log1pf(expf(-FIN(IN_LRULAM)[(l * 2 + dir) * 256 + ch]));
        float hst = 0.f;
        for (int pos = 0; pos < 8448; ++pos) {
            size_t prow, grow; chain_tok(b, dir, pos, prow, grow);
            const int isctx = pos < 256; int t = isctx ? pos : pos - 256; if (dir == 1) t = isctx ? 255 - t : 8191 - t;
            const int seqlen = isctx ? 256 : 8192;
            float xb = cb;
#pragma unroll
            for (int j = 0; j < 4; ++j) { const int tt = t + j - 1; if (tt >= 0 && tt < seqlen) xb += cw[j * 256 + ch] * bf2f(P[(prow + (tt - t)) * NIN + 768 + ch]); }
            if (on) xs[dir * 64 + d] = xb;
            __syncthreads();
            if (on) { float pr_ = br, pi_ = bi;
                for (int c = 0; c < 64; ++c) { const float xv = xs[dir * 64 + c]; pr_ += xv * wr_[c * 64 + d]; pi_ += xv * wi_[c * 64 + d]; }
                const float r = 1.0f / (1.0f + expf(-pr_)), ii = 1.0f / (1.0f + expf(-pi_));
                const float la = -8.0f * r * sp, a = expf(la), u = sqrtf(-expm1f(2.0f * la)) * (ii * xb);
                hst = a * hst + u;
                T[((size_t)dir * MALL + grow) * 256 + ch] = hst; }
            __syncthreads();
        }
    }
}
__device__ __forceinline__ void naive_lru_combine(Frame& F, int l) {
    LAUNDER_IDS
    const bf16* P = (const bf16*)(F.ws + WS_A); bf16* Y = (bf16*)(F.ws + WS_B); const float* T = (const float*)(F.ws + WS_DBG);
    const int gw = F.vcu * NWAVES + wid, NGW = F.G * NWAVES;
    for (int it = gw; it < MALL * 4; it += NGW) {
        const int grow = it >> 2, k = it & 3, ch = k * 64 + lane;
        if (l == 1 && grow >= MLAT) continue;
        const size_t prow = (grow < MLAT) ? (size_t)(grow >> 13) * NKEY + 256 + (grow & 8191) : (size_t)((grow - MLAT) >> 8) * NKEY + ((grow - MLAT) & 255);
        const float hsum = T[(size_t)grow * 256 + ch] + T[((size_t)MALL + grow) * 256 + ch];
        const float g = bf2f(P[prow * NIN + 1024 + ch]);
        const float z = 0.7978845608028654f * (g + 0.044715f * g * g * g);
        Y[(size_t)grow * DM + 256 + ch] = (bf16)f2bf(hsum * 0.5f * g * (1.0f + tanhf(z)));
    }
}
struct Args { const float* in[23]; float* out; unsigned char* ws; int ph_lo, ph_hi; };
__device__ __forceinline__ int fetch_item(Frame& F, unsigned* ctr) {
    volatile LAS int* slot = (volatile LAS int*)(F.lds + MISC_OFF + 64);
    __syncthreads();
    if (F.tid == 0) *slot = (int)__hip_atomic_fetch_add(ctr, 1u, __ATOMIC_RELAXED, __HIP_MEMORY_SCOPE_AGENT);
    __syncthreads();
    return *slot;
}
__device__ __forceinline__ void group_barrier(Frame& F, unsigned* cnt, unsigned n) {
    VM_WAIT(); __syncthreads();
    if (F.tid == 0) { __builtin_amdgcn_fence(__ATOMIC_RELEASE, "agent"); VM_WAIT();
        (void)__hip_atomic_fetch_add(cnt, 1u, __ATOMIC_RELAXED, __HIP_MEMORY_SCOPE_AGENT);
        unsigned sp = 0; while (__hip_atomic_load(cnt, __ATOMIC_RELAXED, __HIP_MEMORY_SCOPE_AGENT) < n) { __builtin_amdgcn_s_sleep(2); if (++sp > (1u << 22)) break; }
        __builtin_amdgcn_fence(__ATOMIC_ACQUIRE, "agent"); VM_WAIT(); }
    __syncthreads();
}
struct OneUnitOrder {
    int pm, pn;
    __device__ bool next(int i, pg8::Unit& u) const { if (i != 0) return false; u.pm = pm; u.pn = pn; return true; }
    __device__ __forceinline__ void a_ready(const pg8::Unit&) const {}
    __device__ __forceinline__ void done(const pg8::Unit&) const {}
};
constexpr int NCTXW = 16;
__global__ void __launch_bounds__(NWAVES * 64, 2) hybrid_fwd(Args args) {
    extern __shared__ __attribute__((aligned(16))) unsigned char lds_raw[];
    Frame F;
    F.lds = (LAS unsigned char*)lds_raw;
    F.tid = threadIdx.x; F.lane = F.tid & 63; F.wave = __builtin_amdgcn_readfirstlane(F.tid >> 6);
    F.G = gridDim.x; { const int bx = blockIdx.x; F.vcu = (F.G % 8 == 0) ? (bx % 8) * (F.G / 8) + bx / 8 : bx; }
    F.kin = (const float* const __attribute__((address_space(4)))*)__builtin_amdgcn_kernarg_segment_ptr();
    F.out = args.out; F.ws = args.ws;
    unsigned* ctl = (unsigned*)(F.ws + WS_CTL);
    for (int u = F.tid; u < (LDS_BYTES - LDSCTL_OFF) / 4; u += NWAVES * 64) ((LAS unsigned*)(F.lds + LDSCTL_OFF))[u] = 0u;
    __syncthreads();
    XcdBarrier bar = xcd_barrier_post(ctl + CW_BAR, (volatile LAS unsigned*)(F.lds + MISC_OFF) + 8);
    const int lo = args.ph_lo, hi = args.ph_hi; int ph = 0;
#ifdef KCLK
    const unsigned long long kclk0 = __builtin_amdgcn_s_memtime();
#endif
#ifdef KFREQ
    const unsigned long long kfc0 = __builtin_amdgcn_s_memtime(), kfr0 = __builtin_amdgcn_s_memrealtime();
#endif
#ifdef BARBENCH
    {
        xcd_barrier(bar);
        const unsigned long long tb0 = __builtin_amdgcn_s_memrealtime();
        for (int i = 0; i < 16; ++i) xcd_barrier(bar);
        const unsigned long long tb1 = __builtin_amdgcn_s_memrealtime();
        if (blockIdx.x == 0 && F.tid == 0) F.out[0] = 1.0e4f * rintf((float)(tb1 - tb0) * (1.0f / 16.0f) * 0.01f * 4.0f) * 0.25f;
        return;
    }
#endif
#ifdef UBENCH
    {
        float a0 = F.tid * 1e-3f, a1 = a0 + 1.f, a2 = a0 + 2.f, a3 = a0 + 3.f, a4 = a0 + 4.f, a5 = a0 + 5.f, a6 = a0 + 6.f, a7 = a0 + 7.f;
        f32x16 c0, c1, c2, c3;
#pragma unroll
        for (int r = 0; r < 16; ++r) { c0[r] = a0; c1[r] = a1; c2[r] = a2; c3[r] = a3; }
        bf16x8 fa, fb;
#pragma unroll
        for (int r = 0; r < 8; ++r) { fa[r] = (short)(0x3c00 + F.lane); fb[r] = (short)(0x3c10 + F.lane); }
        const int role = (F.wave == 0) ? UB_R0 : (F.wave == 4) ? UB_R4 : (F.wave == 1) ? UB_R1 : 0;
        __syncthreads();
        unsigned long long t0 = 0, t1 = 0, best = ~0ull; int ninst = 1;
#define UB8(INS) INS(0) INS(1) INS(2) INS(3) INS(4) INS(5) INS(6) INS(7)
#define UB_EXP(i) "v_exp_f32 %" #i ", %" #i "\n\t"
#define UB_MAX(i) "v_max3_f32 %" #i ", %" #i ", %" #i ", %" #i "\n\t"
#define UB_CVT(i) "v_cvt_pk_bf16_f32 %" #i ", %" #i ", %" #i "\n\t"
#define UB_ADD(i) "v_add_f32 %" #i ", %" #i ", %" #i "\n\t"
#define UB_FMA(i) "v_fma_f32 %" #i ", %" #i ", %" #i ", %" #i "\n\t"
#define UB_RUN(INS) for (int it = 0; it < 16; ++it) asm volatile(UB8(INS) UB8(INS) UB8(INS) UB8(INS) : "+v"(a0), "+v"(a1), "+v"(a2), "+v"(a3), "+v"(a4), "+v"(a5), "+v"(a6), "+v"(a7))
        for (int rep = 0; rep < 8; ++rep) {
        __syncthreads();
        if (role == 1) { t0 = __builtin_amdgcn_s_memtime(); UB_RUN(UB_EXP); t1 = __builtin_amdgcn_s_memtime(); ninst = 512; }
        else if (role == 2) { t0 = __builtin_amdgcn_s_memtime(); UB_RUN(UB_MAX); t1 = __builtin_amdgcn_s_memtime(); ninst = 512; }
        else if (role == 4) { t0 = __builtin_amdgcn_s_memtime(); UB_RUN(UB_CVT); t1 = __builtin_amdgcn_s_memtime(); ninst = 512; }
        else if (role == 6) { t0 = __builtin_amdgcn_s_memtime(); UB_RUN(UB_ADD); t1 = __builtin_amdgcn_s_memtime(); ninst = 512; }
        else if (role == 7) { t0 = __builtin_amdgcn_s_memtime(); UB_RUN(UB_FMA); t1 = __builtin_amdgcn_s_memtime(); ninst = 512; }
        else if (role == 5) { f32x2_t p0 = {a0, a1}, p1 = {a2, a3}, p2 = {a4, a5}, p3 = {a6, a7};
            t0 = __builtin_amdgcn_s_memtime();
            for (int it = 0; it < 16; ++it) asm volatile("v_pk_add_f32 %0, %0, %0\n\tv_pk_add_f32 %1, %1, %1\n\tv_pk_add_f32 %2, %2, %2\n\tv_pk_add_f32 %3, %3, %3\n\tv_pk_add_f32 %0, %0, %0\n\tv_pk_add_f32 %1, %1, %1\n\tv_pk_add_f32 %2, %2, %2\n\tv_pk_add_f32 %3, %3, %3\n\t"
                                                         "v_pk_add_f32 %0, %0, %0\n\tv_pk_add_f32 %1, %1, %1\n\tv_pk_add_f32 %2, %2, %2\n\tv_pk_add_f32 %3, %3, %3\n\tv_pk_add_f32 %0, %0, %0\n\tv_pk_add_f32 %1, %1, %1\n\tv_pk_add_f32 %2, %2, %2\n\tv_pk_add_f32 %3, %3, %3\n\t"
                                                         : "+v"(p0), "+v"(p1), "+v"(p2), "+v"(p3));
            t1 = __builtin_amdgcn_s_memtime(); ninst = 256; a0 = p0.x + p1.y + p2.x + p3.y; }
        else if (role == 3) { t0 = __builtin_amdgcn_s_memtime();
            for (int it = 0; it < 16; ++it) asm volatile("v_mfma_f32_32x32x16_bf16 %0, %4, %5, %0\n\tv_mfma_f32_32x32x16_bf16 %1, %4, %5, %1\n\tv_mfma_f32_32x32x16_bf16 %2, %4, %5, %2\n\tv_mfma_f32_32x32x16_bf16 %3, %4, %5, %3\n\t"
                                                         "v_mfma_f32_32x32x16_bf16 %0, %4, %5, %0\n\tv_mfma_f32_32x32x16_bf16 %1, %4, %5, %1\n\tv_mfma_f32_32x32x16_bf16 %2, %4, %5, %2\n\tv_mfma_f32_32x32x16_bf16 %3, %4, %5, %3\n\t"
                                                         : "+v"(c0), "+v"(c1), "+v"(c2), "+v"(c3) : "v"(fa), "v"(fb));
            asm volatile("s_nop 15\n\ts_nop 15" : "+v"(c0), "+v"(c1), "+v"(c2), "+v"(c3));
            t1 = __builtin_amdgcn_s_memtime(); ninst = 128; }
        if (t1 - t0 < best) best = t1 - t0;
        }
        __syncthreads();
        float keep = a0 + a1 + a2 + a3 + a4 + a5 + a6 + a7 + c0[0] + c1[1] + c2[2] + c3[3];
        if (keep == 12345.6789f) F.out[1] = keep;
        if (blockIdx.x == 0 && F.wave == UB_REP && F.lane == 0) F.out[0] = rintf((float)best / (float)ninst * 2.0f) * 0.5f * 1.0e4f;
        return;
    }
#endif
#ifndef D7A
#define D7A true
#define D7B 1
#endif
#ifndef DIFF_IMPL
#define DIFF_IMPL 7
#endif
#ifndef UMASK
#define UMASK 0xFF
#endif
#ifndef PHMASK
#define PHMASK 0xFFFF
#endif
#ifndef REPEAT_MASK
#define REPEAT_MASK 0
#endif
#ifndef REPEAT_UMASK
#define REPEAT_UMASK 0xFF
#endif
#define PHASE_BEGIN(kind) if ((((PHMASK) >> (kind)) & 1) && ph >= lo && ph < hi) { for (int rep_ = 0; rep_ <= (((REPEAT_MASK) >> (kind)) & 1); ++rep_) { if (rep_) xcd_barrier(bar);
#ifdef PHPROF
#define PH_STAMP(i) do { if (blockIdx.x == 0 && F.tid == 0) ((unsigned long long*)(F.ws + WS_CTL))[8300 + (i)] = __builtin_amdgcn_s_memrealtime(); } while (0)
#else
#define PH_STAMP(i) do {} while (0)
#endif
#define PHASE_END(last) } if (!(last) && ph + 1 < hi) xcd_barrier(bar); } ++ph; PH_STAMP(ph);

    PH_STAMP(0);
    PHASE_BEGIN(0) p0a(F); PHASE_END(false)
    PHASE_BEGIN(1) p0b(F); PHASE_END(false)
    for (int l = 0; l < 2; ++l) {
        const int M = (l == 0) ? MALL : MLAT;
        PHASE_BEGIN(2) {
            pg8::Gemm g{(const pg8::bf16_t*)(F.ws + WS_B), (const pg8::bf16_t*)(F.ws + WS_WIN + l * SZ_WIN), MALL, NIN, DM}; pg8::StaticOrder S; S.init(MALL, NIN, F.G, (int)blockIdx.x);
            const float* tab = (const float*)(F.ws + WS_TAB);
            pg8::EpiInProj E{(pg8::bf16_t*)(F.ws + WS_A), tab, tab + 2048, tab + 4096, tab + 5120};
            pg8::gemm_phase<pg8::EpiInProj, pg8::StaticOrder, true, true>(F.lds, g, S, E);
        } PHASE_END(false)
        PHASE_BEGIN(3) {
            unsigned* ctr = ctl + CW_Q + 64 * l + 16 * rep_;
            const int n_diff = 512, n_na = 512, n_ret = 528, n_lru = 528, n_cx = (l == 0) ? 32 : 0;
            const int total = n_diff + n_na + n_ret + n_lru + n_cx;
            for (;;) {
                int it = fetch_item(F, ctr);
                if (it >= total) break;
#ifdef REPEAT_M1_LO
                if (rep_ && (it < REPEAT_M1_LO || it >= REPEAT_M1_HI)) continue;
#endif
                if (it < n_diff) { if (UMASK & 1) { if (rep_ && DIFF_VAR) diff_unit<DIFF_VAR>(F, l, it >> 7, (it >> 5) & 3, it & 31); else { if (DIFF_IMPL == 9) { if (diff9_unit<D7A>(F, l, it >> 7, (it >> 5) & 3, it & 31)) { if (D7B) diff9_unit<false>(F, l, it >> 7, (it >> 5) & 3, it & 31); } } else if (DIFF_IMPL == 8) { if (diff8_unit<D7A>(F, l, it >> 7, (it >> 5) & 3, it & 31)) { if (D7B) diff8_unit<false>(F, l, it >> 7, (it >> 5) & 3, it & 31); } } else if (DIFF_IMPL == 7) { if (diff7_unit<D7A>(F, l, it >> 7, (it >> 5) & 3, it & 31)) { if (D7B) diff7_unit<false>(F, l, it >> 7, (it >> 5) & 3, it & 31); } } else if (DIFF_IMPL == 6) diff6_unit(F, l, it >> 7, (it >> 5) & 3, it & 31); else if (DIFF_IMPL == 5) diff5_unit(F, l, it >> 7, (it >> 5) & 3, it & 31); else if (DIFF_IMPL == 3) diff3_unit(F, l, it >> 7, (it >> 5) & 3, it & 31); else diff_unit<0>(F, l, it >> 7, (it >> 5) & 3, it & 31); } } continue; } it -= n_diff;
                if (it < n_na) { if (UMASK & 2) attn_unit<1>(F, l, it >> 7, (it >> 5) & 3, it & 31); continue; } it -= n_na;
                if (it < n_lru) { if (UMASK & 8) lru_unit<false>(F, l, it); continue; } it -= n_lru;
                if (it < n_cx) { if (it < 16) { if (UMASK & 16) attn_unit<2>(F, l, it >> 2, it & 3, 0); } else { if (UMASK & 32) attn_unit<3>(F, l, (it - 16) >> 2, it & 3, 0); } continue; } it -= n_cx;
                if (UMASK & 4) ret_m1_unit(F, l, it);
            }
        } PHASE_END(false)
        PHASE_BEGIN(4) m2_phase(F, l); PHASE_END(false)
        PHASE_BEGIN(5) {
            unsigned* ctr3 = ctl + CW_Q + 64 * l + 32 + 8 * rep_;
            for (;;) {
                const int it = fetch_item(F, ctr3);
                if (it >= 528 + 256 + 16) break;
                if (it >= 528) { const int u = it - 528;
                    if ((!NAIVE_RET || DBG_PROBE == 2) && (UMASK & 64) && (!rep_ || (REPEAT_UMASK & 64))) {
                        if (u < 256) ret_m3_unit(F, l, u >> 6, 2 + (u & 63), 0, 2);
                        else if (l == 0) { const int v = u - 256; ret_m3_unit(F, l, v >> 2, (v >> 1) & 1, v & 1, (v & 1) + 1); } } }
                else { const int u = it; if (!NAIVE_LRU && (UMASK & 128) && (!rep_ || (REPEAT_UMASK & 128)) && (l == 0 || (u % 132) >= 4)) lru_final_unit(F, l, u); }
            }
#if NAIVE_RET
            naive_ret(F, l); xcd_barrier(bar); naive_ret_combine(F, l);
#endif
#if NAIVE_LRU
            xcd_barrier(bar); naive_lru(F, l); xcd_barrier(bar); naive_lru_combine(F, l);
#endif
        } PHASE_END(false)
        PHASE_BEGIN(6) {
            pg8::Gemm g{(const pg8::bf16_t*)(F.ws + WS_B), (const pg8::bf16_t*)(F.ws + WS_WOUT + l * SZ_WOUT), MLAT, DM, DM}; pg8::StaticOrder S; S.init(MLAT, DM, F.G, (int)blockIdx.x);
            pg8::EpiPlain E{(pg8::bf16_t*)(F.ws + WS_A), DM};
            pg8::gemm_phase<pg8::EpiPlain, pg8::StaticOrder, true, true>(F.lds, g, S, E);
        } PHASE_END(false)
        PHASE_BEGIN(7) {
            if (l == 0 && F.G > 2 * NCTXW) {
                if ((int)blockIdx.x < NCTXW) {
                    pg8::Gemm g{(const pg8::bf16_t*)(F.ws + WS_B), (const pg8::bf16_t*)(F.ws + WS_WOUT), MALL, DM, DM}; OneUnitOrder S{128 + ((int)blockIdx.x >> 2), (int)blockIdx.x & 3};
                    pg8::EpiPlain E{(pg8::bf16_t*)(F.ws + WS_A), DM};
                    pg8::gemm_phase<pg8::EpiPlain, OneUnitOrder, false, true>(F.lds, g, S, E);
                    group_barrier(F, ctl + CW_Q + 128, NCTXW);
                    e2_phase(F, 0, MLAT, MALL, (int)blockIdx.x, NCTXW);
                } else e2_phase(F, 0, 0, MLAT, (int)blockIdx.x - NCTXW, F.G - NCTXW);
            } else if (l == 0) {
                e2_phase(F, 0, 0, MALL, F.vcu, F.G);
            } else e2_phase(F, l, 0, MLAT, F.vcu, F.G);
        } PHASE_END(false)
        PHASE_BEGIN(8) {
            pg8::Gemm g{(const pg8::bf16_t*)(F.ws + WS_B), (const pg8::bf16_t*)(F.ws + WS_WF1 + l * SZ_WF1), M, 2 * DFF, DM}; pg8::StaticOrder S; S.init(M, 2 * DFF, F.G, (int)blockIdx.x);
            pg8::EpiSwiGLU E{(pg8::bf16_t*)(F.ws + WS_A), DFF};
            pg8::gemm_phase<pg8::EpiSwiGLU, pg8::StaticOrder, true, true>(F.lds, g, S, E);
        } PHASE_END(false)
        PHASE_BEGIN(9) {
#ifndef G4_KPROBE
#define G4_KPROBE DFF
#endif
            pg8::Gemm g{(const pg8::bf16_t*)(F.ws + WS_A), (const pg8::bf16_t*)(F.ws + WS_WF2 + l * SZ_WF2), MLAT, DM, G4_KPROBE, DFF}; pg8::StaticOrder S; S.init(MLAT, DM, F.G, (int)blockIdx.x);
            pg8::EpiPlain E{(pg8::bf16_t*)(F.ws + WS_B), DM};
            pg8::gemm_phase<pg8::EpiPlain, pg8::StaticOrder, true, true>(F.lds, g, S, E);
        } PHASE_END(false)
        PHASE_BEGIN(10) {
            if (l == 0) {
                constexpr int NC2 = 2 * NCTXW, E3_R1 = MLAT - 36 * NC2;
                if ((int)blockIdx.x < NC2) {
                    const int uu = (int)blockIdx.x & (NCTXW - 1), ks = (int)blockIdx.x / NCTXW;
                    pg8::bf16_t* part2 = (pg8::bf16_t*)(F.ws + WS_KVT) - (size_t)MLAT * DM;
                    pg8::Gemm g{(const pg8::bf16_t*)(F.ws + WS_A) + ks * (DFF / 2), (const pg8::bf16_t*)(F.ws + WS_WF2) + ks * (DFF / 2), MALL, DM, DFF / 2, DFF}; OneUnitOrder S{128 + (uu >> 2), uu & 3};
                    pg8::EpiPlain E{ks ? part2 : (pg8::bf16_t*)(F.ws + WS_B), DM};
                    pg8::gemm_phase<pg8::EpiPlain, OneUnitOrder, false, true>(F.lds, g, S, E);
                    group_barrier(F, ctl + CW_Q + 192, NC2);
                    e3_rows<false, true>(F, 0, MLAT, MALL, (int)blockIdx.x, NC2, (const bf16*)part2);
                    e3_phase(F, 0, E3_R1, MLAT, (int)blockIdx.x, NC2);
                } else e3_phase(F, 0, 0, E3_R1, (int)blockIdx.x - NC2, F.G - NC2);
            } else e3_phase(F, l, 0, MLAT, F.vcu, F.G);
        } PHASE_END(l == 1)
    }
#ifdef KCLK
    if (blockIdx.x == 0 && F.tid == 0) { const float cyc = (float)(__builtin_amdgcn_s_memtime() - kclk0); F.out[0] = 1000.0f * rintf(cyc * (1.0f / (float)KCLK)); }
#endif
#ifdef PHPROF
    if (blockIdx.x == 0 && F.tid == 0) { const unsigned long long* pr = (const unsigned long long*)(F.ws + WS_CTL) + 8300; const float us = (float)(pr[PHPROF + 1] - pr[PHPROF]) * 0.01f;
        F.out[0] = 1000.0f * rintf(log2f(fmaxf(us, 0.01f)) * (float)PHPROF_Q); }
#endif
#ifdef KFREQ
    if (blockIdx.x == 0 && F.tid == 0) { const float cyc = (float)(__builtin_amdgcn_s_memtime() - kfc0), rt = (float)(__builtin_amdgcn_s_memrealtime() - kfr0); const float mhz = cyc / rt * 100.0f;
        F.out[0] = 1000.0f * rintf((mhz - (float)KFREQ) * (1.0f / (float)KFSTEP)); }
#endif
#ifndef D5_PROF_Q
#define D5_PROF_Q 6
#endif
#ifdef LRUPROF
    xcd_barrier(bar);
    if (blockIdx.x == 0 && F.tid == 0) { const unsigned long long* pr = (const unsigned long long*)(F.ws + WS_CTL) + 8192; F.out[0] = 1000.0f * rintf(log2f(fmaxf((float)pr[0], 1.0f)) * (float)LRUPROF_Q); }
#endif
#if D5_PROF
    xcd_barrier(bar);
    if (blockIdx.x == 0 && F.tid == 0) { const unsigned long long* pr = (const unsigned long long*)(F.ws + WS_CTL) + 8192; { const float v_ = (float)pr[0] * (1.0f / 132.0f); F.out[0] = 1000.0f * rintf(log2f(fmaxf(v_, 1.0f)) * (float)D5_PROF_Q); }     F.out[1] = 0.f; }
#endif
#if DBG_PROBE
    xcd_barrier(bar);
    if (blockIdx.x == 0 && F.tid == 0) { const float md = __uint_as_float(ctl[CW_DBG]), ms = __uint_as_float(ctl[CW_DBG + 1]); F.out[0] = 1.0e4f * md / fmaxf(ms, 1e-20f); F.out[1] = 0.f; }
#endif
}
constexpr int N_PHASES = 2 + 2 * 9;

#ifndef MK_N_LAUNCHES
#define MK_N_LAUNCHES 1
#endif
extern "C" void kernel_launch(void* const* d_in, const int* in_sizes, int n_in, void* d_out, int out_size, void* d_ws, size_t ws_size, hipStream_t stream) {
    static int grid = 0;
    if (grid == 0) {
        if (n_in != 23 || in_sizes[0] != MLAT * DM || out_size != MLAT * DM || ws_size < WS_END) { fprintf(stderr, "kernel_launch: unexpected shapes (n_in %d, in0 %d, out %d, ws %zu); nothing launched\n", n_in, n_in > 0 ? in_sizes[0] : -1, out_size, ws_size); grid = -1; return; }
        int dev = 0, cus = 0, per_cu = 0;
        if (hipGetDevice(&dev) != hipSuccess || hipDeviceGetAttribute(&cus, hipDeviceAttributeMultiprocessorCount, dev) != hipSuccess) { fprintf(stderr, "kernel_launch: device query failed\n"); grid = -1; return; }
        if (hipFuncSetAttribute((const void*)hybrid_fwd, hipFuncAttributeMaxDynamicSharedMemorySize, LDS_BYTES) != hipSuccess) { fprintf(stderr, "kernel_launch: hipFuncSetAttribute failed\n"); grid = -1; return; }
        if (hipOccupancyMaxActiveBlocksPerMultiprocessor(&per_cu, (const void*)hybrid_fwd, NWAVES * 64, LDS_BYTES) != hipSuccess || per_cu < 1) { fprintf(stderr, "kernel_launch: occupancy query reports %d workgroups per CU\n", per_cu); }
        (void)hipGetLastError();
        grid = cus;
    }
    if (grid < 0) return;
    if (hipMemsetAsync((char*)d_ws + WS_CTL, 0, CTL_ZERO_BYTES, stream) != hipSuccess) { fprintf(stderr, "kernel_launch: memset failed\n"); return; }
    Args a{};
    for (int i = 0; i < 23; ++i) a.in[i] = (const float*)d_in[i];
    a.out = (float*)d_out; a.ws = (unsigned char*)d_ws;
#if MK_N_LAUNCHES == 1
    a.ph_lo = 0; a.ph_hi = N_PHASES;
    hipLaunchKernelGGL(hybrid_fwd, dim3(grid), dim3(NWAVES * 64), LDS_BYTES, stream, a);
#else
    for (int p = 0; p < N_PHASES; ++p) { a.ph_lo = p; a.ph_hi = p + 1; hipLaunchKernelGGL(hybrid_fwd, dim3(grid), dim3(NWAVES * 64), LDS_BYTES, stream, a); }
#endif
    const hipError_t le = hipPeekAtLastError();
    if (le != hipSuccess) fprintf(stderr, "kernel_launch: launch failed: %s\n", hipGetErrorName(le));
}
```
